# Optimizing an MI355X kernel written in HIP

```python
import jax, jax.numpy as jnp
from jax import lax
import numpy as np

D_MODEL = 1024
BATCH = 16
SEQ = 2048
DEPTH = 4

CHUNK = 64
N_MEM = 256
D_MIX = D_MODEL
N_GROUPS = 4
D_GROUP = D_MIX // N_GROUPS
CONV_WIDTH = 3
POOL_WINDOWS = (2, 4, 8, 16)
POOL_CH = D_GROUP // len(POOL_WINDOWS)
GMLP_BLOCK = 128
GMLP_HEADS = 4
GMLP_HEAD_DIM = D_GROUP // GMLP_HEADS
MEM_HEADS = 4
MEM_HEAD_DIM = D_GROUP // MEM_HEADS
N_EXPERTS = 32
TOP_K = 4
D_FF = D_MODEL
SWIGLU_ALPHA = 1.702
SWIGLU_LIMIT = 7.0
DEEPNORM_ALPHA = (2 * DEPTH) ** 0.25
DEEPNORM_BETA = (8 * DEPTH) ** -0.25
LN_EPS = 1e-5
RMS_EPS = 1e-6
D_IN_PROJ = 7 * D_GROUP
IN_SPLITS = (D_GROUP, 2 * D_GROUP, 3 * D_GROUP, 4 * D_GROUP, 6 * D_GROUP)

kernel_name = "hybrid_conv_pool_gmlp_memattn_moe_deepnorm"


def layer_norm(x, g, b):
    xf = x.astype(jnp.float32)
    mu = jnp.mean(xf, axis=-1, keepdims=True)
    var = jnp.mean(jnp.square(xf - mu), axis=-1, keepdims=True)
    y = (xf - mu) * lax.rsqrt(var + LN_EPS) * g.astype(jnp.float32) + b.astype(jnp.float32)
    return y.astype(x.dtype)


def rms_norm(x, g):
    xf = x.astype(jnp.float32)
    y = xf * lax.rsqrt(jnp.mean(jnp.square(xf), axis=-1, keepdims=True) + RMS_EPS) * g.astype(jnp.float32)
    return y.astype(x.dtype)


def short_conv_mixer(gate_b, gate_c, h, conv_w):
    z = gate_c * h
    y = lax.conv_general_dilated(
        z, conv_w[:, None, :], window_strides=(1,), padding=[(CONV_WIDTH - 1, 0)],
        dimension_numbers=('NWC', 'WIO', 'NWC'), feature_group_count=D_GROUP)
    return gate_b * y


def pool_mixer(p, pool_w, pool_scale):
    _, S, _ = p.shape
    pf = p.astype(jnp.float32)
    csum = jnp.cumsum(pf, axis=1)
    t = jnp.arange(S)
    diffs = []
    for g, w in enumerate(POOL_WINDOWS):
        c = csum[:, :, g * POOL_CH:(g + 1) * POOL_CH]
        prev = jnp.pad(c, ((0, 0), (w, 0), (0, 0)))[:, :S]
        count = jnp.minimum(t + 1, w).astype(jnp.float32)[None, :, None]
        diffs.append((c - prev) / count - pf[:, :, g * POOL_CH:(g + 1) * POOL_CH])
    d = jnp.stack(diffs, axis=2).astype(p.dtype)
    y = jnp.einsum('bsgc,gcd->bsgd', d, pool_w)
    return y.reshape(p.shape) * pool_scale


def spatial_gating_mixer(z, v_ln_g, v_ln_b, w_s, b_s):
    Bsz, S, _ = z.shape
    z = jax.nn.gelu(z)
    u, v = jnp.split(z, 2, axis=-1)
    v = layer_norm(v, v_ln_g, v_ln_b)
    vb = v.reshape(Bsz, S // GMLP_BLOCK, GMLP_BLOCK, GMLP_HEADS, GMLP_HEAD_DIM)
    pos = jnp.arange(GMLP_BLOCK)
    mask = (pos[None, :] // CHUNK) <= (pos[:, None] // CHUNK)
    w_masked = jnp.where(mask[None], w_s, jnp.zeros_like(w_s))
    gate = jnp.einsum('hij,bnjhd->bnihd', w_masked, vb) + b_s.T[:, :, None]
    return u * gate.reshape(Bsz, S, D_GROUP)


def memory_attention(q, k, v):
    Bsz, S, _ = q.shape
    qh = q.reshape(Bsz, S, MEM_HEADS, MEM_HEAD_DIM)
    kh = k.reshape(Bsz, -1, MEM_HEADS, MEM_HEAD_DIM)
    vh = v.reshape(Bsz, -1, MEM_HEADS, MEM_HEAD_DIM)
    s = jnp.einsum('bshd,bmhd->bhsm', qh, kh).astype(jnp.float32) * (MEM_HEAD_DIM ** -0.5)
    p = jax.nn.softmax(s, axis=-1).astype(v.dtype)
    o = jnp.einsum('bhsm,bmhd->bshd', p, vh)
    return o.reshape(Bsz, S, D_GROUP)


def hybrid_mixer(x, mem_n, w_in, conv_w, pool_w, pool_scale, gmlp_ln_g, gmlp_ln_b, gmlp_w, gmlp_b,
                 w_mem_kv, group_norm_g, w_out):
    Bsz, S, _ = x.shape
    proj = jnp.einsum('bsd,dp->bsp', x, w_in)
    gate_b, gate_c, conv_in, pool_in, gmlp_in, mem_q = jnp.split(proj, IN_SPLITS, axis=-1)
    y_conv = short_conv_mixer(gate_b, gate_c, conv_in, conv_w)
    y_pool = pool_mixer(pool_in, pool_w, pool_scale)
    y_gmlp = spatial_gating_mixer(gmlp_in, gmlp_ln_g, gmlp_ln_b, gmlp_w, gmlp_b)
    mem_k, mem_v = jnp.split(jnp.einsum('bmd,dp->bmp', mem_n, w_mem_kv), 2, axis=-1)
    y_mem = memory_attention(mem_q, mem_k, mem_v)
    groups = jnp.stack([y_conv, y_pool, y_gmlp, y_mem], axis=2)
    groups = rms_norm(groups, group_norm_g.reshape(N_GROUPS, D_GROUP))
    return jnp.einsum('bsc,cd->bsd', groups.reshape(Bsz, S, D_MIX), w_out)


def moe_ffn(x, w_router, b_router, w1, b1, w2, b2):
    Bsz, S, D = x.shape
    xt = x.reshape(-1, D)
    logits = (xt @ w_router + b_router).astype(jnp.float32)
    top_val, top_idx = lax.top_k(logits, TOP_K)
    top_w = jax.nn.softmax(top_val, axis=-1)
    gates = jnp.einsum('nk,nke->ne', top_w,
                       jax.nn.one_hot(top_idx, N_EXPERTS, dtype=jnp.float32)).astype(x.dtype)
    y = jnp.zeros_like(xt)
    for e in range(N_EXPERTS):
        h = xt @ w1[e] + b1[e]
        glu = jnp.minimum(h[:, :D_FF], SWIGLU_LIMIT)
        lin = jnp.clip(h[:, D_FF:], -SWIGLU_LIMIT, SWIGLU_LIMIT)
        act = glu * jax.nn.sigmoid(SWIGLU_ALPHA * glu) * (lin + 1)
        y = y + gates[:, e:e + 1] * (act @ w2[e] + b2[e])
    return y.reshape(Bsz, S, D)


def setup_inputs(seed: int = 0) -> dict:
    key = jax.random.key(seed)
    ks = jax.random.split(key, 32)
    f32 = jnp.float32

    def nrm(k, shape, scale):
        return jax.random.normal(k, shape, f32) * scale

    L = DEPTH
    return {
        "x": nrm(ks[0], (BATCH, SEQ, D_MODEL), 1.0),
        "mem": nrm(ks[1], (BATCH, N_MEM, D_MODEL), 1.0),
        "ln_in_g": 1.0 + nrm(ks[2], (D_MODEL,), 0.02),
        "ln_in_b": nrm(ks[3], (D_MODEL,), 0.02),
        "mem_ln_g": 1.0 + nrm(ks[4], (D_MODEL,), 0.02),
        "mem_ln_b": nrm(ks[5], (D_MODEL,), 0.02),
        "w_in": nrm(ks[6], (L, D_MODEL, D_IN_PROJ), D_MODEL ** -0.5),
        "conv_w": nrm(ks[7], (L, CONV_WIDTH, D_GROUP), CONV_WIDTH ** -0.5),
        "pool_w": nrm(ks[8], (L, len(POOL_WINDOWS), POOL_CH, POOL_CH), POOL_CH ** -0.5),
        "pool_scale": 1.0 + nrm(ks[9], (L, D_GROUP), 0.1),
        "gmlp_ln_g": 1.0 + nrm(ks[10], (L, D_GROUP), 0.02),
        "gmlp_ln_b": nrm(ks[11], (L, D_GROUP), 0.02),
        "gmlp_w": nrm(ks[12], (L, GMLP_HEADS, GMLP_BLOCK, GMLP_BLOCK), GMLP_BLOCK ** -0.5),
        "gmlp_b": 1.0 + nrm(ks[13], (L, GMLP_HEADS, GMLP_BLOCK), 0.02),
        "w_mem_kv": nrm(ks[14], (L, D_MODEL, 2 * D_GROUP), D_MODEL ** -0.5),
        "group_norm_g": 1.0 + nrm(ks[15], (L, D_MIX), 0.02),
        "w_out": nrm(ks[16], (L, D_MIX, D_MODEL), D_MIX ** -0.5 * DEEPNORM_BETA),
        "ln1_g": 1.0 + nrm(ks[17], (L, D_MODEL), 0.02),
        "ln1_b": nrm(ks[18], (L, D_MODEL), 0.02),
        "w_router": nrm(ks[19], (L, D_MODEL, N_EXPERTS), D_MODEL ** -0.5),
        "b_router": nrm(ks[20], (L, N_EXPERTS), 0.01),
        "w1": nrm(ks[21], (L, N_EXPERTS, D_MODEL, 2 * D_FF), D_MODEL ** -0.5),
        "b1": nrm(ks[22], (L, N_EXPERTS, 2 * D_FF), 0.02),
        "w2": nrm(ks[23], (L, N_EXPERTS, D_FF, D_MODEL), D_FF ** -0.5 * DEEPNORM_BETA),
        "b2": nrm(ks[24], (L, N_EXPERTS, D_MODEL), 0.02),
        "ln2_g": 1.0 + nrm(ks[25], (L, D_MODEL), 0.02),
        "ln2_b": nrm(ks[26], (L, D_MODEL), 0.02),
    }


def reference(x, mem, ln_in_g, ln_in_b, mem_ln_g, mem_ln_b, w_in, conv_w, pool_w, pool_scale,
              gmlp_ln_g, gmlp_ln_b, gmlp_w, gmlp_b, w_mem_kv, group_norm_g, w_out, ln1_g, ln1_b,
              w_router, b_router, w1, b1, w2, b2, ln2_g, ln2_b):
    h = layer_norm(x, ln_in_g, ln_in_b)
    mem_n = layer_norm(mem, mem_ln_g, mem_ln_b)
    for l in range(DEPTH):
        mix = hybrid_mixer(h, mem_n, w_in[l], conv_w[l], pool_w[l], pool_scale[l], gmlp_ln_g[l],
                           gmlp_ln_b[l], gmlp_w[l], gmlp_b[l], w_mem_kv[l], group_norm_g[l], w_out[l])
        h = layer_norm(DEEPNORM_ALPHA * h + mix, ln1_g[l], ln1_b[l])
        ffn = moe_ffn(h, w_router[l], b_router[l], w1[l], b1[l], w2[l], b2[l])
        h = layer_norm(DEEPNORM_ALPHA * h + ffn, ln2_g[l], ln2_b[l])
    return h
```

```cpp
#include <hip/hip_runtime.h>
#include <cstdio>
#include <cstdint>

#ifndef MK_ONE_LAUNCH
#define MK_ONE_LAUNCH 0
#endif
#ifndef PHMASK
#define PHMASK 0xffff
#endif
#ifndef NAIVE_MIX
#define NAIVE_MIX 1
#endif

namespace pg8 {
#define PG8_LAS __attribute__((address_space(3)))
typedef unsigned short bf16_t;
typedef short bf16x8 __attribute__((ext_vector_type(8)));
typedef float f32x4 __attribute__((ext_vector_type(4)));
typedef float f32x2 __attribute__((ext_vector_type(2)));
typedef unsigned u32x4 __attribute__((ext_vector_type(4)));
typedef unsigned u32x2 __attribute__((ext_vector_type(2)));
constexpr int BM = 256, BK = 64, HALF = 128, HTB = HALF * BK * 2  , STAGE_BYTES = 8 * HTB, NXCD = 8, WGM = 8;

__host__ __device__ __forceinline__ int lds_byte(int r, int c) { const int st = (r >> 4) * 2 + (c >> 5), rr = r & 15, cc = c & 31, ob = rr * 64 + cc * 2; return st * 1024 + (ob ^ (((ob >> 9) & 1) << 5)); }
__host__ __device__ __forceinline__ void stage_rc(int b, int& R, int& C) { const int st = b / 1024, sb = b % 1024, swz = sb ^ (((sb >> 9) & 1) << 5); R = (st >> 1) * 16 + swz / 64; C = (st & 1) * 32 + (swz % 64) / 2; }
__host__ __device__ __forceinline__ int perm32(int rho) { const int n = rho >> 4, i = rho & 15; return 8 * (i >> 2) + 4 * n + (i & 3); }

struct Unit { int pm, pn, lm, ln, a0; };
struct Gemm { const bf16_t* A; const bf16_t* Bt; int K; };

__device__ __forceinline__ void tile_of(int L, int nM, int nN, int& tm, int& tn) {
    const int nwg = nM * nN; int wgid = L; { const int q = nwg / NXCD, r = nwg % NXCD, xcd = wgid % NXCD, off = wgid / NXCD; wgid = (xcd < r ? xcd * (q + 1) : r * (q + 1) + (xcd - r) * q) + off; }
    const int nig = WGM * nN, gid = wgid / nig, fm = gid * WGM, gsz = (nM - fm) < WGM ? (nM - fm) : WGM;
    tm = fm + ((wgid % nig) % gsz); tn = (wgid % nig) / gsz;
}

__device__ __forceinline__ unsigned cvt_pk_bf16(float lo, float hi) { unsigned r; asm volatile("v_cvt_pk_bf16_f32 %0, %1, %2" : "=v"(r) : "v"(lo), "v"(hi)); return r; }


struct EpiBf16Sel {
    static constexpr bool PERM = true, AFTER_DRAIN = false;
    bf16_t* o0; bf16_t* o1; int ld0, ld1;
    __device__ __forceinline__ void operator()(const f32x4 (&acc)[2][2][4][2], const Unit& u, int wr, int wc, int fr, int fq) const {
        bf16_t* base = u.a0 == 0 ? o0 : o1; const int ldc = u.a0 == 0 ? ld0 : ld1;
        const int row0 = u.lm * BM + wr * 64 + fr, col0 = u.ln * BM + wc * 32 + 8 * fq;
#pragma unroll
        for (int ai = 0; ai < 2; ++ai)
#pragma unroll
            for (int m = 0; m < 4; ++m) { bf16_t* rowp = base + (size_t)(row0 + ai * HALF + m * 16) * ldc + col0;
#pragma unroll
                for (int bj = 0; bj < 2; ++bj) { const f32x4 v0 = acc[ai][bj][m][0], v1 = acc[ai][bj][m][1];
                    u32x4 w; w.x = cvt_pk_bf16(v0[0], v0[1]); w.y = cvt_pk_bf16(v0[2], v0[3]); w.z = cvt_pk_bf16(v1[0], v1[1]); w.w = cvt_pk_bf16(v1[2], v1[3]);
                    *(u32x4*)(rowp + bj * HALF) = w; } }
    }
};
struct EpiResF32 {
    static constexpr bool PERM = false, AFTER_DRAIN = false;
    const float* h; float* pre; float alpha;
    __device__ __forceinline__ void operator()(const f32x4 (&acc)[2][2][4][2], const Unit& u, int wr, int wc, int fr, int fq) const {
        const int row0 = u.lm * BM + wr * 64 + fr, col0 = u.ln * BM + wc * 32 + 4 * fq;
#pragma unroll
        for (int ai = 0; ai < 2; ++ai)
#pragma unroll
            for (int m = 0; m < 4; ++m) { const size_t off = (size_t)(row0 + ai * HALF + m * 16) * 1024 + col0;
#pragma unroll
                for (int bj = 0; bj < 2; ++bj)
#pragma unroll
                    for (int n = 0; n < 2; ++n) { const f32x4 hv = *(const f32x4*)(h + off + bj * HALF + n * 16); *(f32x4*)(pre + off + bj * HALF + n * 16) = hv * alpha + acc[ai][bj][m][n]; }
                asm volatile("" ::: "memory"); }
    }
};
struct EpiSwiglu {
    static constexpr bool PERM = true, AFTER_DRAIN = false;
    bf16_t* act; const float* b1;
    __device__ __forceinline__ void operator()(const f32x4 (&acc)[2][2][4][2], const Unit& u, int wr, int wc, int fr, int fq) const {
        const int row0 = u.lm * BM + wr * 64 + fr, lc0 = u.ln * HALF + wc * 32 + 8 * fq;
        const float* bb = b1 + (size_t)u.a0 * 2048 + lc0;
        const f32x4 bg0 = *(const f32x4*)(bb), bg1 = *(const f32x4*)(bb + 4), bl0 = *(const f32x4*)(bb + 1024), bl1 = *(const f32x4*)(bb + 1028);
#pragma unroll
        for (int ai = 0; ai < 2; ++ai)
#pragma unroll
            for (int m = 0; m < 4; ++m) {
                u32x4 w; unsigned* wp = (unsigned*)&w;
#pragma unroll
                for (int n = 0; n < 2; ++n) { const f32x4 g4 = acc[ai][0][m][n] + (n ? bg1 : bg0), l4 = acc[ai][1][m][n] + (n ? bl1 : bl0); float r4[4];
#pragma unroll
                    for (int j = 0; j < 4; ++j) { const float g = fminf(g4[j], 7.0f), li = fminf(fmaxf(l4[j], -7.0f), 7.0f);
                        const float sg = __builtin_amdgcn_rcpf(1.0f + __builtin_amdgcn_exp2f(g * (-1.702f * 1.4426950408889634f))); r4[j] = g * sg * (li + 1.0f); }
                    wp[2 * n] = cvt_pk_bf16(r4[0], r4[1]); wp[2 * n + 1] = cvt_pk_bf16(r4[2], r4[3]); }
                *(u32x4*)(act + (size_t)(row0 + ai * HALF + m * 16) * 1024 + lc0) = w; }
    }
};
struct EpiDown {
    static constexpr bool PERM = true, AFTER_DRAIN = false;
    bf16_t* ys; const float* b2;
    __device__ __forceinline__ void operator()(const f32x4 (&acc)[2][2][4][2], const Unit& u, int wr, int wc, int fr, int fq) const {
        const int row0 = u.lm * BM + wr * 64 + fr, col0 = u.ln * BM + wc * 32 + 8 * fq;
        f32x4 bv[2][2];
#pragma unroll
        for (int bj = 0; bj < 2; ++bj)
#pragma unroll
            for (int n = 0; n < 2; ++n) bv[bj][n] = *(const f32x4*)(b2 + (size_t)u.a0 * 1024 + col0 + bj * HALF + 4 * n);
#pragma unroll
        for (int ai = 0; ai < 2; ++ai)
#pragma unroll
            for (int m = 0; m < 4; ++m) { bf16_t* rowp = ys + (size_t)(row0 + ai * HALF + m * 16) * 1024 + col0;
#pragma unroll
                for (int bj = 0; bj < 2; ++bj) { const f32x4 v0 = acc[ai][bj][m][0] + bv[bj][0], v1 = acc[ai][bj][m][1] + bv[bj][1];
                    u32x4 w; w.x = cvt_pk_bf16(v0[0], v0[1]); w.y = cvt_pk_bf16(v0[2], v0[3]); w.z = cvt_pk_bf16(v1[0], v1[1]); w.w = cvt_pk_bf16(v1[2], v1[3]);
                    *(u32x4*)(rowp + bj * HALF) = w; } }
    }
};

template <class Epi, class Sched, bool ALIGN_EPI = false, bool SP2 = false>
__device__ __forceinline__ void gemm_phase(PG8_LAS unsigned char* lds, const Gemm g, const Sched& S, const Epi& E) {
    int tid_l = threadIdx.x; asm volatile("" : "+v"(tid_l));
    const int tid = tid_l, wid = __builtin_amdgcn_readfirstlane(tid >> 6), lane = tid & 63, wr = wid >> 2, wc = wid & 3, fr = lane & 15, fq = lane >> 4;
    const int K = g.K, nt = K / BK;
    unsigned voffA[2], voffB[2];
#pragma unroll
    for (int i = 0; i < 2; ++i) { int R, C; stage_rc(tid * 16 + i * 8192, R, C); const int Rb = Epi::PERM ? ((R & ~31) + perm32(R & 31)) : R;
        voffA[i] = (unsigned)(R * K + C) * 2u; voffB[i] = (unsigned)(Rb * K + C) * 2u; }
    const size_t kstep = (size_t)(BK * 2);
    const size_t hstep = (size_t)HALF * K * 2;
    const size_t tstep = 2 * hstep;
    const unsigned ldsw = (unsigned)wid * 1024u;
    const int aoff = lds_byte(wr * 64 + fr, fq * 8), boff = lds_byte(wc * 32 + fr, fq * 8);
#define PG8_SA(b, h) (((b) * 2 + (h)) * HTB)
#define PG8_SB(b, h) ((4 + (b) * 2 + (h)) * HTB)
#define PG8_STAGE(bufoff, gbase, voff) do { _Pragma("unroll") for (int _i = 0; _i < 2; ++_i) \
        __builtin_amdgcn_global_load_lds((const unsigned*)((const char*)(gbase) + (voff)[_i]), (PG8_LAS unsigned*)(lds + (bufoff) + ldsw + _i * 8192), 16, 0, 0); } while (0)
#define PG8_LDA(dst, b, h) do { _Pragma("unroll") for (int m = 0; m < 4; ++m) _Pragma("unroll") for (int k = 0; k < 2; ++k) dst[m][k] = *(const PG8_LAS bf16x8*)(lds + PG8_SA(b, h) + aoff + m * 2048 + k * 1024); } while (0)
#define PG8_LDB(dst, b, h) do { _Pragma("unroll") for (int n = 0; n < 2; ++n) _Pragma("unroll") for (int k = 0; k < 2; ++k) dst[n][k] = *(const PG8_LAS bf16x8*)(lds + PG8_SB(b, h) + boff + n * 2048 + k * 1024); } while (0)
#define PG8_MMA(ai, bj, At, Bt) do { __builtin_amdgcn_s_setprio(1); _Pragma("unroll") for (int m = 0; m < 4; ++m) _Pragma("unroll") for (int n = 0; n < 2; ++n) _Pragma("unroll") for (int k = 0; k < 2; ++k) \
        acc[ai][bj][m][n] = __builtin_amdgcn_mfma_f32_16x16x32_bf16(Bt[n][k], At[m][k], acc[ai][bj][m][n], 0, 0, 0); __builtin_amdgcn_s_setprio(0); } while (0)
#define PG8_WAIT_V(n) asm volatile("s_waitcnt vmcnt(" #n ")" ::: "memory")
#define PG8_WAIT_L(n) asm volatile("s_waitcnt lgkmcnt(" #n ")" ::: "memory")
#define PG8_BAR __builtin_amdgcn_s_barrier()
#define PG8_SCHED __builtin_amdgcn_sched_barrier(0)
    Unit cur, nxt; int ui = 0;
    if (!S.next(0, cur)) return;
    f32x4 acc[2][2][4][2];
#pragma unroll
    for (int a = 0; a < 2; ++a)
#pragma unroll
        for (int b = 0; b < 2; ++b)
#pragma unroll
            for (int m = 0; m < 4; ++m)
#pragma unroll
                for (int n = 0; n < 2; ++n) acc[a][b][m][n] = (f32x4){0.f, 0.f, 0.f, 0.f};
    bf16x8 At[4][2], B0[2][2], B1[2][2];
    const char* cA = (const char*)g.A + (size_t)cur.pm * tstep; const char* cB = (const char*)g.Bt + (size_t)cur.pn * tstep;
    S.a_ready(cur);
    if constexpr (SP2) {
        PG8_STAGE(PG8_SB(0, 0), cB, voffB); PG8_STAGE(PG8_SB(0, 1), cB + hstep, voffB); PG8_STAGE(PG8_SA(0, 0), cA, voffA); PG8_STAGE(PG8_SA(0, 1), cA + hstep, voffA);
        if (wr == 1) PG8_BAR;
        PG8_WAIT_V(2); PG8_BAR;
        PG8_STAGE(PG8_SB(1, 0), cB + kstep, voffB); PG8_STAGE(PG8_SA(1, 0), cA + kstep, voffA); PG8_STAGE(PG8_SB(1, 1), cB + hstep + kstep, voffB);
        PG8_WAIT_V(6); PG8_BAR;
    } else {
        PG8_STAGE(PG8_SB(0, 0), cB, voffB); PG8_STAGE(PG8_SA(0, 0), cA, voffA); PG8_STAGE(PG8_SB(0, 1), cB + hstep, voffB); PG8_STAGE(PG8_SA(0, 1), cA + hstep, voffA);
        if (wr == 1) PG8_BAR;
        PG8_WAIT_V(4); PG8_BAR;
        PG8_STAGE(PG8_SB(1, 0), cB + kstep, voffB); PG8_STAGE(PG8_SA(1, 0), cA + kstep, voffA); PG8_STAGE(PG8_SB(1, 1), cB + hstep + kstep, voffB);
        PG8_WAIT_V(6); PG8_BAR;
    }
    for (;;) {
        const bool has_next = S.next(ui + 1, nxt);
        const char* nA = has_next ? (const char*)g.A + (size_t)nxt.pm * tstep : cA; const char* nB = has_next ? (const char*)g.Bt + (size_t)nxt.pn * tstep : cB;
        for (int t = 0; t < nt; t += 2) {
            const bool last = (t == nt - 2);
            const char* a1 = cA + (size_t)(t + 1) * kstep;
            const char* a2 = last ? nA : cA + (size_t)(t + 2) * kstep; const char* b2 = last ? nB : cB + (size_t)(t + 2) * kstep;
            const char* a3 = a2 + kstep; const char* b3 = b2 + kstep;
            if (last && has_next) S.a_ready(nxt);
            if constexpr (SP2) {
            PG8_LDB(B0, 0, 0); PG8_LDB(B1, 0, 1); PG8_SCHED; PG8_LDA(At, 0, 0); PG8_STAGE(PG8_SA(1, 1), a1 + hstep, voffA);
            PG8_WAIT_V(8); PG8_WAIT_L(0); PG8_BAR; PG8_MMA(0, 0, At, B0); PG8_MMA(0, 1, At, B1); PG8_BAR; PG8_SCHED;
            PG8_LDA(At, 0, 1); PG8_STAGE(PG8_SB(0, 0), b2, voffB); PG8_STAGE(PG8_SB(0, 1), b2 + hstep, voffB); PG8_STAGE(PG8_SA(0, 0), a2, voffA);
            PG8_WAIT_V(8); PG8_WAIT_L(0); PG8_BAR; PG8_MMA(1, 0, At, B0); PG8_MMA(1, 1, At, B1); PG8_BAR; PG8_SCHED;
            PG8_LDB(B0, 1, 0); PG8_LDB(B1, 1, 1); PG8_SCHED; PG8_LDA(At, 1, 0); PG8_STAGE(PG8_SA(0, 1), a2 + hstep, voffA);
            PG8_WAIT_V(8); PG8_WAIT_L(0); PG8_BAR; PG8_MMA(0, 0, At, B0); PG8_MMA(0, 1, At, B1); PG8_BAR; PG8_SCHED;
            PG8_LDA(At, 1, 1); PG8_STAGE(PG8_SB(1, 0), b3, voffB); PG8_STAGE(PG8_SB(1, 1), b3 + hstep, voffB); PG8_STAGE(PG8_SA(1, 0), a3, voffA);
            PG8_WAIT_V(8); PG8_WAIT_L(0); PG8_BAR; PG8_MMA(1, 0, At, B0); PG8_MMA(1, 1, At, B1); PG8_BAR; PG8_SCHED;
            } else {
            PG8_LDB(B0, 0, 0); PG8_SCHED; PG8_LDA(At, 0, 0); PG8_STAGE(PG8_SA(1, 1), a1 + hstep, voffA);
            PG8_WAIT_L(8); PG8_BAR; PG8_WAIT_L(0); PG8_MMA(0, 0, At, B0); PG8_BAR; PG8_SCHED;
            PG8_LDB(B1, 0, 1); PG8_STAGE(PG8_SB(0, 0), b2, voffB);
            PG8_BAR; PG8_WAIT_L(0); PG8_MMA(0, 1, At, B1); PG8_BAR;
            PG8_LDA(At, 0, 1); PG8_STAGE(PG8_SA(0, 0), a2, voffA);
            PG8_BAR; PG8_WAIT_L(0); PG8_MMA(1, 0, At, B0); PG8_BAR; PG8_SCHED;
            PG8_STAGE(PG8_SB(0, 1), b2 + hstep, voffB);
            PG8_WAIT_V(6); PG8_BAR; PG8_MMA(1, 1, At, B1); PG8_BAR;
            PG8_LDB(B0, 1, 0); PG8_SCHED; PG8_LDA(At, 1, 0); PG8_STAGE(PG8_SA(0, 1), a2 + hstep, voffA);
            PG8_WAIT_L(8); PG8_BAR; PG8_WAIT_L(0); PG8_MMA(0, 0, At, B0); PG8_BAR; PG8_SCHED;
            PG8_LDB(B1, 1, 1); PG8_STAGE(PG8_SB(1, 0), b3, voffB);
            PG8_BAR; PG8_WAIT_L(0); PG8_MMA(0, 1, At, B1); PG8_BAR;
            PG8_LDA(At, 1, 1); PG8_STAGE(PG8_SA(1, 0), a3, voffA);
            PG8_BAR; PG8_WAIT_L(0); PG8_MMA(1, 0, At, B0); PG8_BAR; PG8_SCHED;
            PG8_STAGE(PG8_SB(1, 1), b3 + hstep, voffB);
            PG8_WAIT_V(6); PG8_BAR; PG8_MMA(1, 1, At, B1); PG8_BAR;
            }
        }
        if constexpr (ALIGN_EPI) { if (wr == 0) PG8_BAR; }
        if constexpr (!Epi::AFTER_DRAIN) { E(acc, cur, wr, wc, fr, fq); S.done(cur); }
        if (!has_next) break;
#pragma unroll
        for (int a = 0; a < 2; ++a)
#pragma unroll
            for (int b = 0; b < 2; ++b)
#pragma unroll
                for (int m = 0; m < 4; ++m)
#pragma unroll
                    for (int n = 0; n < 2; ++n) acc[a][b][m][n] = (f32x4){0.f, 0.f, 0.f, 0.f};
        cur = nxt; cA = nA; cB = nB; ++ui;
        if constexpr (ALIGN_EPI) { if (wr == 1) PG8_BAR; }
    }
    PG8_WAIT_V(0);
    if constexpr (!ALIGN_EPI) { if (wr == 0) PG8_BAR; }
    PG8_BAR;
    if constexpr (Epi::AFTER_DRAIN) { E.fused(acc, cur, wr, wc, fr, fq, lds, wid, lane); S.done(cur); }
#undef PG8_SA
#undef PG8_SB
#undef PG8_STAGE
#undef PG8_LDA
#undef PG8_LDB
#undef PG8_MMA
#undef PG8_WAIT_V
#undef PG8_WAIT_L
#undef PG8_BAR
#undef PG8_SCHED
}
}

#define GAS __attribute__((address_space(1)))
#define LAS __attribute__((address_space(3)))
typedef unsigned short bf16;
typedef unsigned v4u __attribute__((ext_vector_type(4)));
typedef unsigned v2u __attribute__((ext_vector_type(2)));
typedef float f32x4 __attribute__((ext_vector_type(4)));
typedef short bf16x8 __attribute__((ext_vector_type(8)));
typedef GAS unsigned gu32;
typedef GAS unsigned long long gu64;
#define RLX_AGENT __ATOMIC_RELAXED, __HIP_MEMORY_SCOPE_AGENT
#define LDS_WAIT() asm volatile("s_waitcnt lgkmcnt(0)" ::: "memory")
#define VM_WAIT() asm volatile("s_waitcnt vmcnt(0)" ::: "memory")
__device__ __forceinline__ unsigned long long rt() { return __builtin_amdgcn_s_memrealtime(); }
__device__ __forceinline__ unsigned f2bf(float f) { unsigned u = __builtin_bit_cast(unsigned, f); return (u + 0x7fffu + ((u >> 16) & 1u)) >> 16; }
__device__ __forceinline__ unsigned pk2(float lo, float hi) { return f2bf(lo) | (f2bf(hi) << 16); }

#define XB_TMO      128
#define XB_XCNT(j)  (256  + 64 * (j))
#define XB_XSUB(j)  (1280 + 64 * (j))
#define XB_XGEN(j)  (2304 + 64 * (j))
#define XB_TOP      3328
#define XB_TOPGEN   3392
#define XCD_BAR_WORDS 3456
#define XB_SPIN_CAP (1u << 18)

__device__ __forceinline__ unsigned xb_ld(unsigned* p)              { return __hip_atomic_load(p, __ATOMIC_RELAXED, __HIP_MEMORY_SCOPE_AGENT); }
__device__ __forceinline__ unsigned xb_add(unsigned* p, unsigned v) { return __hip_atomic_fetch_add(p, v, __ATOMIC_RELAXED, __HIP_MEMORY_SCOPE_AGENT); }
__device__ __forceinline__ unsigned xb_xcc_id() { return (unsigned)__builtin_amdgcn_s_getreg((3 << 11) | 20) & 0xFu; }
#define XB_SPIN(cond, bar) do { unsigned _sp = 0; while (cond) { __builtin_amdgcn_s_sleep(1); \
    if ((++_sp & 255u) == 0u) { if (xb_ld(&(bar)[XB_TMO])) break; if (_sp > XB_SPIN_CAP) { atomicAdd(&(bar)[XB_TMO], 1u); break; } } } } while (0)

struct XcdBarrier {
    unsigned* bar; unsigned x;
    volatile LAS unsigned* st;
};

__device__ __forceinline__ XcdBarrier xcd_barrier_post(unsigned* bar, volatile LAS unsigned* st) {
    XcdBarrier b; b.bar = bar; b.x = xb_xcc_id(); b.st = st;
    if (threadIdx.x == 0) (void)xb_add(&bar[XB_XCNT(b.x)], 1u);
    return b;
}
__device__ __forceinline__ void xcd_barrier_complete(unsigned* bar, unsigned x, unsigned& nloc, unsigned& nx) {
    const unsigned G = gridDim.x * gridDim.y * gridDim.z;
    unsigned sum, cnt, mine, sp = 0u;
    for (;;) {
        sum = 0u; cnt = 0u; mine = 0u;
#pragma unroll
        for (unsigned j = 0; j < 16; ++j) { const unsigned c = xb_ld(&bar[XB_XCNT(j)]); sum += c; cnt += (c > 0u) ? 1u : 0u; mine = (j == x) ? c : mine; }
        if (sum == G) break;
        __builtin_amdgcn_s_sleep(1);
        if ((++sp & 255u) == 0u) { if (xb_ld(&bar[XB_TMO])) break; if (sp > XB_SPIN_CAP) { atomicAdd(&bar[XB_TMO], 1u); break; } }
    }
    nloc = mine > 0u ? mine : 1u; nx = cnt > 0u ? cnt : 1u;
}

__device__ __forceinline__ void xcd_barrier(const XcdBarrier& b) {
    asm volatile("s_waitcnt vmcnt(0)" ::: "memory");
    __syncthreads();
    if (threadIdx.x == 0) {
        unsigned* bar = b.bar;
        __builtin_amdgcn_s_waitcnt(0);
        unsigned nloc = b.st[0], nx = b.st[1];
        if (nloc == 0u) { xcd_barrier_complete(bar, b.x, nloc, nx); b.st[0] = nloc; b.st[1] = nx; }
        const unsigned old = xb_add(&bar[XB_XSUB(b.x)], 1u);
        const unsigned gen = old / nloc;
        if (old + 1u == (gen + 1u) * nloc) {
            __builtin_amdgcn_fence(__ATOMIC_RELEASE, "agent");
            asm volatile("s_waitcnt vmcnt(0)" ::: "memory");
            const unsigned og = xb_add(&bar[XB_TOP], 1u);
            const unsigned tg = og / nx;
            if (og + 1u == (tg + 1u) * nx) xb_add(&bar[XB_TOPGEN], 1u);
            else XB_SPIN(xb_ld(&bar[XB_TOPGEN]) == tg, bar);
            __builtin_amdgcn_fence(__ATOMIC_ACQUIRE, "agent");
            xb_add(&bar[XB_XGEN(b.x)], 1u);
            asm volatile("s_waitcnt vmcnt(0)" ::: "memory");
        } else {
            XB_SPIN(xb_ld(&bar[XB_XGEN(b.x)]) == gen, bar);
            __builtin_amdgcn_fence(__ATOMIC_ACQUIRE, "agent");
            asm volatile("s_waitcnt vmcnt(0)" ::: "memory");
        }
    }
    __syncthreads();
}


constexpr int NWAVES = 8;
constexpr int NTOK = 32768, D = 1024, NPROJ = 1792, NLAYER = 4, NEXP = 32, SEQ = 2048, NBATCH = 16, NMEM = 256;
constexpr float LN_EPS = 1e-5f, RMS_EPS = 1e-6f;
constexpr float DN_ALPHA = 1.6817928305074292f;
constexpr int XP_TILES = NTOK * 4 / 256 + NEXP;

constexpr size_t MiB = 1u << 20, TILE = 512 * 1024;
constexpr size_t WS_CTL = 0, CTL_ZERO_BYTES = 1 * MiB;
constexpr size_t WS_WMB = 1 * MiB;
constexpr size_t WS_POOLT = WS_WMB + 512 * 1024;
constexpr size_t WS_WRT = WS_POOLT + 128 * 1024;
constexpr int T_WIN = 4, T_WOUT = T_WIN + 28, T_WKV = T_WOUT + 16, T_MEMN = T_WKV + 8, T_W1 = T_MEMN + 16, T_W2 = T_W1 + 1024, T_HB = T_W2 + 512, T_G = T_HB + 128,
              T_XP = T_G + 128, T_ACT = T_XP + XP_TILES, T_YS = T_ACT + XP_TILES, T_END = T_YS + XP_TILES;
constexpr size_t WS_P = (size_t)T_END * TILE;
constexpr size_t WS_HF = WS_P + 112 * MiB;
constexpr size_t WS_PRE = WS_HF + 128 * MiB;
constexpr size_t WS_KB = WS_PRE + 128 * MiB;
constexpr size_t WS_VT = WS_KB + 8 * MiB;
constexpr size_t WS_TOKES = WS_VT + 8 * MiB;
constexpr size_t WS_TOKG = WS_TOKES + 512 * 1024;
constexpr size_t WS_ROWIDX = WS_TOKG + 512 * 1024;
constexpr size_t WS_NV_VN = WS_ROWIDX + 512 * 1024;
constexpr size_t WS_NV_DP = WS_NV_VN + 32 * MiB;
constexpr size_t WS_NV_Y = WS_NV_DP + 32 * MiB;
constexpr size_t WS_END = WS_NV_Y + 128 * MiB;
constexpr int CW_TMO = 0, CW_CODE = 1;
constexpr int CW_BAR = 4096;
constexpr int CW_CNT = 16384;
static_assert((CW_CNT + NLAYER * NEXP * 16) * 4 <= (int)CTL_ZERO_BYTES, "CTL words inside the memset region");
constexpr int RING_OFF = 0, RING_BYTES = 131072;
constexpr int LDSCTL_OFF = 147456 - 1024, MISC_OFF = LDSCTL_OFF + 320, TOFF_OFF = MISC_OFF + 128;
constexpr int LDS_BYTES = 147456;
static_assert(TOFF_OFF + 160 <= LDS_BYTES, "LDS map");

__device__ __forceinline__ float bf2f(unsigned short b) { return __builtin_bit_cast(float, (unsigned)b << 16); }
__device__ __forceinline__ float wave_sum(float v) {
#pragma unroll
    for (int o = 1; o < 64; o <<= 1) v += __shfl_xor(v, o);
    return v;
}
__device__ __forceinline__ float gelu_tanh(float x) {
    const float u = 0.7978845608028654f * (x + 0.044715f * x * x * x);
    return x * __builtin_amdgcn_rcpf(1.0f + __builtin_amdgcn_exp2f(u * (-2.0f * 1.4426950408889634f)));
}

struct Frame {
    LAS unsigned char* lds;
    volatile LAS unsigned* MISC;
    gu32* ctl;
    unsigned char* ws;
    int tid, lane, wave, G;
    float* out;
};
struct Args { const float* in[27]; float* out; unsigned char* ws; int ph_lo, ph_hi; };
enum { I_X = 0, I_MEM, I_LN_IN_G, I_LN_IN_B, I_MEM_LN_G, I_MEM_LN_B, I_W_IN, I_CONV_W, I_POOL_W, I_POOL_SCALE, I_GMLP_LN_G, I_GMLP_LN_B, I_GMLP_W, I_GMLP_B, I_W_MEM_KV, I_GROUP_NORM_G, I_W_OUT,
       I_LN1_G, I_LN1_B, I_W_ROUTER, I_B_ROUTER, I_W1, I_B1, I_W2, I_B2, I_LN2_G, I_LN2_B };
#define RELANE(F) do { int t_ = threadIdx.x; asm volatile("" : "+v"(t_)); (F).tid = t_; (F).lane = t_ & 63; (F).wave = __builtin_amdgcn_readfirstlane(t_ >> 6); } while (0)
#define WSP(T, off) ((T*)(F.ws + (off)))
#define TILEP(t) ((bf16*)(F.ws + (size_t)(t) * TILE))

__device__ __forceinline__ void tr64(const float* W, int ldw, int k0, int n0, bf16* WT, int ldt, int drow0, LAS float* scr, int lane) {
    const int c4 = 4 * (lane & 15), kq = lane >> 4;
#pragma unroll
    for (int i = 0; i < 16; ++i) { const int kk = 4 * i + kq; const f32x4 v = *(const f32x4*)(W + (size_t)(k0 + kk) * ldw + n0 + c4);
        LAS float* s = scr + kk * 65 + c4; s[0] = v.x; s[1] = v.y; s[2] = v.z; s[3] = v.w; }
    LDS_WAIT(); asm volatile("" ::: "memory");
    const int ck = lane & 7;
#pragma unroll
    for (int j = 0; j < 8; ++j) { const int n = (lane >> 3) + 8 * j; const LAS float* s = scr + (8 * ck) * 65 + n;
        v4u o; o.x = pk2(s[0 * 65], s[1 * 65]); o.y = pk2(s[2 * 65], s[3 * 65]); o.z = pk2(s[4 * 65], s[5 * 65]); o.w = pk2(s[6 * 65], s[7 * 65]);
        *(v4u*)(WT + (size_t)(drow0 + n) * ldt + k0 + 8 * ck) = o; }
    LDS_WAIT(); asm volatile("" ::: "memory");
}
__device__ __forceinline__ void ln_affine(f32x4 (&v)[4], const float* gam, const float* bet, int lane) {
    float s = 0.f;
#pragma unroll
    for (int j = 0; j < 4; ++j) s += (v[j].x + v[j].y) + (v[j].z + v[j].w);
    const float mean = wave_sum(s) * (1.f / 1024.f); float s2 = 0.f;
#pragma unroll
    for (int j = 0; j < 4; ++j) { v[j] = v[j] - mean; s2 += (v[j].x * v[j].x + v[j].y * v[j].y) + (v[j].z * v[j].z + v[j].w * v[j].w); }
    const float rstd = 1.f / sqrtf(wave_sum(s2) * (1.f / 1024.f) + LN_EPS);
#pragma unroll
    for (int j = 0; j < 4; ++j) { const f32x4 g = *(const f32x4*)(gam + 4 * lane + 256 * j), b = *(const f32x4*)(bet + 4 * lane + 256 * j); v[j] = v[j] * rstd * g + b; }
}
__device__ __forceinline__ void store_row_bf16(bf16* orow, const f32x4 (&v)[4], int lane) {
#pragma unroll
    for (int j = 0; j < 4; ++j) { v2u o; o.x = pk2(v[j].x, v[j].y); o.y = pk2(v[j].z, v[j].w); *(v2u*)(orow + 4 * lane + 256 * j) = o; }
}
__device__ __forceinline__ void p0_prologue(Frame& F, const Args& A) {
    RELANE(F);
    LAS float* scr = (LAS float*)(F.lds + RING_OFF + F.wave * 16640);
    const int gw = blockIdx.x * NWAVES + F.wave, NGW = F.G * NWAVES;
    constexpr int NI_W1 = NLAYER * NEXP * 16 * 32, NI_W2 = NLAYER * NEXP * 16 * 16, NI_WIN = NLAYER * 16 * 28, NI_WOUT = NLAYER * 16 * 16, NI_WKV = NLAYER * 16 * 8, NI_POOL = NLAYER * 4;
    constexpr int NITEMS = NI_W1 + NI_W2 + NI_WIN + NI_WOUT + NI_WKV + NI_POOL;
    for (int it = gw; it < NITEMS; it += NGW) {
        int r = it;
        if (r < NI_W1) { const int le = r >> 9, rr = r & 511, kb = rr >> 5, nb = rr & 31; const int n0 = 64 * nb, nn = n0 & 1023;
            const int drow = (nn >> 7) * 256 + (n0 >= 1024 ? 128 : 0) + (nn & 127);
            tr64(A.in[I_W1] + (size_t)le * 1024 * 2048, 2048, 64 * kb, n0, TILEP(T_W1) + (size_t)le * 2048 * 1024, 1024, drow, scr, F.lane); continue; } r -= NI_W1;
        if (r < NI_W2) { const int le = r >> 8, rr = r & 255, kb = rr >> 4, nb = rr & 15;
            tr64(A.in[I_W2] + (size_t)le * 1024 * 1024, 1024, 64 * kb, 64 * nb, TILEP(T_W2) + (size_t)le * 1024 * 1024, 1024, 64 * nb, scr, F.lane); continue; } r -= NI_W2;
        if (r < NI_WIN) { const int l = r / 448, rr = r % 448, kb = rr / 28, nb = rr % 28;
            tr64(A.in[I_W_IN] + (size_t)l * 1024 * NPROJ, NPROJ, 64 * kb, 64 * nb, TILEP(T_WIN) + (size_t)l * NPROJ * 1024, 1024, 64 * nb, scr, F.lane); continue; } r -= NI_WIN;
        if (r < NI_WOUT) { const int l = r >> 8, rr = r & 255, kb = rr >> 4, nb = rr & 15;
            tr64(A.in[I_W_OUT] + (size_t)l * 1024 * 1024, 1024, 64 * kb, 64 * nb, TILEP(T_WOUT) + (size_t)l * 1024 * 1024, 1024, 64 * nb, scr, F.lane); continue; } r -= NI_WOUT;
        if (r < NI_WKV) { const int l = r >> 7, rr = r & 127, kb = rr >> 3, nb = rr & 7;
            tr64(A.in[I_W_MEM_KV] + (size_t)l * 1024 * 512, 512, 64 * kb, 64 * nb, TILEP(T_WKV) + (size_t)l * 512 * 1024, 1024, 64 * nb, scr, F.lane); continue; } r -= NI_WKV;
        tr64(A.in[I_POOL_W] + (size_t)r * 64 * 64, 64, 0, 0, WSP(bf16, WS_POOLT) + (size_t)r * 64 * 64, 64, 0, scr, F.lane);
    }
    const int gt = blockIdx.x * (NWAVES * 64) + F.tid, NGT = F.G * NWAVES * 64;
    for (int i = gt; i < NLAYER * 4 * 128 * 128; i += NGT) { const int j = i & 127, ii = (i >> 7) & 127; WSP(bf16, WS_WMB)[i] = (bf16)(((j >> 6) <= (ii >> 6)) ? f2bf(A.in[I_GMLP_W][i]) : 0u); }
    for (int i = gt; i < NLAYER * 32 * 1024; i += NGT) { const int k = i & 1023, e = (i >> 10) & 31, l = i >> 15; WSP(bf16, WS_WRT)[i] = (bf16)f2bf(A.in[I_W_ROUTER][((size_t)l * 1024 + k) * 32 + e]); }
    for (int m = gw; m < NTOK + NBATCH * NMEM; m += NGW) {
        const bool ismem = m >= NTOK; const int row = ismem ? m - NTOK : m;
        const float* src = (ismem ? A.in[I_MEM] : A.in[I_X]) + (size_t)row * D;
        f32x4 v[4];
#pragma unroll
        for (int j = 0; j < 4; ++j) v[j] = *(const f32x4*)(src + 4 * F.lane + 256 * j);
        ln_affine(v, ismem ? A.in[I_MEM_LN_G] : A.in[I_LN_IN_G], ismem ? A.in[I_MEM_LN_B] : A.in[I_LN_IN_B], F.lane);
        if (!ismem) {
            float* hf = WSP(float, WS_HF) + (size_t)row * D;
#pragma unroll
            for (int j = 0; j < 4; ++j) *(f32x4*)(hf + 4 * F.lane + 256 * j) = v[j];
        }
        store_row_bf16((ismem ? TILEP(T_MEMN) : TILEP(T_HB)) + (size_t)row * D, v, F.lane);
    }
}

struct DenseOrder {
    int nM, nN, G, c, a_t0, b_t0;
    __device__ __forceinline__ bool next(int i, pg8::Unit& u) const {
        const long L = (long)i * G + c; if (L >= (long)nM * nN) return false;
        int tm, tn; pg8::tile_of((int)L, nM, nN, tm, tn); u.pm = a_t0 + tm; u.pn = b_t0 + tn; u.lm = tm; u.ln = tn; u.a0 = 0; return true;
    }
    __device__ __forceinline__ void a_ready(const pg8::Unit&) const {}
    __device__ __forceinline__ void done(const pg8::Unit&) const {}
};
struct KvOrder {
    int G, c;
    __device__ __forceinline__ bool next(int i, pg8::Unit& u) const {
        const int L = i * G + c; if (L >= NLAYER * 32) return false;
        const int l = L >> 5, r = L & 31;
        if (r < 16) { u.pm = T_MEMN + r; u.pn = T_WKV + 2 * l; u.lm = l * 16 + r; u.ln = 0; u.a0 = 0; }
        else { u.pm = T_WKV + 2 * l + 1; u.pn = T_MEMN + (r - 16); u.lm = l; u.ln = r - 16; u.a0 = 1; }
        return true;
    }
    __device__ __forceinline__ void a_ready(const pg8::Unit&) const {}
    __device__ __forceinline__ void done(const pg8::Unit&) const {}
};
struct MoeOrder {
    int TM, NTN, G, c, a_t0, b_t0; const LAS int* toff;
    __device__ __forceinline__ bool next(int i, pg8::Unit& u) const {
        const long L = (long)i * G + c; if (L >= (long)TM * NTN) return false;
        int tm, tn; pg8::tile_of((int)L, TM, NTN, tm, tn);
        int e = 0;
#pragma unroll
        for (int j = 1; j < NEXP; ++j) e += (toff[j] <= tm) ? 1 : 0;
        e = __builtin_amdgcn_readfirstlane(e);
        u.pm = a_t0 + tm; u.pn = b_t0 + e * NTN + tn; u.lm = tm; u.ln = tn; u.a0 = e; return true;
    }
    __device__ __forceinline__ void a_ready(const pg8::Unit&) const {}
    __device__ __forceinline__ void done(const pg8::Unit&) const {}
};
__device__ __forceinline__ void compute_toff(Frame& F, int l) {
    RELANE(F);
    LAS int* toff = (LAS int*)(F.lds + TOFF_OFF);
    __syncthreads();
    if (F.wave == 0) {
        int t = 0;
        if (F.lane < NEXP) { const unsigned c = __hip_atomic_load(F.ctl + CW_CNT + (l * NEXP + F.lane) * 16, RLX_AGENT); t = (int)((c + 255u) >> 8); }
        int incl = t;
#pragma unroll
        for (int o = 1; o < 32; o <<= 1) { const int y = __shfl_up(incl, o); if ((F.lane & 31) >= o) incl += y; }
        if (F.lane < NEXP) toff[F.lane + 1] = incl;
        if (F.lane == 0) toff[0] = 0;
    }
    __syncthreads();
}

__device__ __forceinline__ void pd_phase(Frame& F, const Args& A, int l) {
    RELANE(F);
    LAS unsigned char* T = F.lds;
    LAS float* part = (LAS float*)(F.lds + 66048);
    LAS float* logit = (LAS float*)(F.lds + 82432);
    LAS int* cntl = (LAS int*)(F.lds + 86656);
    LAS int* basel = (LAS int*)(F.lds + 86784);
    LAS int* sel_e = (LAS int*)(F.lds + 86912);
    LAS int* sel_r = sel_e + 512; LAS float* sel_g = (LAS float*)(sel_r + 512);
    const float* gam = A.in[I_LN1_G] + l * D; const float* bet = A.in[I_LN1_B] + l * D;
    const bf16* wr = WSP(bf16, WS_WRT) + (size_t)l * NEXP * D; const float* br = A.in[I_B_ROUTER] + l * NEXP;
    const float* pre = WSP(float, WS_PRE); float* hf = WSP(float, WS_HF); bf16* hb = TILEP(T_HB);
    const int r16 = F.lane & 15, g4 = F.lane >> 4;
    for (int blk = blockIdx.x; blk < NTOK / 128; blk += F.G) {
        if (F.tid < NEXP) cntl[F.tid] = 0;
        __syncthreads();
        for (int it = 0; it < 4; ++it) {
            const int r0 = blk * 128 + it * 32;
#pragma unroll 1
            for (int q = 0; q < 4; ++q) {
                const int lr = F.wave * 4 + q; const size_t row = (size_t)(r0 + lr);
                f32x4 v[4];
#pragma unroll
                for (int j = 0; j < 4; ++j) v[j] = *(const f32x4*)(pre + row * D + 4 * F.lane + 256 * j);
                ln_affine(v, gam, bet, F.lane);
#pragma unroll
                for (int j = 0; j < 4; ++j) { *(f32x4*)(hf + row * D + 4 * F.lane + 256 * j) = v[j];
                    v2u o; o.x = pk2(v[j].x, v[j].y); o.y = pk2(v[j].z, v[j].w);
                    *(v2u*)(hb + row * D + 4 * F.lane + 256 * j) = o; *(LAS v2u*)(T + lr * 2064 + (4 * F.lane + 256 * j) * 2) = o; }
            }
            __syncthreads();
            {
                const int mt = F.wave & 1, kq = F.wave >> 1;
                f32x4 a0 = {0.f, 0.f, 0.f, 0.f}, a1 = {0.f, 0.f, 0.f, 0.f};
#pragma unroll
                for (int ks = 0; ks < 8; ++ks) { const int k0 = 256 * kq + 32 * ks + 8 * g4;
                    const bf16x8 a = *(const LAS bf16x8*)(T + (16 * mt + r16) * 2064 + k0 * 2);
                    const bf16x8 b0 = *(const bf16x8*)(wr + (size_t)r16 * D + k0), b1 = *(const bf16x8*)(wr + (size_t)(16 + r16) * D + k0);
                    a0 = __builtin_amdgcn_mfma_f32_16x16x32_bf16(a, b0, a0, 0, 0, 0); a1 = __builtin_amdgcn_mfma_f32_16x16x32_bf16(a, b1, a1, 0, 0, 0); }
#pragma unroll
                for (int i = 0; i < 4; ++i) { part[kq * 1024 + (16 * mt + 4 * g4 + i) * 32 + r16] = a0[i]; part[kq * 1024 + (16 * mt + 4 * g4 + i) * 32 + 16 + r16] = a1[i]; }
            }
            __syncthreads();
            for (int idx = F.tid; idx < 1024; idx += NWAVES * 64) { const int rr = idx >> 5, e = idx & 31;
                logit[rr * 33 + e] = ((part[idx] + part[1024 + idx]) + (part[2048 + idx] + part[3072 + idx])) + br[e]; }
            __syncthreads();
            if (F.tid < 32) {
                const LAS float* lg = logit + F.tid * 33; float tv[4]; int ti[4];
#pragma unroll
                for (int k = 0; k < 4; ++k) { float best = -3.0e38f; int bi = 0;
                    for (int e = 0; e < NEXP; ++e) { const float x = lg[e]; bool taken = false;
#pragma unroll
                        for (int kk = 0; kk < 4; ++kk) if (kk < k && ti[kk] == e) taken = true;
                        if (!taken && x > best) { best = x; bi = e; } }
                    tv[k] = best; ti[k] = bi; }
                float ex[4], sum = 0.f;
#pragma unroll
                for (int k = 0; k < 4; ++k) { ex[k] = __expf(tv[k] - tv[0]); sum += ex[k]; }
                const float inv = 1.0f / sum;
#pragma unroll
                for (int k = 0; k < 4; ++k) { const int p = (it * 32 + F.tid) * 4 + k; sel_e[p] = ti[k]; sel_r[p] = __hip_atomic_fetch_add(cntl + ti[k], 1, __ATOMIC_RELAXED, __HIP_MEMORY_SCOPE_WORKGROUP); sel_g[p] = ex[k] * inv; }
            }
        }
        __syncthreads();
        if (F.tid < NEXP) basel[F.tid] = (int)__hip_atomic_fetch_add(F.ctl + CW_CNT + (l * NEXP + F.tid) * 16, (unsigned)cntl[F.tid], RLX_AGENT);
        __syncthreads();
        { const int p = F.tid, e = sel_e[p], slot = basel[e] + sel_r[p];
          WSP(int, WS_TOKES)[(size_t)blk * 512 + p] = (e << 16) | slot; WSP(float, WS_TOKG)[(size_t)blk * 512 + p] = sel_g[p]; }
        __syncthreads();
    }
}
__device__ __forceinline__ void pe_phase(Frame& F, int l) {
    RELANE(F);
    compute_toff(F, l);
    const LAS int* toff = (const LAS int*)(F.lds + TOFF_OFF);
    const bf16* hb = TILEP(T_HB); bf16* xp = TILEP(T_XP);
    for (int blk = blockIdx.x; blk < NTOK / 128; blk += F.G) {
        const int p0 = blk * 512 + F.wave * 64;
        const int es = WSP(int, WS_TOKES)[p0 + F.lane];
        const int rowl = toff[es >> 16] * 256 + (es & 0xffff);
        WSP(int, WS_ROWIDX)[p0 + F.lane] = rowl;
#pragma unroll 4
        for (int p = 0; p < 64; ++p) { const int row = __shfl(rowl, p); const int t = (p0 + p) >> 2;
            const v4u a = *(const v4u*)(hb + (size_t)t * D + 8 * F.lane), b = *(const v4u*)(hb + (size_t)t * D + 512 + 8 * F.lane);
            *(v4u*)(xp + (size_t)row * D + 8 * F.lane) = a; *(v4u*)(xp + (size_t)row * D + 512 + 8 * F.lane) = b; }
    }
}
__device__ __forceinline__ void ph_phase(Frame& F, const Args& A, int l) {
    RELANE(F);
    const int gw = blockIdx.x * NWAVES + F.wave, NGW = F.G * NWAVES;
    const float* gam = A.in[I_LN2_G] + l * D; const float* bet = A.in[I_LN2_B] + l * D;
    float* hf = WSP(float, WS_HF); bf16* hb = TILEP(T_HB); const bf16* ys = TILEP(T_YS);
    for (int t = gw; t < NTOK; t += NGW) {
        int ri = 0; float gk = 0.f;
        if (F.lane < 4) { ri = WSP(int, WS_ROWIDX)[(size_t)t * 4 + F.lane]; gk = WSP(float, WS_TOKG)[(size_t)t * 4 + F.lane]; }
        f32x4 v[4];
#pragma unroll
        for (int j = 0; j < 4; ++j) v[j] = *(const f32x4*)(hf + (size_t)t * D + 4 * F.lane + 256 * j) * DN_ALPHA;
#pragma unroll
        for (int k = 0; k < 4; ++k) { const int row = __shfl(ri, k); const float g = __shfl(gk, k);
#pragma unroll
            for (int j = 0; j < 4; ++j) { const v2u raw = *(const v2u*)(ys + (size_t)row * D + 4 * F.lane + 256 * j);
                v[j].x += g * __builtin_bit_cast(float, raw.x << 16); v[j].y += g * __builtin_bit_cast(float, raw.x & 0xffff0000u);
                v[j].z += g * __builtin_bit_cast(float, raw.y << 16); v[j].w += g * __builtin_bit_cast(float, raw.y & 0xffff0000u); } }
        ln_affine(v, gam, bet, F.lane);
        if (l == NLAYER - 1) {
#pragma unroll
            for (int j = 0; j < 4; ++j) *(f32x4*)(F.out + (size_t)t * D + 4 * F.lane + 256 * j) = v[j];
        } else {
#pragma unroll
            for (int j = 0; j < 4; ++j) *(f32x4*)(hf + (size_t)t * D + 4 * F.lane + 256 * j) = v[j];
            store_row_bf16(hb + (size_t)t * D, v, F.lane);
        }
    }
}

#if NAIVE_MIX
__global__ void __launch_bounds__(256) nv_mix_pre(const bf16* P, const float* lng, const float* lnb, float* Vn, float* Dp) {
    const int row = blockIdx.x * 4 + (threadIdx.x >> 6), lane = threadIdx.x & 63;
    const bf16* p = P + (size_t)row * NPROJ;
    float v[4]; float s = 0.f;
    for (int i = 0; i < 4; ++i) { v[i] = gelu_tanh(bf2f(p[1280 + 4 * lane + i])); s += v[i]; }
    const float mean = wave_sum(s) * (1.f / 256.f); float s2 = 0.f;
    for (int i = 0; i < 4; ++i) { v[i] -= mean; s2 += v[i] * v[i]; }
    const float rstd = 1.f / sqrtf(wave_sum(s2) * (1.f / 256.f) + LN_EPS);
    for (int i = 0; i < 4; ++i) Vn[(size_t)row * 256 + 4 * lane + i] = v[i] * rstd * lng[4 * lane + i] + lnb[4 * lane + i];
    const int t = row % SEQ, w = 2 << (lane >> 4), cnt = (t + 1 < w) ? t + 1 : w;
    for (int i = 0; i < 4; ++i) { const int c = 4 * lane + i; float acc = 0.f;
        for (int d = 0; d < cnt; ++d) acc += bf2f(P[(size_t)(row - d) * NPROJ + 768 + c]);
        Dp[(size_t)row * 256 + c] = acc / (float)cnt - bf2f(p[768 + c]); }
}
__global__ void __launch_bounds__(256) nv_mix_main(const bf16* P, const float* Vn, const float* Dp, const bf16* Kb, const bf16* VT, const float* conv_w, const float* pool_w, const float* pool_scale,
                                                   const float* gmlp_w, const float* gmlp_b, float* Y) {
    const int row = blockIdx.x >> 2, grp = blockIdx.x & 3, c = threadIdx.x, t = row % SEQ;
    const bf16* p = P + (size_t)row * NPROJ; float y = 0.f;
    if (grp == 0) {
        float z[3];
        for (int d = 0; d < 3; ++d) { const int tt = t - 2 + d; z[d] = (tt >= 0) ? bf2f(P[(size_t)(row - 2 + d) * NPROJ + 256 + c]) * bf2f(P[(size_t)(row - 2 + d) * NPROJ + 512 + c]) : 0.f; }
        y = bf2f(p[c]) * (conv_w[c] * z[0] + conv_w[256 + c] * z[1] + conv_w[512 + c] * z[2]);
    } else if (grp == 1) {
        const int gi = c >> 6, dd = c & 63; float acc = 0.f;
        for (int cc = 0; cc < 64; ++cc) acc += Dp[(size_t)row * 256 + gi * 64 + cc] * pool_w[(gi * 64 + cc) * 64 + dd];
        y = acc * pool_scale[c];
    } else if (grp == 2) {
        const int hh = c >> 6, i = t & 127, jmax = ((i >> 6) + 1) * 64; const size_t blk0 = (size_t)(row - i); float acc = 0.f;
        for (int j = 0; j < jmax; ++j) acc += gmlp_w[(hh * 128 + i) * 128 + j] * Vn[(blk0 + j) * 256 + c];
        y = gelu_tanh(bf2f(p[1024 + c])) * (acc + gmlp_b[hh * 128 + i]);
    } else {
        const int hh = c >> 6, lane = c & 63, b = row / SEQ;
        const float q = bf2f(p[1536 + hh * 64 + lane]);
        float sc[4] = {0.f, 0.f, 0.f, 0.f};
        for (int d = 0; d < 64; ++d) { const float qd = __shfl(q, d);
            for (int m = 0; m < 4; ++m) sc[m] += qd * bf2f(Kb[(size_t)(b * 256 + lane + 64 * m) * 256 + hh * 64 + d]); }
        float mx = -3.0e38f;
        for (int m = 0; m < 4; ++m) { sc[m] *= 0.125f; mx = fmaxf(mx, sc[m]); }
        for (int o = 1; o < 64; o <<= 1) mx = fmaxf(mx, __shfl_xor(mx, o));
        float sum = 0.f;
        for (int m = 0; m < 4; ++m) { sc[m] = __expf(sc[m] - mx); sum += sc[m]; }
        sum = wave_sum(sum);
        float o = 0.f;
        for (int m = 0; m < 4; ++m) for (int j = 0; j < 64; ++j) { const float pj = __shfl(sc[m], j); o += pj * bf2f(VT[(size_t)(hh * 64 + lane) * 4096 + b * 256 + j + 64 * m]); }
        y = o / sum;
    }
    Y[(size_t)row * 1024 + grp * 256 + c] = y;
}
__global__ void __launch_bounds__(256) nv_mix_norm(const float* Y, const float* gng, bf16* G) {
    const int wv = blockIdx.x * 4 + (threadIdx.x >> 6), lane = threadIdx.x & 63, row = wv >> 2, grp = wv & 3;
    const float* y = Y + (size_t)row * 1024 + grp * 256; float v[4], s2 = 0.f;
    for (int i = 0; i < 4; ++i) { v[i] = y[4 * lane + i]; s2 += v[i] * v[i]; }
    const float r = 1.f / sqrtf(wave_sum(s2) * (1.f / 256.f) + RMS_EPS);
    for (int i = 0; i < 4; ++i) G[(size_t)row * 1024 + grp * 256 + 4 * lane + i] = (bf16)f2bf(v[i] * r * gng[grp * 256 + 4 * lane + i]);
}
#endif

constexpr int PH_PRO = 0, PH_KV = 1, PH_L0 = 2, PH_PER_LAYER = 8, N_PHASES = PH_L0 + NLAYER * PH_PER_LAYER;
__global__ void __launch_bounds__(NWAVES * 64, 2) fwd(Args args) {
    const Args& A = args;
    extern __shared__ __attribute__((aligned(16))) unsigned char lds[];
    Frame F;
    F.lds = (LAS unsigned char*)lds;
    F.MISC = (volatile LAS unsigned*)(F.lds + MISC_OFF);
    F.tid = threadIdx.x; F.lane = F.tid & 63; F.wave = __builtin_amdgcn_readfirstlane(F.tid >> 6);
    F.G = gridDim.x; F.ws = args.ws; F.ctl = (gu32*)(args.ws + WS_CTL); F.out = args.out;
    for (int u = F.tid; u < (LDS_BYTES - LDSCTL_OFF) / 4; u += NWAVES * 64) ((LAS unsigned*)(F.lds + LDSCTL_OFF))[u] = 0u;
    __syncthreads();
#if MK_ONE_LAUNCH
    XcdBarrier bar = xcd_barrier_post((unsigned*)(F.ctl + CW_BAR), F.MISC + 8);
#define GRID_BAR() xcd_barrier(bar)
#else
#define GRID_BAR() do { } while (0)
#endif
    const int lo = args.ph_lo, hi = args.ph_hi;
#define IN(k) (lo <= (k) && (k) < hi)
#define BOTH(k) (IN(k) && IN((k) + 1))
    const pg8::Gemm gm{(const pg8::bf16_t*)F.ws, (const pg8::bf16_t*)F.ws, D};
    const int c = (int)blockIdx.x;

    if (IN(PH_PRO) && (PHMASK & 1)) { p0_prologue(F, args); if (BOTH(PH_PRO)) GRID_BAR(); }
    if (IN(PH_KV) && (PHMASK & 2)) {
        KvOrder S{F.G, c};
        pg8::EpiBf16Sel E{WSP(bf16, WS_KB), WSP(bf16, WS_VT), 256, 4096};
        pg8::gemm_phase<pg8::EpiBf16Sel, KvOrder, true, true>(F.lds + RING_OFF, gm, S, E);
        if (BOTH(PH_KV)) GRID_BAR();
    }
    for (int l = 0; l < NLAYER; ++l) {
        const int pb = PH_L0 + l * PH_PER_LAYER;
        if (IN(pb + 0) && (PHMASK & 4)) {
            DenseOrder S{NTOK / 256, NPROJ / 256, F.G, c, T_HB, T_WIN + l * (NPROJ / 256)};
            pg8::EpiBf16Sel E{WSP(bf16, WS_P), WSP(bf16, WS_P), NPROJ, NPROJ};
            pg8::gemm_phase<pg8::EpiBf16Sel, DenseOrder, true, true>(F.lds + RING_OFF, gm, S, E);
            if (BOTH(pb + 0)) GRID_BAR();
        }
        if (IN(pb + 1)) {
            if (BOTH(pb + 1)) GRID_BAR();
        }
        if (IN(pb + 2) && (PHMASK & 8)) {
            DenseOrder S{NTOK / 256, D / 256, F.G, c, T_G, T_WOUT + l * (D / 256)};
            pg8::EpiResF32 E{WSP(float, WS_HF), WSP(float, WS_PRE), DN_ALPHA};
            pg8::gemm_phase<pg8::EpiResF32, DenseOrder, true, true>(F.lds + RING_OFF, gm, S, E);
            if (BOTH(pb + 2)) GRID_BAR();
        }
        if (IN(pb + 3) && (PHMASK & 16)) { pd_phase(F, args, l); if (BOTH(pb + 3)) GRID_BAR(); }
        if (IN(pb + 4) && (PHMASK & 32)) { pe_phase(F, l); if (BOTH(pb + 4)) GRID_BAR(); }
        if (IN(pb + 5) && (PHMASK & 64)) {
            compute_toff(F, l);
            const LAS int* toff = (const LAS int*)(F.lds + TOFF_OFF);
            MoeOrder S{__builtin_amdgcn_readfirstlane(toff[NEXP]), 8, F.G, c, T_XP, T_W1 + l * NEXP * 8, toff};
            pg8::EpiSwiglu E{TILEP(T_ACT), A.in[I_B1] + (size_t)l * NEXP * 2048};
            pg8::gemm_phase<pg8::EpiSwiglu, MoeOrder, true, true>(F.lds + RING_OFF, gm, S, E);
            if (BOTH(pb + 5)) GRID_BAR();
        }
        if (IN(pb + 6) && (PHMASK & 128)) {
            compute_toff(F, l);
            const LAS int* toff = (const LAS int*)(F.lds + TOFF_OFF);
            MoeOrder S{__builtin_amdgcn_readfirstlane(toff[NEXP]), 4, F.G, c, T_ACT, T_W2 + l * NEXP * 4, toff};
            pg8::EpiDown E{TILEP(T_YS), A.in[I_B2] + (size_t)l * NEXP * 1024};
            pg8::gemm_phase<pg8::EpiDown, MoeOrder, true, true>(F.lds + RING_OFF, gm, S, E);
            if (BOTH(pb + 6)) GRID_BAR();
        }
        if (IN(pb + 7) && (PHMASK & 256)) { ph_phase(F, args, l); if (BOTH(pb + 7)) GRID_BAR(); }
    }
#undef IN
#undef BOTH
}

extern "C" void kernel_launch(void* const* d_in, const int* in_sizes, int n_in, void* d_out, int out_size, void* d_ws, size_t ws_size, hipStream_t stream) {
    static int grid = 0;
    if (grid == 0) {
        if (n_in != 27 || out_size != NTOK * D || ws_size < WS_END) { fprintf(stderr, "kernel_launch: unexpected problem (n_in %d, out %d, ws %zu < %zu)\n", n_in, out_size, ws_size, (size_t)WS_END); grid = -1; return; }
        int dev = 0, cus = 0, per_cu = 0;
        if (hipGetDevice(&dev) != hipSuccess || hipDeviceGetAttribute(&cus, hipDeviceAttributeMultiprocessorCount, dev) != hipSuccess) { grid = -1; return; }
        if (hipFuncSetAttribute((const void*)fwd, hipFuncAttributeMaxDynamicSharedMemorySize, LDS_BYTES) != hipSuccess) { fprintf(stderr, "kernel_launch: hipFuncSetAttribute failed\n"); grid = -1; return; }
        if (hipOccupancyMaxActiveBlocksPerMultiprocessor(&per_cu, (const void*)fwd, NWAVES * 64, LDS_BYTES) != hipSuccess || per_cu < 1) fprintf(stderr, "kernel_launch: occupancy query says %d\n", per_cu);
        (void)hipGetLastError();
        grid = cus;
    }
    if (grid < 0) return;
    if (hipMemsetAsync((char*)d_ws + WS_CTL, 0, CTL_ZERO_BYTES, stream) != hipSuccess) return;
    Args a{};
    for (int i = 0; i < 27; ++i) a.in[i] = (const float*)d_in[i];
    a.out = (float*)d_out; a.ws = (unsigned char*)d_ws;
#if MK_ONE_LAUNCH
    a.ph_lo = 0; a.ph_hi = N_PHASES;
    hipLaunchKernelGGL(fwd, dim3(grid), dim3(NWAVES * 64), LDS_BYTES, stream, a);
#else
    unsigned char* ws = (unsigned char*)d_ws;
    for (int p = 0; p < N_PHASES; ++p) {
        const int l = (p - PH_L0) / PH_PER_LAYER, q = (p - PH_L0) % PH_PER_LAYER;
        if (p >= PH_L0 && q == 1) {
#if NAIVE_MIX
            const float* const* in = (const float* const*)d_in;
            hipLaunchKernelGGL(nv_mix_pre, dim3(NTOK / 4), dim3(256), 0, stream, (const bf16*)(ws + WS_P), in[10] + l * 256, in[11] + l * 256, (float*)(ws + WS_NV_VN), (float*)(ws + WS_NV_DP));
            hipLaunchKernelGGL(nv_mix_main, dim3(NTOK * 4), dim3(256), 0, stream, (const bf16*)(ws + WS_P), (const float*)(ws + WS_NV_VN), (const float*)(ws + WS_NV_DP),
                               (const bf16*)(ws + WS_KB) + (size_t)l * 4096 * 256, (const bf16*)(ws + WS_VT) + (size_t)l * 256 * 4096, in[7] + l * 768, in[8] + l * 4 * 64 * 64, in[9] + l * 256,
                               in[12] + l * 4 * 128 * 128, in[13] + l * 4 * 128, (float*)(ws + WS_NV_Y));
            hipLaunchKernelGGL(nv_mix_norm, dim3(NTOK), dim3(256), 0, stream, (const float*)(ws + WS_NV_Y), in[15] + l * 1024, (bf16*)(ws + (size_t)T_G * TILE));
            continue;
#endif
        }
        a.ph_lo = p; a.ph_hi = p + 1;
        hipLaunchKernelGGL(fwd, dim3(grid), dim3(NWAVES * 64), LDS_BYTES, stream, a);
    }
#endif
}
```

```cpp
#include <hip/hip_runtime.h>
#include <cstdio>
#include <cstdint>

#ifndef MK_ONE_LAUNCH
#define MK_ONE_LAUNCH 0
#endif
#ifndef PHMASK
#define PHMASK 0xffff
#endif
#ifndef MXMASK
#define MXMASK 15
#endif
#ifndef NAIVE_MIX
#define NAIVE_MIX 0
#endif

namespace pg8 {
#define PG8_LAS __attribute__((address_space(3)))
typedef unsigned short bf16_t;
typedef short bf16x8 __attribute__((ext_vector_type(8)));
typedef float f32x4 __attribute__((ext_vector_type(4)));
typedef float f32x2 __attribute__((ext_vector_type(2)));
typedef unsigned u32x4 __attribute__((ext_vector_type(4)));
typedef unsigned u32x2 __attribute__((ext_vector_type(2)));
constexpr int BM = 256, BK = 64, HALF = 128, HTB = HALF * BK * 2  , STAGE_BYTES = 8 * HTB, NXCD = 8, WGM = 8;

__host__ __device__ __forceinline__ int lds_byte(int r, int c) { const int st = (r >> 4) * 2 + (c >> 5), rr = r & 15, cc = c & 31, ob = rr * 64 + cc * 2; return st * 1024 + (ob ^ (((ob >> 9) & 1) << 5)); }
__host__ __device__ __forceinline__ void stage_rc(int b, int& R, int& C) { const int st = b / 1024, sb = b % 1024, swz = sb ^ (((sb >> 9) & 1) << 5); R = (st >> 1) * 16 + swz / 64; C = (st & 1) * 32 + (swz % 64) / 2; }
__host__ __device__ __forceinline__ int perm32(int rho) { const int n = rho >> 4, i = rho & 15; return 8 * (i >> 2) + 4 * n + (i & 3); }

struct Unit { int pm, pn, lm, ln, a0; };
struct Gemm { const bf16_t* A; const bf16_t* Bt; int K; };

__device__ __forceinline__ void tile_of(int L, int nM, int nN, int& tm, int& tn) {
    const int nwg = nM * nN; int wgid = L; { const int q = nwg / NXCD, r = nwg % NXCD, xcd = wgid % NXCD, off = wgid / NXCD; wgid = (xcd < r ? xcd * (q + 1) : r * (q + 1) + (xcd - r) * q) + off; }
    const int nig = WGM * nN, gid = wgid / nig, fm = gid * WGM, gsz = (nM - fm) < WGM ? (nM - fm) : WGM;
    tm = fm + ((wgid % nig) % gsz); tn = (wgid % nig) / gsz;
}

__device__ __forceinline__ unsigned cvt_pk_bf16(float lo, float hi) { unsigned r; asm volatile("v_cvt_pk_bf16_f32 %0, %1, %2" : "=v"(r) : "v"(lo), "v"(hi)); return r; }


struct EpiBf16Sel {
    static constexpr bool PERM = true, AFTER_DRAIN = false;
    bf16_t* o0; bf16_t* o1; int ld0, ld1;
    __device__ __forceinline__ void operator()(const f32x4 (&acc)[2][2][4][2], const Unit& u, int wr, int wc, int fr, int fq) const {
        bf16_t* base = u.a0 == 0 ? o0 : o1; const int ldc = u.a0 == 0 ? ld0 : ld1;
        const int row0 = u.lm * BM + wr * 64 + fr, col0 = u.ln * BM + wc * 32 + 8 * fq;
#pragma unroll
        for (int ai = 0; ai < 2; ++ai)
#pragma unroll
            for (int m = 0; m < 4; ++m) { bf16_t* rowp = base + (size_t)(row0 + ai * HALF + m * 16) * ldc + col0;
#pragma unroll
                for (int bj = 0; bj < 2; ++bj) { const f32x4 v0 = acc[ai][bj][m][0], v1 = acc[ai][bj][m][1];
                    u32x4 w; w.x = cvt_pk_bf16(v0[0], v0[1]); w.y = cvt_pk_bf16(v0[2], v0[3]); w.z = cvt_pk_bf16(v1[0], v1[1]); w.w = cvt_pk_bf16(v1[2], v1[3]);
                    *(u32x4*)(rowp + bj * HALF) = w; } }
    }
};
struct EpiResF32 {
    static constexpr bool PERM = false, AFTER_DRAIN = false;
    const float* h; float* pre; float alpha;
    __device__ __forceinline__ void operator()(const f32x4 (&acc)[2][2][4][2], const Unit& u, int wr, int wc, int fr, int fq) const {
        const int row0 = u.lm * BM + wr * 64 + fr, col0 = u.ln * BM + wc * 32 + 4 * fq;
#pragma unroll
        for (int ai = 0; ai < 2; ++ai)
#pragma unroll
            for (int m = 0; m < 4; ++m) { const size_t off = (size_t)(row0 + ai * HALF + m * 16) * 1024 + col0;
#pragma unroll
                for (int bj = 0; bj < 2; ++bj)
#pragma unroll
                    for (int n = 0; n < 2; ++n) { const f32x4 hv = *(const f32x4*)(h + off + bj * HALF + n * 16); *(f32x4*)(pre + off + bj * HALF + n * 16) = hv * alpha + acc[ai][bj][m][n]; }
                asm volatile("" ::: "memory"); }
    }
};
struct EpiSwiglu {
    static constexpr bool PERM = true, AFTER_DRAIN = false;
    bf16_t* act; const float* b1;
    __device__ __forceinline__ void operator()(const f32x4 (&acc)[2][2][4][2], const Unit& u, int wr, int wc, int fr, int fq) const {
        const int row0 = u.lm * BM + wr * 64 + fr, lc0 = u.ln * HALF + wc * 32 + 8 * fq;
        const float* bb = b1 + (size_t)u.a0 * 2048 + lc0;
        const f32x4 bg0 = *(const f32x4*)(bb), bg1 = *(const f32x4*)(bb + 4), bl0 = *(const f32x4*)(bb + 1024), bl1 = *(const f32x4*)(bb + 1028);
#pragma unroll
        for (int ai = 0; ai < 2; ++ai)
#pragma unroll
            for (int m = 0; m < 4; ++m) {
                u32x4 w; unsigned* wp = (unsigned*)&w;
#pragma unroll
                for (int n = 0; n < 2; ++n) { const f32x4 g4 = acc[ai][0][m][n] + (n ? bg1 : bg0), l4 = acc[ai][1][m][n] + (n ? bl1 : bl0); float r4[4];
#pragma unroll
                    for (int j = 0; j < 4; ++j) { const float g = fminf(g4[j], 7.0f), li = fminf(fmaxf(l4[j], -7.0f), 7.0f);
                        const float sg = __builtin_amdgcn_rcpf(1.0f + __builtin_amdgcn_exp2f(g * (-1.702f * 1.4426950408889634f))); r4[j] = g * sg * (li + 1.0f); }
                    wp[2 * n] = cvt_pk_bf16(r4[0], r4[1]); wp[2 * n + 1] = cvt_pk_bf16(r4[2], r4[3]); }
                *(u32x4*)(act + (size_t)(row0 + ai * HALF + m * 16) * 1024 + lc0) = w; }
    }
};
struct EpiDown {
    static constexpr bool PERM = true, AFTER_DRAIN = false;
    bf16_t* ys; const float* b2;
    __device__ __forceinline__ void operator()(const f32x4 (&acc)[2][2][4][2], const Unit& u, int wr, int wc, int fr, int fq) const {
        const int row0 = u.lm * BM + wr * 64 + fr, col0 = u.ln * BM + wc * 32 + 8 * fq;
        f32x4 bv[2][2];
#pragma unroll
        for (int bj = 0; bj < 2; ++bj)
#pragma unroll
            for (int n = 0; n < 2; ++n) bv[bj][n] = *(const f32x4*)(b2 + (size_t)u.a0 * 1024 + col0 + bj * HALF + 4 * n);
#pragma unroll
        for (int ai = 0; ai < 2; ++ai)
#pragma unroll
            for (int m = 0; m < 4; ++m) { bf16_t* rowp = ys + (size_t)(row0 + ai * HALF + m * 16) * 1024 + col0;
#pragma unroll
                for (int bj = 0; bj < 2; ++bj) { const f32x4 v0 = acc[ai][bj][m][0] + bv[bj][0], v1 = acc[ai][bj][m][1] + bv[bj][1];
                    u32x4 w; w.x = cvt_pk_bf16(v0[0], v0[1]); w.y = cvt_pk_bf16(v0[2], v0[3]); w.z = cvt_pk_bf16(v1[0], v1[1]); w.w = cvt_pk_bf16(v1[2], v1[3]);
                    *(u32x4*)(rowp + bj * HALF) = w; } }
    }
};

template <class Epi, class Sched, bool ALIGN_EPI = false, bool SP2 = false>
__device__ __forceinline__ void gemm_phase(PG8_LAS unsigned char* lds, const Gemm g, const Sched& S, const Epi& E) {
    int tid_l = threadIdx.x; asm volatile("" : "+v"(tid_l));
    const int tid = tid_l, wid = __builtin_amdgcn_readfirstlane(tid >> 6), lane = tid & 63, wr = wid >> 2, wc = wid & 3, fr = lane & 15, fq = lane >> 4;
    const int K = g.K, nt = K / BK;
    unsigned voffA[2], voffB[2];
#pragma unroll
    for (int i = 0; i < 2; ++i) { int R, C; stage_rc(tid * 16 + i * 8192, R, C); const int Rb = Epi::PERM ? ((R & ~31) + perm32(R & 31)) : R;
        voffA[i] = (unsigned)(R * K + C) * 2u; voffB[i] = (unsigned)(Rb * K + C) * 2u; }
    const size_t kstep = (size_t)(BK * 2);
    const size_t hstep = (size_t)HALF * K * 2;
    const size_t tstep = 2 * hstep;
    const unsigned ldsw = (unsigned)wid * 1024u;
    const int aoff = lds_byte(wr * 64 + fr, fq * 8), boff = lds_byte(wc * 32 + fr, fq * 8);
#define PG8_SA(b, h) (((b) * 2 + (h)) * HTB)
#define PG8_SB(b, h) ((4 + (b) * 2 + (h)) * HTB)
#define PG8_STAGE(bufoff, gbase, voff) do { _Pragma("unroll") for (int _i = 0; _i < 2; ++_i) \
        __builtin_amdgcn_global_load_lds((const unsigned*)((const char*)(gbase) + (voff)[_i]), (PG8_LAS unsigned*)(lds + (bufoff) + ldsw + _i * 8192), 16, 0, 0); } while (0)
#define PG8_LDA(dst, b, h) do { _Pragma("unroll") for (int m = 0; m < 4; ++m) _Pragma("unroll") for (int k = 0; k < 2; ++k) dst[m][k] = *(const PG8_LAS bf16x8*)(lds + PG8_SA(b, h) + aoff + m * 2048 + k * 1024); } while (0)
#define PG8_LDB(dst, b, h) do { _Pragma("unroll") for (int n = 0; n < 2; ++n) _Pragma("unroll") for (int k = 0; k < 2; ++k) dst[n][k] = *(const PG8_LAS bf16x8*)(lds + PG8_SB(b, h) + boff + n * 2048 + k * 1024); } while (0)
#define PG8_MMA(ai, bj, At, Bt) do { __builtin_amdgcn_s_setprio(1); _Pragma("unroll") for (int m = 0; m < 4; ++m) _Pragma("unroll") for (int n = 0; n < 2; ++n) _Pragma("unroll") for (int k = 0; k < 2; ++k) \
        acc[ai][bj][m][n] = __builtin_amdgcn_mfma_f32_16x16x32_bf16(Bt[n][k], At[m][k], acc[ai][bj][m][n], 0, 0, 0); __builtin_amdgcn_s_setprio(0); } while (0)
#define PG8_WAIT_V(n) asm volatile("s_waitcnt vmcnt(" #n ")" ::: "memory")
#define PG8_WAIT_L(n) asm volatile("s_waitcnt lgkmcnt(" #n ")" ::: "memory")
#define PG8_BAR __builtin_amdgcn_s_barrier()
#define PG8_SCHED __builtin_amdgcn_sched_barrier(0)
    Unit cur, nxt; int ui = 0;
    if (!S.next(0, cur)) return;
    f32x4 acc[2][2][4][2];
#pragma unroll
    for (int a = 0; a < 2; ++a)
#pragma unroll
        for (int b = 0; b < 2; ++b)
#pragma unroll
            for (int m = 0; m < 4; ++m)
#pragma unroll
                for (int n = 0; n < 2; ++n) acc[a][b][m][n] = (f32x4){0.f, 0.f, 0.f, 0.f};
    bf16x8 At[4][2], B0[2][2], B1[2][2];
    const char* cA = (const char*)g.A + (size_t)cur.pm * tstep; const char* cB = (const char*)g.Bt + (size_t)cur.pn * tstep;
    S.a_ready(cur);
    if constexpr (SP2) {
        PG8_STAGE(PG8_SB(0, 0), cB, voffB); PG8_STAGE(PG8_SB(0, 1), cB + hstep, voffB); PG8_STAGE(PG8_SA(0, 0), cA, voffA); PG8_STAGE(PG8_SA(0, 1), cA + hstep, voffA);
        if (wr == 1) PG8_BAR;
        PG8_WAIT_V(2); PG8_BAR;
        PG8_STAGE(PG8_SB(1, 0), cB + kstep, voffB); PG8_STAGE(PG8_SA(1, 0), cA + kstep, voffA); PG8_STAGE(PG8_SB(1, 1), cB + hstep + kstep, voffB);
        PG8_WAIT_V(6); PG8_BAR;
    } else {
        PG8_STAGE(PG8_SB(0, 0), cB, voffB); PG8_STAGE(PG8_SA(0, 0), cA, voffA); PG8_STAGE(PG8_SB(0, 1), cB + hstep, voffB); PG8_STAGE(PG8_SA(0, 1), cA + hstep, voffA);
        if (wr == 1) PG8_BAR;
        PG8_WAIT_V(4); PG8_BAR;
        PG8_STAGE(PG8_SB(1, 0), cB + kstep, voffB); PG8_STAGE(PG8_SA(1, 0), cA + kstep, voffA); PG8_STAGE(PG8_SB(1, 1), cB + hstep + kstep, voffB);
        PG8_WAIT_V(6); PG8_BAR;
    }
    for (;;) {
        const bool has_next = S.next(ui + 1, nxt);
        const char* nA = has_next ? (const char*)g.A + (size_t)nxt.pm * tstep : cA; const char* nB = has_next ? (const char*)g.Bt + (size_t)nxt.pn * tstep : cB;
        for (int t = 0; t < nt; t += 2) {
            const bool last = (t == nt - 2);
            const char* a1 = cA + (size_t)(t + 1) * kstep;
            const char* a2 = last ? nA : cA + (size_t)(t + 2) * kstep; const char* b2 = last ? nB : cB + (size_t)(t + 2) * kstep;
            const char* a3 = a2 + kstep; const char* b3 = b2 + kstep;
            if (last && has_next) S.a_ready(nxt);
            if constexpr (SP2) {
            PG8_LDB(B0, 0, 0); PG8_LDB(B1, 0, 1); PG8_SCHED; PG8_LDA(At, 0, 0); PG8_STAGE(PG8_SA(1, 1), a1 + hstep, voffA);
            PG8_WAIT_V(8); PG8_WAIT_L(0); PG8_BAR; PG8_MMA(0, 0, At, B0); PG8_MMA(0, 1, At, B1); PG8_BAR; PG8_SCHED;
            PG8_LDA(At, 0, 1); PG8_STAGE(PG8_SB(0, 0), b2, voffB); PG8_STAGE(PG8_SB(0, 1), b2 + hstep, voffB); PG8_STAGE(PG8_SA(0, 0), a2, voffA);
            PG8_WAIT_V(8); PG8_WAIT_L(0); PG8_BAR; PG8_MMA(1, 0, At, B0); PG8_MMA(1, 1, At, B1); PG8_BAR; PG8_SCHED;
            PG8_LDB(B0, 1, 0); PG8_LDB(B1, 1, 1); PG8_SCHED; PG8_LDA(At, 1, 0); PG8_STAGE(PG8_SA(0, 1), a2 + hstep, voffA);
            PG8_WAIT_V(8); PG8_WAIT_L(0); PG8_BAR; PG8_MMA(0, 0, At, B0); PG8_MMA(0, 1, At, B1); PG8_BAR; PG8_SCHED;
            PG8_LDA(At, 1, 1); PG8_STAGE(PG8_SB(1, 0), b3, voffB); PG8_STAGE(PG8_SB(1, 1), b3 + hstep, voffB); PG8_STAGE(PG8_SA(1, 0), a3, voffA);
            PG8_WAIT_V(8); PG8_WAIT_L(0); PG8_BAR; PG8_MMA(1, 0, At, B0); PG8_MMA(1, 1, At, B1); PG8_BAR; PG8_SCHED;
            } else {
            PG8_LDB(B0, 0, 0); PG8_SCHED; PG8_LDA(At, 0, 0); PG8_STAGE(PG8_SA(1, 1), a1 + hstep, voffA);
            PG8_WAIT_L(8); PG8_BAR; PG8_WAIT_L(0); PG8_MMA(0, 0, At, B0); PG8_BAR; PG8_SCHED;
            PG8_LDB(B1, 0, 1); PG8_STAGE(PG8_SB(0, 0), b2, voffB);
            PG8_BAR; PG8_WAIT_L(0); PG8_MMA(0, 1, At, B1); PG8_BAR;
            PG8_LDA(At, 0, 1); PG8_STAGE(PG8_SA(0, 0), a2, voffA);
            PG8_BAR; PG8_WAIT_L(0); PG8_MMA(1, 0, At, B0); PG8_BAR; PG8_SCHED;
            PG8_STAGE(PG8_SB(0, 1), b2 + hstep, voffB);
            PG8_WAIT_V(6); PG8_BAR; PG8_MMA(1, 1, At, B1); PG8_BAR;
            PG8_LDB(B0, 1, 0); PG8_SCHED; PG8_LDA(At, 1, 0); PG8_STAGE(PG8_SA(0, 1), a2 + hstep, voffA);
            PG8_WAIT_L(8); PG8_BAR; PG8_WAIT_L(0); PG8_MMA(0, 0, At, B0); PG8_BAR; PG8_SCHED;
            PG8_LDB(B1, 1, 1); PG8_STAGE(PG8_SB(1, 0), b3, voffB);
            PG8_BAR; PG8_WAIT_L(0); PG8_MMA(0, 1, At, B1); PG8_BAR;
            PG8_LDA(At, 1, 1); PG8_STAGE(PG8_SA(1, 0), a3, voffA);
            PG8_BAR; PG8_WAIT_L(0); PG8_MMA(1, 0, At, B0); PG8_BAR; PG8_SCHED;
            PG8_STAGE(PG8_SB(1, 1), b3 + hstep, voffB);
            PG8_WAIT_V(6); PG8_BAR; PG8_MMA(1, 1, At, B1); PG8_BAR;
            }
        }
        if constexpr (ALIGN_EPI) { if (wr == 0) PG8_BAR; }
        if constexpr (!Epi::AFTER_DRAIN) { E(acc, cur, wr, wc, fr, fq); S.done(cur); }
        if (!has_next) break;
#pragma unroll
        for (int a = 0; a < 2; ++a)
#pragma unroll
            for (int b = 0; b < 2; ++b)
#pragma unroll
                for (int m = 0; m < 4; ++m)
#pragma unroll
                    for (int n = 0; n < 2; ++n) acc[a][b][m][n] = (f32x4){0.f, 0.f, 0.f, 0.f};
        cur = nxt; cA = nA; cB = nB; ++ui;
        if constexpr (ALIGN_EPI) { if (wr == 1) PG8_BAR; }
    }
    PG8_WAIT_V(0);
    if constexpr (!ALIGN_EPI) { if (wr == 0) PG8_BAR; }
    PG8_BAR;
    if constexpr (Epi::AFTER_DRAIN) { E.fused(acc, cur, wr, wc, fr, fq, lds, wid, lane); S.done(cur); }
#undef PG8_SA
#undef PG8_SB
#undef PG8_STAGE
#undef PG8_LDA
#undef PG8_LDB
#undef PG8_MMA
#undef PG8_WAIT_V
#undef PG8_WAIT_L
#undef PG8_BAR
#undef PG8_SCHED
}
}

#define GAS __attribute__((address_space(1)))
#define LAS __attribute__((address_space(3)))
typedef unsigned short bf16;
typedef unsigned v4u __attribute__((ext_vector_type(4)));
typedef unsigned v2u __attribute__((ext_vector_type(2)));
typedef float f32x4 __attribute__((ext_vector_type(4)));
typedef short bf16x8 __attribute__((ext_vector_type(8)));
typedef GAS unsigned gu32;
typedef GAS unsigned long long gu64;
#define RLX_AGENT __ATOMIC_RELAXED, __HIP_MEMORY_SCOPE_AGENT
#define LDS_WAIT() asm volatile("s_waitcnt lgkmcnt(0)" ::: "memory")
#define VM_WAIT() asm volatile("s_waitcnt vmcnt(0)" ::: "memory")
__device__ __forceinline__ unsigned long long rt() { return __builtin_amdgcn_s_memrealtime(); }
__device__ __forceinline__ unsigned f2bf(float f) { unsigned u = __builtin_bit_cast(unsigned, f); return (u + 0x7fffu + ((u >> 16) & 1u)) >> 16; }
__device__ __forceinline__ unsigned pk2(float lo, float hi) { return f2bf(lo) | (f2bf(hi) << 16); }

#define XB_TMO      128
#define XB_XCNT(j)  (256  + 64 * (j))
#define XB_XSUB(j)  (1280 + 64 * (j))
#define XB_XGEN(j)  (2304 + 64 * (j))
#define XB_TOP      3328
#define XB_TOPGEN   3392
#define XCD_BAR_WORDS 3456
#define XB_SPIN_CAP (1u << 18)

__device__ __forceinline__ unsigned xb_ld(unsigned* p)              { return __hip_atomic_load(p, __ATOMIC_RELAXED, __HIP_MEMORY_SCOPE_AGENT); }
__device__ __forceinline__ unsigned xb_add(unsigned* p, unsigned v) { return __hip_atomic_fetch_add(p, v, __ATOMIC_RELAXED, __HIP_MEMORY_SCOPE_AGENT); }
__device__ __forceinline__ unsigned xb_xcc_id() { return (unsigned)__builtin_amdgcn_s_getreg((3 << 11) | 20) & 0xFu; }
#define XB_SPIN(cond, bar) do { unsigned _sp = 0; while (cond) { __builtin_amdgcn_s_sleep(1); \
    if ((++_sp & 255u) == 0u) { if (xb_ld(&(bar)[XB_TMO])) break; if (_sp > XB_SPIN_CAP) { atomicAdd(&(bar)[XB_TMO], 1u); break; } } } } while (0)

struct XcdBarrier {
    unsigned* bar; unsigned x;
    volatile LAS unsigned* st;
};

__device__ __forceinline__ XcdBarrier xcd_barrier_post(unsigned* bar, volatile LAS unsigned* st) {
    XcdBarrier b; b.bar = bar; b.x = xb_xcc_id(); b.st = st;
    if (threadIdx.x == 0) (void)xb_add(&bar[XB_XCNT(b.x)], 1u);
    return b;
}
__device__ __forceinline__ void xcd_barrier_complete(unsigned* bar, unsigned x, unsigned& nloc, unsigned& nx) {
    const unsigned G = gridDim.x * gridDim.y * gridDim.z;
    unsigned sum, cnt, mine, sp = 0u;
    for (;;) {
        sum = 0u; cnt = 0u; mine = 0u;
#pragma unroll
        for (unsigned j = 0; j < 16; ++j) { const unsigned c = xb_ld(&bar[XB_XCNT(j)]); sum += c; cnt += (c > 0u) ? 1u : 0u; mine = (j == x) ? c : mine; }
        if (sum == G) break;
        __builtin_amdgcn_s_sleep(1);
        if ((++sp & 255u) == 0u) { if (xb_ld(&bar[XB_TMO])) break; if (sp > XB_SPIN_CAP) { atomicAdd(&bar[XB_TMO], 1u); break; } }
    }
    nloc = mine > 0u ? mine : 1u; nx = cnt > 0u ? cnt : 1u;
}

__device__ __forceinline__ void xcd_barrier(const XcdBarrier& b) {
    asm volatile("s_waitcnt vmcnt(0)" ::: "memory");
    __syncthreads();
    if (threadIdx.x == 0) {
        unsigned* bar = b.bar;
        __builtin_amdgcn_s_waitcnt(0);
        unsigned nloc = b.st[0], nx = b.st[1];
        if (nloc == 0u) { xcd_barrier_complete(bar, b.x, nloc, nx); b.st[0] = nloc; b.st[1] = nx; }
        const unsigned old = xb_add(&bar[XB_XSUB(b.x)], 1u);
        const unsigned gen = old / nloc;
        if (old + 1u == (gen + 1u) * nloc) {
            __builtin_amdgcn_fence(__ATOMIC_RELEASE, "agent");
            asm volatile("s_waitcnt vmcnt(0)" ::: "memory");
            const unsigned og = xb_add(&bar[XB_TOP], 1u);
            const unsigned tg = og / nx;
            if (og + 1u == (tg + 1u) * nx) xb_add(&bar[XB_TOPGEN], 1u);
            else XB_SPIN(xb_ld(&bar[XB_TOPGEN]) == tg, bar);
            __builtin_amdgcn_fence(__ATOMIC_ACQUIRE, "agent");
            xb_add(&bar[XB_XGEN(b.x)], 1u);
            asm volatile("s_waitcnt vmcnt(0)" ::: "memory");
        } else {
            XB_SPIN(xb_ld(&bar[XB_XGEN(b.x)]) == gen, bar);
            __builtin_amdgcn_fence(__ATOMIC_ACQUIRE, "agent");
            asm volatile("s_waitcnt vmcnt(0)" ::: "memory");
        }
    }
    __syncthreads();
}


constexpr int NWAVES = 8;
constexpr int NTOK = 32768, D = 1024, NPROJ = 1792, NLAYER = 4, NEXP = 32, SEQ = 2048, NBATCH = 16, NMEM = 256;
constexpr float LN_EPS = 1e-5f, RMS_EPS = 1e-6f;
constexpr float DN_ALPHA = 1.6817928305074292f;
constexpr int XP_TILES = NTOK * 4 / 256 + NEXP;

constexpr size_t MiB = 1u << 20, TILE = 512 * 1024;
constexpr size_t WS_CTL = 0, CTL_ZERO_BYTES = 1 * MiB;
constexpr size_t WS_WMB = 1 * MiB;
constexpr size_t WS_POOLT = WS_WMB + 512 * 1024;
constexpr size_t WS_WRT = WS_POOLT + 128 * 1024;
constexpr int T_WIN = 4, T_WOUT = T_WIN + 28, T_WKV = T_WOUT + 16, T_MEMN = T_WKV + 8, T_W1 = T_MEMN + 16, T_W2 = T_W1 + 1024, T_HB = T_W2 + 512, T_G = T_HB + 128,
              T_XP = T_G + 128, T_ACT = T_XP + XP_TILES, T_YS = T_ACT + XP_TILES, T_END = T_YS + XP_TILES;
constexpr size_t WS_P = (size_t)T_END * TILE;
constexpr size_t WS_HF = WS_P + 112 * MiB;
constexpr size_t WS_PRE = WS_HF + 128 * MiB;
constexpr size_t WS_KB = WS_PRE + 128 * MiB;
constexpr size_t WS_VT = WS_KB + 8 * MiB;
constexpr size_t WS_TOKES = WS_VT + 8 * MiB;
constexpr size_t WS_TOKG = WS_TOKES + 512 * 1024;
constexpr size_t WS_ROWIDX = WS_TOKG + 512 * 1024;
constexpr size_t WS_NV_VN = WS_ROWIDX + 512 * 1024;
constexpr size_t WS_NV_DP = WS_NV_VN + 32 * MiB;
constexpr size_t WS_NV_Y = WS_NV_DP + 32 * MiB;
constexpr size_t WS_END = WS_NV_Y + 128 * MiB;
constexpr int CW_TMO = 0, CW_CODE = 1;
constexpr int CW_BAR = 4096;
constexpr int CW_CNT = 16384;
static_assert((CW_CNT + NLAYER * NEXP * 16) * 4 <= (int)CTL_ZERO_BYTES, "CTL words inside the memset region");
constexpr int RING_OFF = 0, RING_BYTES = 131072;
constexpr int LDSCTL_OFF = 147456 - 1024, MISC_OFF = LDSCTL_OFF + 320, TOFF_OFF = MISC_OFF + 128;
constexpr int LDS_BYTES = 147456;
static_assert(TOFF_OFF + 160 <= LDS_BYTES, "LDS map");

__device__ __forceinline__ float bf2f(unsigned short b) { return __builtin_bit_cast(float, (unsigned)b << 16); }
__device__ __forceinline__ float wave_sum(float v) {
#pragma unroll
    for (int o = 1; o < 64; o <<= 1) v += __shfl_xor(v, o);
    return v;
}
__device__ __forceinline__ float gelu_tanh(float x) {
    const float u = 0.7978845608028654f * (x + 0.044715f * x * x * x);
    return x * __builtin_amdgcn_rcpf(1.0f + __builtin_amdgcn_exp2f(u * (-2.0f * 1.4426950408889634f)));
}

struct Frame {
    LAS unsigned char* lds;
    volatile LAS unsigned* MISC;
    gu32* ctl;
    unsigned char* ws;
    int tid, lane, wave, G;
    float* out;
};
struct Args { const float* in[27]; float* out; unsigned char* ws; int ph_lo, ph_hi; };
enum { I_X = 0, I_MEM, I_LN_IN_G, I_LN_IN_B, I_MEM_LN_G, I_MEM_LN_B, I_W_IN, I_CONV_W, I_POOL_W, I_POOL_SCALE, I_GMLP_LN_G, I_GMLP_LN_B, I_GMLP_W, I_GMLP_B, I_W_MEM_KV, I_GROUP_NORM_G, I_W_OUT,
       I_LN1_G, I_LN1_B, I_W_ROUTER, I_B_ROUTER, I_W1, I_B1, I_W2, I_B2, I_LN2_G, I_LN2_B };
#define RELANE(F) do { int t_ = threadIdx.x; asm volatile("" : "+v"(t_)); (F).tid = t_; (F).lane = t_ & 63; (F).wave = __builtin_amdgcn_readfirstlane(t_ >> 6); } while (0)
#define WSP(T, off) ((T*)(F.ws + (off)))
#define TILEP(t) ((bf16*)(F.ws + (size_t)(t) * TILE))

__device__ __forceinline__ void tr64(const float* W, int ldw, int k0, int n0, bf16* WT, int ldt, int drow0, LAS float* scr, int lane) {
    const int c4 = 4 * (lane & 15), kq = lane >> 4;
#pragma unroll
    for (int i = 0; i < 16; ++i) { const int kk = 4 * i + kq; const f32x4 v = *(const f32x4*)(W + (size_t)(k0 + kk) * ldw + n0 + c4);
        LAS float* s = scr + kk * 65 + c4; s[0] = v.x; s[1] = v.y; s[2] = v.z; s[3] = v.w; }
    LDS_WAIT(); asm volatile("" ::: "memory");
    const int ck = lane & 7;
#pragma unroll
    for (int j = 0; j < 8; ++j) { const int n = (lane >> 3) + 8 * j; const LAS float* s = scr + (8 * ck) * 65 + n;
        v4u o; o.x = pk2(s[0 * 65], s[1 * 65]); o.y = pk2(s[2 * 65], s[3 * 65]); o.z = pk2(s[4 * 65], s[5 * 65]); o.w = pk2(s[6 * 65], s[7 * 65]);
        *(v4u*)(WT + (size_t)(drow0 + n) * ldt + k0 + 8 * ck) = o; }
    LDS_WAIT(); asm volatile("" ::: "memory");
}
__device__ __forceinline__ void ln_affine(f32x4 (&v)[4], const float* gam, const float* bet, int lane) {
    float s = 0.f;
#pragma unroll
    for (int j = 0; j < 4; ++j) s += (v[j].x + v[j].y) + (v[j].z + v[j].w);
    const float mean = wave_sum(s) * (1.f / 1024.f); float s2 = 0.f;
#pragma unroll
    for (int j = 0; j < 4; ++j) { v[j] = v[j] - mean; s2 += (v[j].x * v[j].x + v[j].y * v[j].y) + (v[j].z * v[j].z + v[j].w * v[j].w); }
    const float rstd = 1.f / sqrtf(wave_sum(s2) * (1.f / 1024.f) + LN_EPS);
#pragma unroll
    for (int j = 0; j < 4; ++j) { const f32x4 g = *(const f32x4*)(gam + 4 * lane + 256 * j), b = *(const f32x4*)(bet + 4 * lane + 256 * j); v[j] = v[j] * rstd * g + b; }
}
__device__ __forceinline__ void store_row_bf16(bf16* orow, const f32x4 (&v)[4], int lane) {
#pragma unroll
    for (int j = 0; j < 4; ++j) { v2u o; o.x = pk2(v[j].x, v[j].y); o.y = pk2(v[j].z, v[j].w); *(v2u*)(orow + 4 * lane + 256 * j) = o; }
}
__device__ __forceinline__ void p0_prologue(Frame& F, const Args& A) {
    RELANE(F);
    LAS float* scr = (LAS float*)(F.lds + RING_OFF + F.wave * 16640);
    const int gw = blockIdx.x * NWAVES + F.wave, NGW = F.G * NWAVES;
    constexpr int NI_W1 = NLAYER * NEXP * 16 * 32, NI_W2 = NLAYER * NEXP * 16 * 16, NI_WIN = NLAYER * 16 * 28, NI_WOUT = NLAYER * 16 * 16, NI_WKV = NLAYER * 16 * 8, NI_POOL = NLAYER * 4;
    constexpr int NITEMS = NI_W1 + NI_W2 + NI_WIN + NI_WOUT + NI_WKV + NI_POOL;
    for (int it = gw; it < NITEMS; it += NGW) {
        int r = it;
        if (r < NI_W1) { const int le = r >> 9, rr = r & 511, kb = rr >> 5, nb = rr & 31; const int n0 = 64 * nb, nn = n0 & 1023;
            const int drow = (nn >> 7) * 256 + (n0 >= 1024 ? 128 : 0) + (nn & 127);
            tr64(A.in[I_W1] + (size_t)le * 1024 * 2048, 2048, 64 * kb, n0, TILEP(T_W1) + (size_t)le * 2048 * 1024, 1024, drow, scr, F.lane); continue; } r -= NI_W1;
        if (r < NI_W2) { const int le = r >> 8, rr = r & 255, kb = rr >> 4, nb = rr & 15;
            tr64(A.in[I_W2] + (size_t)le * 1024 * 1024, 1024, 64 * kb, 64 * nb, TILEP(T_W2) + (size_t)le * 1024 * 1024, 1024, 64 * nb, scr, F.lane); continue; } r -= NI_W2;
        if (r < NI_WIN) { const int l = r / 448, rr = r % 448, kb = rr / 28, nb = rr % 28;
            tr64(A.in[I_W_IN] + (size_t)l * 1024 * NPROJ, NPROJ, 64 * kb, 64 * nb, TILEP(T_WIN) + (size_t)l * NPROJ * 1024, 1024, 64 * nb, scr, F.lane); continue; } r -= NI_WIN;
        if (r < NI_WOUT) { const int l = r >> 8, rr = r & 255, kb = rr >> 4, nb = rr & 15;
            tr64(A.in[I_W_OUT] + (size_t)l * 1024 * 1024, 1024, 64 * kb, 64 * nb, TILEP(T_WOUT) + (size_t)l * 1024 * 1024, 1024, 64 * nb, scr, F.lane); continue; } r -= NI_WOUT;
        if (r < NI_WKV) { const int l = r >> 7, rr = r & 127, kb = rr >> 3, nb = rr & 7;
            tr64(A.in[I_W_MEM_KV] + (size_t)l * 1024 * 512, 512, 64 * kb, 64 * nb, TILEP(T_WKV) + (size_t)l * 512 * 1024, 1024, 64 * nb, scr, F.lane); continue; } r -= NI_WKV;
        tr64(A.in[I_POOL_W] + (size_t)r * 64 * 64, 64, 0, 0, WSP(bf16, WS_POOLT) + (size_t)r * 64 * 64, 64, 0, scr, F.lane);
    }
    const int gt = blockIdx.x * (NWAVES * 64) + F.tid, NGT = F.G * NWAVES * 64;
    for (int i = gt; i < NLAYER * 4 * 128 * 128; i += NGT) { const int j = i & 127, ii = (i >> 7) & 127; WSP(bf16, WS_WMB)[i] = (bf16)(((j >> 6) <= (ii >> 6)) ? f2bf(A.in[I_GMLP_W][i]) : 0u); }
    for (int i = gt; i < NLAYER * 32 * 1024; i += NGT) { const int k = i & 1023, e = (i >> 10) & 31, l = i >> 15; WSP(bf16, WS_WRT)[i] = (bf16)f2bf(A.in[I_W_ROUTER][((size_t)l * 1024 + k) * 32 + e]); }
    for (int m = gw; m < NTOK + NBATCH * NMEM; m += NGW) {
        const bool ismem = m >= NTOK; const int row = ismem ? m - NTOK : m;
        const float* src = (ismem ? A.in[I_MEM] : A.in[I_X]) + (size_t)row * D;
        f32x4 v[4];
#pragma unroll
        for (int j = 0; j < 4; ++j) v[j] = *(const f32x4*)(src + 4 * F.lane + 256 * j);
        ln_affine(v, ismem ? A.in[I_MEM_LN_G] : A.in[I_LN_IN_G], ismem ? A.in[I_MEM_LN_B] : A.in[I_LN_IN_B], F.lane);
        if (!ismem) {
            float* hf = WSP(float, WS_HF) + (size_t)row * D;
#pragma unroll
            for (int j = 0; j < 4; ++j) *(f32x4*)(hf + 4 * F.lane + 256 * j) = v[j];
        }
        store_row_bf16((ismem ? TILEP(T_MEMN) : TILEP(T_HB)) + (size_t)row * D, v, F.lane);
    }
}

struct DenseOrder {
    int nM, nN, G, c, a_t0, b_t0;
    __device__ __forceinline__ bool next(int i, pg8::Unit& u) const {
        const long L = (long)i * G + c; if (L >= (long)nM * nN) return false;
        int tm, tn; pg8::tile_of((int)L, nM, nN, tm, tn); u.pm = a_t0 + tm; u.pn = b_t0 + tn; u.lm = tm; u.ln = tn; u.a0 = 0; return true;
    }
    __device__ __forceinline__ void a_ready(const pg8::Unit&) const {}
    __device__ __forceinline__ void done(const pg8::Unit&) const {}
};
struct KvOrder {
    int G, c;
    __device__ __forceinline__ bool next(int i, pg8::Unit& u) const {
        const int L = i * G + c; if (L >= NLAYER * 32) return false;
        const int l = L >> 5, r = L & 31;
        if (r < 16) { u.pm = T_MEMN + r; u.pn = T_WKV + 2 * l; u.lm = l * 16 + r; u.ln = 0; u.a0 = 0; }
        else { u.pm = T_WKV + 2 * l + 1; u.pn = T_MEMN + (r - 16); u.lm = l; u.ln = r - 16; u.a0 = 1; }
        return true;
    }
    __device__ __forceinline__ void a_ready(const pg8::Unit&) const {}
    __device__ __forceinline__ void done(const pg8::Unit&) const {}
};
struct MoeOrder {
    int TM, NTN, G, c, a_t0, b_t0; const LAS int* toff;
    __device__ __forceinline__ bool next(int i, pg8::Unit& u) const {
        const long L = (long)i * G + c; if (L >= (long)TM * NTN) return false;
        int tm, tn; pg8::tile_of((int)L, TM, NTN, tm, tn);
        int e = 0;
#pragma unroll
        for (int j = 1; j < NEXP; ++j) e += (toff[j] <= tm) ? 1 : 0;
        e = __builtin_amdgcn_readfirstlane(e);
        u.pm = a_t0 + tm; u.pn = b_t0 + e * NTN + tn; u.lm = tm; u.ln = tn; u.a0 = e; return true;
    }
    __device__ __forceinline__ void a_ready(const pg8::Unit&) const {}
    __device__ __forceinline__ void done(const pg8::Unit&) const {}
};
__device__ __forceinline__ void compute_toff(Frame& F, int l) {
    RELANE(F);
    LAS int* toff = (LAS int*)(F.lds + TOFF_OFF);
    __syncthreads();
    if (F.wave == 0) {
        int t = 0;
        if (F.lane < NEXP) { const unsigned c = __hip_atomic_load(F.ctl + CW_CNT + (l * NEXP + F.lane) * 16, RLX_AGENT); t = (int)((c + 255u) >> 8); }
        int incl = t;
#pragma unroll
        for (int o = 1; o < 32; o <<= 1) { const int y = __shfl_up(incl, o); if ((F.lane & 31) >= o) incl += y; }
        if (F.lane < NEXP) toff[F.lane + 1] = incl;
        if (F.lane == 0) toff[0] = 0;
    }
    __syncthreads();
}

__device__ __forceinline__ void pd_phase(Frame& F, const Args& A, int l) {
    RELANE(F);
    LAS unsigned char* T = F.lds;
    LAS float* part = (LAS float*)(F.lds + 66048);
    LAS float* logit = (LAS float*)(F.lds + 82432);
    LAS int* cntl = (LAS int*)(F.lds + 86656);
    LAS int* basel = (LAS int*)(F.lds + 86784);
    LAS int* sel_e = (LAS int*)(F.lds + 86912);
    LAS int* sel_r = sel_e + 512; LAS float* sel_g = (LAS float*)(sel_r + 512);
    const float* gam = A.in[I_LN1_G] + l * D; const float* bet = A.in[I_LN1_B] + l * D;
    const bf16* wr = WSP(bf16, WS_WRT) + (size_t)l * NEXP * D; const float* br = A.in[I_B_ROUTER] + l * NEXP;
    const float* pre = WSP(float, WS_PRE); float* hf = WSP(float, WS_HF); bf16* hb = TILEP(T_HB);
    const int r16 = F.lane & 15, g4 = F.lane >> 4;
    for (int blk = blockIdx.x; blk < NTOK / 128; blk += F.G) {
        if (F.tid < NEXP) cntl[F.tid] = 0;
        __syncthreads();
        for (int it = 0; it < 4; ++it) {
            const int r0 = blk * 128 + it * 32;
#pragma unroll 1
            for (int q = 0; q < 4; ++q) {
                const int lr = F.wave * 4 + q; const size_t row = (size_t)(r0 + lr);
                f32x4 v[4];
#pragma unroll
                for (int j = 0; j < 4; ++j) v[j] = *(const f32x4*)(pre + row * D + 4 * F.lane + 256 * j);
                ln_affine(v, gam, bet, F.lane);
#pragma unroll
                for (int j = 0; j < 4; ++j) { *(f32x4*)(hf + row * D + 4 * F.lane + 256 * j) = v[j];
                    v2u o; o.x = pk2(v[j].x, v[j].y); o.y = pk2(v[j].z, v[j].w);
                    *(v2u*)(hb + row * D + 4 * F.lane + 256 * j) = o; *(LAS v2u*)(T + lr * 2064 + (4 * F.lane + 256 * j) * 2) = o; }
            }
            __syncthreads();
            {
                const int mt = F.wave & 1, kq = F.wave >> 1;
                f32x4 a0 = {0.f, 0.f, 0.f, 0.f}, a1 = {0.f, 0.f, 0.f, 0.f};
#pragma unroll
                for (int ks = 0; ks < 8; ++ks) { const int k0 = 256 * kq + 32 * ks + 8 * g4;
                    const bf16x8 a = *(const LAS bf16x8*)(T + (16 * mt + r16) * 2064 + k0 * 2);
                    const bf16x8 b0 = *(const bf16x8*)(wr + (size_t)r16 * D + k0), b1 = *(const bf16x8*)(wr + (size_t)(16 + r16) * D + k0);
                    a0 = __builtin_amdgcn_mfma_f32_16x16x32_bf16(a, b0, a0, 0, 0, 0); a1 = __builtin_amdgcn_mfma_f32_16x16x32_bf16(a, b1, a1, 0, 0, 0); }
#pragma unroll
                for (int i = 0; i < 4; ++i) { part[kq * 1024 + (16 * mt + 4 * g4 + i) * 32 + r16] = a0[i]; part[kq * 1024 + (16 * mt + 4 * g4 + i) * 32 + 16 + r16] = a1[i]; }
            }
            __syncthreads();
            for (int idx = F.tid; idx < 1024; idx += NWAVES * 64) { const int rr = idx >> 5, e = idx & 31;
                logit[rr * 33 + e] = ((part[idx] + part[1024 + idx]) + (part[2048 + idx] + part[3072 + idx])) + br[e]; }
            __syncthreads();
            if (F.tid < 32) {
                const LAS float* lg = logit + F.tid * 33; float tv[4]; int ti[4];
#pragma unroll
                for (int k = 0; k < 4; ++k) { float best = -3.0e38f; int bi = 0;
                    for (int e = 0; e < NEXP; ++e) { const float x = lg[e]; bool taken = false;
#pragma unroll
                        for (int kk = 0; kk < 4; ++kk) if (kk < k && ti[kk] == e) taken = true;
                        if (!taken && x > best) { best = x; bi = e; } }
                    tv[k] = best; ti[k] = bi; }
                float ex[4], sum = 0.f;
#pragma unroll
                for (int k = 0; k < 4; ++k) { ex[k] = __expf(tv[k] - tv[0]); sum += ex[k]; }
                const float inv = 1.0f / sum;
#pragma unroll
                for (int k = 0; k < 4; ++k) { const int p = (it * 32 + F.tid) * 4 + k; sel_e[p] = ti[k]; sel_r[p] = __hip_atomic_fetch_add(cntl + ti[k], 1, __ATOMIC_RELAXED, __HIP_MEMORY_SCOPE_WORKGROUP); sel_g[p] = ex[k] * inv; }
            }
        }
        __syncthreads();
        if (F.tid < NEXP) basel[F.tid] = (int)__hip_atomic_fetch_add(F.ctl + CW_CNT + (l * NEXP + F.tid) * 16, (unsigned)cntl[F.tid], RLX_AGENT);
        __syncthreads();
        { const int p = F.tid, e = sel_e[p], slot = basel[e] + sel_r[p];
          WSP(int, WS_TOKES)[(size_t)blk * 512 + p] = (e << 16) | slot; WSP(float, WS_TOKG)[(size_t)blk * 512 + p] = sel_g[p]; }
        __syncthreads();
    }
}
__device__ __forceinline__ void pe_phase(Frame& F, int l) {
    RELANE(F);
    compute_toff(F, l);
    const LAS int* toff = (const LAS int*)(F.lds + TOFF_OFF);
    const bf16* hb = TILEP(T_HB); bf16* xp = TILEP(T_XP);
    for (int blk = blockIdx.x; blk < NTOK / 128; blk += F.G) {
        const int p0 = blk * 512 + F.wave * 64;
        const int es = WSP(int, WS_TOKES)[p0 + F.lane];
        const int rowl = toff[es >> 16] * 256 + (es & 0xffff);
        WSP(int, WS_ROWIDX)[p0 + F.lane] = rowl;
#pragma unroll 4
        for (int p = 0; p < 64; ++p) { const int row = __shfl(rowl, p); const int t = (p0 + p) >> 2;
            const v4u a = *(const v4u*)(hb + (size_t)t * D + 8 * F.lane), b = *(const v4u*)(hb + (size_t)t * D + 512 + 8 * F.lane);
            *(v4u*)(xp + (size_t)row * D + 8 * F.lane) = a; *(v4u*)(xp + (size_t)row * D + 512 + 8 * F.lane) = b; }
    }
}
__device__ __forceinline__ void ph_phase(Frame& F, const Args& A, int l) {
    RELANE(F);
    const int gw = blockIdx.x * NWAVES + F.wave, NGW = F.G * NWAVES;
    const float* gam = A.in[I_LN2_G] + l * D; const float* bet = A.in[I_LN2_B] + l * D;
    float* hf = WSP(float, WS_HF); bf16* hb = TILEP(T_HB); const bf16* ys = TILEP(T_YS);
    for (int t = gw; t < NTOK; t += NGW) {
        int ri = 0; float gk = 0.f;
        if (F.lane < 4) { ri = WSP(int, WS_ROWIDX)[(size_t)t * 4 + F.lane]; gk = WSP(float, WS_TOKG)[(size_t)t * 4 + F.lane]; }
        f32x4 v[4];
#pragma unroll
        for (int j = 0; j < 4; ++j) v[j] = *(const f32x4*)(hf + (size_t)t * D + 4 * F.lane + 256 * j) * DN_ALPHA;
#pragma unroll
        for (int k = 0; k < 4; ++k) { const int row = __shfl(ri, k); const float g = __shfl(gk, k);
#pragma unroll
            for (int j = 0; j < 4; ++j) { const v2u raw = *(const v2u*)(ys + (size_t)row * D + 4 * F.lane + 256 * j);
                v[j].x += g * __builtin_bit_cast(float, raw.x << 16); v[j].y += g * __builtin_bit_cast(float, raw.x & 0xffff0000u);
                v[j].z += g * __builtin_bit_cast(float, raw.y << 16); v[j].w += g * __builtin_bit_cast(float, raw.y & 0xffff0000u); } }
        ln_affine(v, gam, bet, F.lane);
        if (l == NLAYER - 1) {
#pragma unroll
            for (int j = 0; j < 4; ++j) *(f32x4*)(F.out + (size_t)t * D + 4 * F.lane + 256 * j) = v[j];
        } else {
#pragma unroll
            for (int j = 0; j < 4; ++j) *(f32x4*)(hf + (size_t)t * D + 4 * F.lane + 256 * j) = v[j];
            store_row_bf16(hb + (size_t)t * D, v, F.lane);
        }
    }
}

constexpr int MX_VT = 0, MX_K = 65536, MX_V = 65536 + 32768;
__device__ __forceinline__ void unpack8(const v4u raw, float (&f)[8]) {
    f[0] = __builtin_bit_cast(float, raw.x << 16); f[1] = __builtin_bit_cast(float, raw.x & 0xffff0000u); f[2] = __builtin_bit_cast(float, raw.y << 16); f[3] = __builtin_bit_cast(float, raw.y & 0xffff0000u);
    f[4] = __builtin_bit_cast(float, raw.z << 16); f[5] = __builtin_bit_cast(float, raw.z & 0xffff0000u); f[6] = __builtin_bit_cast(float, raw.w << 16); f[7] = __builtin_bit_cast(float, raw.w & 0xffff0000u);
}
__device__ __forceinline__ void mix_finish(float (&val)[8][8], const float* gain, bf16* grow, int q) {
    float ss = 0.f;
#pragma unroll
    for (int cb = 0; cb < 8; ++cb)
#pragma unroll
        for (int i = 0; i < 8; ++i) ss += val[cb][i] * val[cb][i];
    ss += __shfl_xor(ss, 16); ss += __shfl_xor(ss, 32);
    const float rs = 1.0f / sqrtf(ss * (1.0f / 256.0f) + RMS_EPS);
#pragma unroll
    for (int cb = 0; cb < 8; ++cb) { const f32x4 g0 = *(const f32x4*)(gain + 32 * cb + 8 * q), g1 = *(const f32x4*)(gain + 32 * cb + 8 * q + 4);
        v4u o; o.x = pk2(val[cb][0] * rs * g0.x, val[cb][1] * rs * g0.y); o.y = pk2(val[cb][2] * rs * g0.z, val[cb][3] * rs * g0.w);
        o.z = pk2(val[cb][4] * rs * g1.x, val[cb][5] * rs * g1.y); o.w = pk2(val[cb][6] * rs * g1.z, val[cb][7] * rs * g1.w);
        *(v4u*)(grow + 32 * cb + 8 * q) = o; }
}
__device__ __forceinline__ void pb_phase(Frame& F, const Args& A, int l) {
    for (int u = blockIdx.x; u < NTOK / 128; u += F.G) {
    RELANE(F);
    const int r = F.lane & 15, q = F.lane >> 4, w = F.wave;
    const bf16* P = WSP(bf16, WS_P); bf16* G = TILEP(T_G);
    const float* gng = A.in[I_GROUP_NORM_G] + l * 1024;
        const int row = u * 128 + 16 * w + r, tseq = (u & 15) * 128 + 16 * w + r, b = u >> 4;
        const bf16* prow = P + (size_t)row * NPROJ; bf16* grow = G + (size_t)row * 1024;
        float val[8][8];
#if MXMASK & 1
        {
            const float* cw = A.in[I_CONV_W] + l * 768;
#pragma unroll
            for (int cb = 0; cb < 8; ++cb) { const int col = 32 * cb + 8 * q;
                float gb[8], zc[8], zh[8], z[8], acc[8];
                unpack8(*(const v4u*)(prow + col), gb);
#pragma unroll
                for (int i = 0; i < 8; ++i) acc[i] = 0.f;
#pragma unroll
                for (int d = 0; d < 3; ++d) {
                    if (tseq - 2 + d >= 0) { const bf16* pr = prow - (size_t)(2 - d) * NPROJ;
                        unpack8(*(const v4u*)(pr + 256 + col), zc); unpack8(*(const v4u*)(pr + 512 + col), zh);
                        const f32x4 w0 = *(const f32x4*)(cw + d * 256 + col), w1 = *(const f32x4*)(cw + d * 256 + col + 4);
#pragma unroll
                        for (int i = 0; i < 8; ++i) z[i] = zc[i] * zh[i];
                        acc[0] += w0.x * z[0]; acc[1] += w0.y * z[1]; acc[2] += w0.z * z[2]; acc[3] += w0.w * z[3]; acc[4] += w1.x * z[4]; acc[5] += w1.y * z[5]; acc[6] += w1.z * z[6]; acc[7] += w1.w * z[7]; } }
#pragma unroll
                for (int i = 0; i < 8; ++i) val[cb][i] = gb[i] * acc[i];
                asm volatile("" ::: "memory"); }
            mix_finish(val, gng, grow, q);
        }
#endif
        asm volatile("" ::: "memory"); __builtin_amdgcn_sched_barrier(0);
#if MXMASK & 2
        {
            const bf16* pt = WSP(bf16, WS_POOLT) + (size_t)l * 4 * 4096;
            bf16x8 dfr[4][2];
#pragma unroll
            for (int g = 0; g < 4; ++g)
#pragma unroll
                for (int ks = 0; ks < 2; ++ks) { const int col = 768 + g * 64 + 32 * ks + 8 * q, wlen = 2 << g;
                    float acc[8], x[8], t8[8];
                    unpack8(*(const v4u*)(prow + col), x);
#pragma unroll
                    for (int i = 0; i < 8; ++i) acc[i] = x[i];
                    for (int d = 1; d < wlen; ++d) if (tseq - d >= 0) { unpack8(*(const v4u*)(prow - (size_t)d * NPROJ + col), t8);
#pragma unroll
                        for (int i = 0; i < 8; ++i) acc[i] += t8[i]; }
                    const float inv = 1.0f / (float)((tseq + 1 < wlen) ? tseq + 1 : wlen);
                    v4u o; o.x = pk2(acc[0] * inv - x[0], acc[1] * inv - x[1]); o.y = pk2(acc[2] * inv - x[2], acc[3] * inv - x[3]);
                    o.z = pk2(acc[4] * inv - x[4], acc[5] * inv - x[5]); o.w = pk2(acc[6] * inv - x[6], acc[7] * inv - x[7]);
                    dfr[g][ks] = __builtin_bit_cast(bf16x8, o);
                    asm volatile("" ::: "memory"); }
            const float* psc = A.in[I_POOL_SCALE] + l * 256;
#pragma unroll
            for (int g = 0; g < 4; ++g)
#pragma unroll
                for (int mt2 = 0; mt2 < 2; ++mt2) { const f32x4 s0 = *(const f32x4*)(psc + g * 64 + 32 * mt2 + 8 * q), s1 = *(const f32x4*)(psc + g * 64 + 32 * mt2 + 8 * q + 4);
#pragma unroll
                    for (int e = 0; e < 2; ++e) { const int dd = 32 * mt2 + 8 * (r >> 2) + 4 * e + (r & 3);
                        f32x4 o = {0.f, 0.f, 0.f, 0.f};
#pragma unroll
                        for (int ks = 0; ks < 2; ++ks) { const bf16x8 a = *(const bf16x8*)(pt + (size_t)(g * 64 + dd) * 64 + 32 * ks + 8 * q);
                            o = __builtin_amdgcn_mfma_f32_16x16x32_bf16(a, dfr[g][ks], o, 0, 0, 0); }
                        const f32x4 sc = e ? s1 : s0;
                        val[2 * g + mt2][4 * e + 0] = o[0] * sc.x; val[2 * g + mt2][4 * e + 1] = o[1] * sc.y; val[2 * g + mt2][4 * e + 2] = o[2] * sc.z; val[2 * g + mt2][4 * e + 3] = o[3] * sc.w; } }
            mix_finish(val, gng + 256, grow + 256, q);
        }
#endif
        asm volatile("" ::: "memory"); __builtin_amdgcn_sched_barrier(0);
#if MXMASK & 4
        {
            const float* lg = A.in[I_GMLP_LN_G] + l * 256; const float* lb = A.in[I_GMLP_LN_B] + l * 256;
            const f32x4 g4 = *(const f32x4*)(lg + 4 * F.lane), b4 = *(const f32x4*)(lb + 4 * F.lane);
            const int hh_l = F.lane >> 4, mt2_l = (F.lane & 15) >> 3, q_l = (F.lane & 7) >> 1, e_l = F.lane & 1;
#pragma unroll 2
            for (int jp = 0; jp < 8; ++jp) { const int j = 16 * w + 2 * jp;
                const bf16* p0 = P + (size_t)(u * 128 + j) * NPROJ + 1280 + 4 * F.lane;
                const v2u ra = *(const v2u*)p0, rb = *(const v2u*)(p0 + NPROJ);
                float va[4], vb[4];
                va[0] = gelu_tanh(__builtin_bit_cast(float, ra.x << 16)); va[1] = gelu_tanh(__builtin_bit_cast(float, ra.x & 0xffff0000u)); va[2] = gelu_tanh(__builtin_bit_cast(float, ra.y << 16)); va[3] = gelu_tanh(__builtin_bit_cast(float, ra.y & 0xffff0000u));
                vb[0] = gelu_tanh(__builtin_bit_cast(float, rb.x << 16)); vb[1] = gelu_tanh(__builtin_bit_cast(float, rb.x & 0xffff0000u)); vb[2] = gelu_tanh(__builtin_bit_cast(float, rb.y << 16)); vb[3] = gelu_tanh(__builtin_bit_cast(float, rb.y & 0xffff0000u));
                const float ma = wave_sum((va[0] + va[1]) + (va[2] + va[3])) * (1.f / 256.f), mb = wave_sum((vb[0] + vb[1]) + (vb[2] + vb[3])) * (1.f / 256.f);
                float sa = 0.f, sb = 0.f;
#pragma unroll
                for (int c = 0; c < 4; ++c) { va[c] -= ma; vb[c] -= mb; sa += va[c] * va[c]; sb += vb[c] * vb[c]; }
                const float ra_ = 1.f / sqrtf(wave_sum(sa) * (1.f / 256.f) + LN_EPS), rb_ = 1.f / sqrtf(wave_sum(sb) * (1.f / 256.f) + LN_EPS);
                const int ks = j >> 5, gg = (j & 31) >> 3, jj = j & 7;
                LAS unsigned char* dst = F.lds + MX_VT + ((((hh_l * 2 + mt2_l) * 2 + e_l) * 4 + ks) * 64 + 16 * gg + 4 * q_l) * 16 + jj * 2;
                const float ga[4] = {g4.x, g4.y, g4.z, g4.w}, ba[4] = {b4.x, b4.y, b4.z, b4.w};
#pragma unroll
                for (int c = 0; c < 4; ++c) *(LAS unsigned*)(dst + c * 16) = pk2(va[c] * ra_ * ga[c] + ba[c], vb[c] * rb_ * ga[c] + ba[c]);
            }
            __syncthreads();
            const bf16* wm = WSP(bf16, WS_WMB) + (size_t)l * 4 * 128 * 128; const float* gbias = A.in[I_GMLP_B] + l * 512;
            const int nks = (w < 4) ? 2 : 4;
#pragma unroll
            for (int hh = 0; hh < 4; ++hh) {
                bf16x8 wf[4];
#pragma unroll
                for (int ks = 0; ks < 4; ++ks) wf[ks] = *(const bf16x8*)(wm + (size_t)(hh * 128 + 16 * w + r) * 128 + 32 * ks + 8 * q);
                const float bias = gbias[hh * 128 + 16 * w + r];
#pragma unroll
                for (int mt2 = 0; mt2 < 2; ++mt2) {
                    float uu[8]; unpack8(*(const v4u*)(prow + 1024 + hh * 64 + 32 * mt2 + 8 * q), uu);
#pragma unroll
                    for (int e = 0; e < 2; ++e) { f32x4 o = {0.f, 0.f, 0.f, 0.f};
#pragma unroll
                        for (int ks = 0; ks < 4; ++ks) if (ks < nks) { const bf16x8 a = *(const LAS bf16x8*)(F.lds + MX_VT + ((((hh * 2 + mt2) * 2 + e) * 4 + ks) * 64 + F.lane) * 16);
                            o = __builtin_amdgcn_mfma_f32_16x16x32_bf16(a, wf[ks], o, 0, 0, 0); }
#pragma unroll
                        for (int i = 0; i < 4; ++i) val[2 * hh + mt2][4 * e + i] = gelu_tanh(uu[4 * e + i]) * (o[i] + bias); } }
            }
            mix_finish(val, gng + 512, grow + 512, q);
        }
#endif
        asm volatile("" ::: "memory"); __builtin_amdgcn_sched_barrier(0);
#if MXMASK & 8
        {
            const bf16* kb = WSP(bf16, WS_KB) + ((size_t)l * 4096 + (size_t)b * 256) * 256;
            const bf16* vt = WSP(bf16, WS_VT) + (size_t)l * 256 * 4096 + (size_t)b * 256;
            float rsum[4];
#pragma unroll
            for (int hh = 0; hh < 4; ++hh) {
                __syncthreads();
#pragma unroll
                for (int i = 0; i < 4; ++i) { const int idx = F.tid + 512 * i;
                    { const int key = idx >> 3, cidx = idx & 7; const v4u x = *(const v4u*)(kb + (size_t)key * 256 + hh * 64 + 8 * cidx);
                      *(LAS v4u*)(F.lds + MX_K + ((((key >> 4) * 2 + (cidx >> 2)) * 64) + 16 * (cidx & 3) + (key & 15)) * 16) = x; }
                    { const int d = idx >> 5, c16 = idx & 31; const v4u x = *(const v4u*)(vt + (size_t)(hh * 64 + d) * 4096 + 8 * c16);
                      const int key0 = 8 * c16, s = key0 >> 5, kk = key0 & 31, half = kk >> 4, gA = (kk & 15) >> 2, mt2 = d >> 5, rem = d & 31, m = 4 * (rem >> 3) + (rem & 3), e = (rem >> 2) & 1;
                      LAS unsigned char* dst = F.lds + MX_V + ((((mt2 * 2 + e) * 8 + s) * 64) + 16 * gA + m) * 16 + half * 8;
                      v2u lo; lo.x = x.x; lo.y = x.y; v2u hi; hi.x = x.z; hi.y = x.w; *(LAS v2u*)dst = lo; *(LAS v2u*)(dst + 256) = hi; } }
                const bf16x8 q0 = *(const bf16x8*)(prow + 1536 + hh * 64 + 8 * q), q1 = *(const bf16x8*)(prow + 1536 + hh * 64 + 32 + 8 * q);
                __syncthreads();
                f32x4 st[16];
#pragma unroll
                for (int t = 0; t < 16; ++t) { const bf16x8 k0 = *(const LAS bf16x8*)(F.lds + MX_K + ((t * 2 + 0) * 64 + F.lane) * 16), k1 = *(const LAS bf16x8*)(F.lds + MX_K + ((t * 2 + 1) * 64 + F.lane) * 16);
                    f32x4 z = {0.f, 0.f, 0.f, 0.f}; z = __builtin_amdgcn_mfma_f32_16x16x32_bf16(k0, q0, z, 0, 0, 0); st[t] = __builtin_amdgcn_mfma_f32_16x16x32_bf16(k1, q1, z, 0, 0, 0); }
                float mx = -3.0e38f;
#pragma unroll
                for (int t = 0; t < 16; ++t) mx = fmaxf(fmaxf(mx, fmaxf(st[t][0], st[t][1])), fmaxf(st[t][2], st[t][3]));
                mx = fmaxf(mx, __shfl_xor(mx, 16)); mx = fmaxf(mx, __shfl_xor(mx, 32));
                float sum = 0.f; const float c2 = 0.125f * 1.4426950408889634f, mo = mx * c2;
#pragma unroll
                for (int t = 0; t < 16; ++t)
#pragma unroll
                    for (int i = 0; i < 4; ++i) { const float p = __builtin_amdgcn_exp2f(st[t][i] * c2 - mo); st[t][i] = p; sum += p; }
                sum += __shfl_xor(sum, 16); sum += __shfl_xor(sum, 32); rsum[hh] = 1.0f / sum;
                bf16x8 pb[8];
#pragma unroll
                for (int s = 0; s < 8; ++s) { v4u o; o.x = pk2(st[2 * s][0], st[2 * s][1]); o.y = pk2(st[2 * s][2], st[2 * s][3]); o.z = pk2(st[2 * s + 1][0], st[2 * s + 1][1]); o.w = pk2(st[2 * s + 1][2], st[2 * s + 1][3]);
                    pb[s] = __builtin_bit_cast(bf16x8, o); }
#pragma unroll
                for (int mt2 = 0; mt2 < 2; ++mt2)
#pragma unroll
                    for (int e = 0; e < 2; ++e) { f32x4 o = {0.f, 0.f, 0.f, 0.f};
#pragma unroll
                        for (int s = 0; s < 8; ++s) { const bf16x8 a = *(const LAS bf16x8*)(F.lds + MX_V + (((mt2 * 2 + e) * 8 + s) * 64 + F.lane) * 16);
                            o = __builtin_amdgcn_mfma_f32_16x16x32_bf16(a, pb[s], o, 0, 0, 0); }
#pragma unroll
                        for (int i = 0; i < 4; ++i) val[2 * hh + mt2][4 * e + i] = o[i] * rsum[hh]; }
            }
            mix_finish(val, gng + 768, grow + 768, q);
        }
#endif
        __syncthreads();
    }
}

#if NAIVE_MIX
__global__ void __launch_bounds__(256) nv_mix_pre(const bf16* P, const float* lng, const float* lnb, float* Vn, float* Dp) {
    const int row = blockIdx.x * 4 + (threadIdx.x >> 6), lane = threadIdx.x & 63;
    const bf16* p = P + (size_t)row * NPROJ;
    float v[4]; float s = 0.f;
    for (int i = 0; i < 4; ++i) { v[i] = gelu_tanh(bf2f(p[1280 + 4 * lane + i])); s += v[i]; }
    const float mean = wave_sum(s) * (1.f / 256.f); float s2 = 0.f;
    for (int i = 0; i < 4; ++i) { v[i] -= mean; s2 += v[i] * v[i]; }
    const float rstd = 1.f / sqrtf(wave_sum(s2) * (1.f / 256.f) + LN_EPS);
    for (int i = 0; i < 4; ++i) Vn[(size_t)row * 256 + 4 * lane + i] = v[i] * rstd * lng[4 * lane + i] + lnb[4 * lane + i];
    const int t = row % SEQ, w = 2 << (lane >> 4), cnt = (t + 1 < w) ? t + 1 : w;
    for (int i = 0; i < 4; ++i) { const int c = 4 * lane + i; float acc = 0.f;
        for (int d = 0; d < cnt; ++d) acc += bf2f(P[(size_t)(row - d) * NPROJ + 768 + c]);
        Dp[(size_t)row * 256 + c] = acc / (float)cnt - bf2f(p[768 + c]); }
}
__global__ void __launch_bounds__(256) nv_mix_main(const bf16* P, const float* Vn, const float* Dp, const bf16* Kb, const bf16* VT, const float* conv_w, const float* pool_w, const float* pool_scale,
                                                   const float* gmlp_w, const float* gmlp_b, float* Y) {
    const int row = blockIdx.x >> 2, grp = blockIdx.x & 3, c = threadIdx.x, t = row % SEQ;
    const bf16* p = P + (size_t)row * NPROJ; float y = 0.f;
    if (grp == 0) {
        float z[3];
        for (int d = 0; d < 3; ++d) { const int tt = t - 2 + d; z[d] = (tt >= 0) ? bf2f(P[(size_t)(row - 2 + d) * NPROJ + 256 + c]) * bf2f(P[(size_t)(row - 2 + d) * NPROJ + 512 + c]) : 0.f; }
        y = bf2f(p[c]) * (conv_w[c] * z[0] + conv_w[256 + c] * z[1] + conv_w[512 + c] * z[2]);
    } else if (grp == 1) {
        const int gi = c >> 6, dd = c & 63; float acc = 0.f;
        for (int cc = 0; cc < 64; ++cc) acc += Dp[(size_t)row * 256 + gi * 64 + cc] * pool_w[(gi * 64 + cc) * 64 + dd];
        y = acc * pool_scale[c];
    } else if (grp == 2) {
        const int hh = c >> 6, i = t & 127, jmax = ((i >> 6) + 1) * 64; const size_t blk0 = (size_t)(row - i); float acc = 0.f;
        for (int j = 0; j < jmax; ++j) acc += gmlp_w[(hh * 128 + i) * 128 + j] * Vn[(blk0 + j) * 256 + c];
        y = gelu_tanh(bf2f(p[1024 + c])) * (acc + gmlp_b[hh * 128 + i]);
    } else {
        const int hh = c >> 6, lane = c & 63, b = row / SEQ;
        const float q = bf2f(p[1536 + hh * 64 + lane]);
        float sc[4] = {0.f, 0.f, 0.f, 0.f};
        for (int d = 0; d < 64; ++d) { const float qd = __shfl(q, d);
            for (int m = 0; m < 4; ++m) sc[m] += qd * bf2f(Kb[(size_t)(b * 256 + lane + 64 * m) * 256 + hh * 64 + d]); }
        float mx = -3.0e38f;
        for (int m = 0; m < 4; ++m) { sc[m] *= 0.125f; mx = fmaxf(mx, sc[m]); }
        for (int o = 1; o < 64; o <<= 1) mx = fmaxf(mx, __shfl_xor(mx, o));
        float sum = 0.f;
        for (int m = 0; m < 4; ++m) { sc[m] = __expf(sc[m] - mx); sum += sc[m]; }
        sum = wave_sum(sum);
        float o = 0.f;
        for (int m = 0; m < 4; ++m) for (int j = 0; j < 64; ++j) { const float pj = __shfl(sc[m], j); o += pj * bf2f(VT[(size_t)(hh * 64 + lane) * 4096 + b * 256 + j + 64 * m]); }
        y = o / sum;
    }
    Y[(size_t)row * 1024 + grp * 256 + c] = y;
}
__global__ void __launch_bounds__(256) nv_mix_norm(const float* Y, const float* gng, bf16* G) {
    const int wv = blockIdx.x * 4 + (threadIdx.x >> 6), lane = threadIdx.x & 63, row = wv >> 2, grp = wv & 3;
    const float* y = Y + (size_t)row * 1024 + grp * 256; float v[4], s2 = 0.f;
    for (int i = 0; i < 4; ++i) { v[i] = y[4 * lane + i]; s2 += v[i] * v[i]; }
    const float r = 1.f / sqrtf(wave_sum(s2) * (1.f / 256.f) + RMS_EPS);
    for (int i = 0; i < 4; ++i) G[(size_t)row * 1024 + grp * 256 + 4 * lane + i] = (bf16)f2bf(v[i] * r * gng[grp * 256 + 4 * lane + i]);
}
#endif

constexpr int PH_PRO = 0, PH_KV = 1, PH_L0 = 2, PH_PER_LAYER = 8, N_PHASES = PH_L0 + NLAYER * PH_PER_LAYER;
__global__ void __launch_bounds__(NWAVES * 64, 2) fwd(Args args) {
    const Args& A = args;
    extern __shared__ __attribute__((aligned(16))) unsigned char lds[];
    Frame F;
    F.lds = (LAS unsigned char*)lds;
    F.MISC = (volatile LAS unsigned*)(F.lds + MISC_OFF);
    F.tid = threadIdx.x; F.lane = F.tid & 63; F.wave = __builtin_amdgcn_readfirstlane(F.tid >> 6);
    F.G = gridDim.x; F.ws = args.ws; F.ctl = (gu32*)(args.ws + WS_CTL); F.out = args.out;
    for (int u = F.tid; u < (LDS_BYTES - LDSCTL_OFF) / 4; u += NWAVES * 64) ((LAS unsigned*)(F.lds + LDSCTL_OFF))[u] = 0u;
    __syncthreads();
#if MK_ONE_LAUNCH
    XcdBarrier bar = xcd_barrier_post((unsigned*)(F.ctl + CW_BAR), F.MISC + 8);
#define GRID_BAR() xcd_barrier(bar)
#else
#define GRID_BAR() do { } while (0)
#endif
    const int lo = args.ph_lo, hi = args.ph_hi;
#define IN(k) (lo <= (k) && (k) < hi)
#define BOTH(k) (IN(k) && IN((k) + 1))
    const pg8::Gemm gm{(const pg8::bf16_t*)F.ws, (const pg8::bf16_t*)F.ws, D};
    const int c = (int)blockIdx.x;

    if (IN(PH_PRO) && (PHMASK & 1)) { p0_prologue(F, args); if (BOTH(PH_PRO)) GRID_BAR(); }
    if (IN(PH_KV) && (PHMASK & 2)) {
        KvOrder S{F.G, c};
        pg8::EpiBf16Sel E{WSP(bf16, WS_KB), WSP(bf16, WS_VT), 256, 4096};
        pg8::gemm_phase<pg8::EpiBf16Sel, KvOrder, true, true>(F.lds + RING_OFF, gm, S, E);
        if (BOTH(PH_KV)) GRID_BAR();
    }
    for (int l = 0; l < NLAYER; ++l) {
        const int pb = PH_L0 + l * PH_PER_LAYER;
        if (IN(pb + 0) && (PHMASK & 4)) {
            DenseOrder S{NTOK / 256, NPROJ / 256, F.G, c, T_HB, T_WIN + l * (NPROJ / 256)};
            pg8::EpiBf16Sel E{WSP(bf16, WS_P), WSP(bf16, WS_P), NPROJ, NPROJ};
            pg8::gemm_phase<pg8::EpiBf16Sel, DenseOrder, true, true>(F.lds + RING_OFF, gm, S, E);
            if (BOTH(pb + 0)) GRID_BAR();
        }
        if (IN(pb + 1) && (PHMASK & 512)) {
            pb_phase(F, args, l);
            if (BOTH(pb + 1)) GRID_BAR();
        }
        if (IN(pb + 2) && (PHMASK & 8)) {
            DenseOrder S{NTOK / 256, D / 256, F.G, c, T_G, T_WOUT + l * (D / 256)};
            pg8::EpiResF32 E{WSP(float, WS_HF), WSP(float, WS_PRE), DN_ALPHA};
            pg8::gemm_phase<pg8::EpiResF32, DenseOrder, true, true>(F.lds + RING_OFF, gm, S, E);
            if (BOTH(pb + 2)) GRID_BAR();
        }
        if (IN(pb + 3) && (PHMASK & 16)) { pd_phase(F, args, l); if (BOTH(pb + 3)) GRID_BAR(); }
        if (IN(pb + 4) && (PHMASK & 32)) { pe_phase(F, l); if (BOTH(pb + 4)) GRID_BAR(); }
        if (IN(pb + 5) && (PHMASK & 64)) {
            compute_toff(F, l);
            const LAS int* toff = (const LAS int*)(F.lds + TOFF_OFF);
            MoeOrder S{__builtin_amdgcn_readfirstlane(toff[NEXP]), 8, F.G, c, T_XP, T_W1 + l * NEXP * 8, toff};
            pg8::EpiSwiglu E{TILEP(T_ACT), A.in[I_B1] + (size_t)l * NEXP * 2048};
            pg8::gemm_phase<pg8::EpiSwiglu, MoeOrder, true, true>(F.lds + RING_OFF, gm, S, E);
            if (BOTH(pb + 5)) GRID_BAR();
        }
        if (IN(pb + 6) && (PHMASK & 128)) {
            compute_toff(F, l);
            const LAS int* toff = (const LAS int*)(F.lds + TOFF_OFF);
            MoeOrder S{__builtin_amdgcn_readfirstlane(toff[NEXP]), 4, F.G, c, T_ACT, T_W2 + l * NEXP * 4, toff};
            pg8::EpiDown E{TILEP(T_YS), A.in[I_B2] + (size_t)l * NEXP * 1024};
            pg8::gemm_phase<pg8::EpiDown, MoeOrder, true, true>(F.lds + RING_OFF, gm, S, E);
            if (BOTH(pb + 6)) GRID_BAR();
        }
        if (IN(pb + 7) && (PHMASK & 256)) { ph_phase(F, args, l); if (BOTH(pb + 7)) GRID_BAR(); }
    }
#undef IN
#undef BOTH
}

extern "C" void kernel_launch(void* const* d_in, const int* in_sizes, int n_in, void* d_out, int out_size, void* d_ws, size_t ws_size, hipStream_t stream) {
    static int grid = 0;
    if (grid == 0) {
        if (n_in != 27 || out_size != NTOK * D || ws_size < WS_END) { fprintf(stderr, "kernel_launch: unexpected problem (n_in %d, out %d, ws %zu < %zu)\n", n_in, out_size, ws_size, (size_t)WS_END); grid = -1; return; }
        int dev = 0, cus = 0, per_cu = 0;
        if (hipGetDevice(&dev) != hipSuccess || hipDeviceGetAttribute(&cus, hipDeviceAttributeMultiprocessorCount, dev) != hipSuccess) { grid = -1; return; }
        if (hipFuncSetAttribute((const void*)fwd, hipFuncAttributeMaxDynamicSharedMemorySize, LDS_BYTES) != hipSuccess) { fprintf(stderr, "kernel_launch: hipFuncSetAttribute failed\n"); grid = -1; return; }
        if (hipOccupancyMaxActiveBlocksPerMultiprocessor(&per_cu, (const void*)fwd, NWAVES * 64, LDS_BYTES) != hipSuccess || per_cu < 1) fprintf(stderr, "kernel_launch: occupancy query says %d\n", per_cu);
        (void)hipGetLastError();
        grid = cus;
    }
    if (grid < 0) return;
    if (hipMemsetAsync((char*)d_ws + WS_CTL, 0, CTL_ZERO_BYTES, stream) != hipSuccess) return;
    Args a{};
    for (int i = 0; i < 27; ++i) a.in[i] = (const float*)d_in[i];
    a.out = (float*)d_out; a.ws = (unsigned char*)d_ws;
#if MK_ONE_LAUNCH
    a.ph_lo = 0; a.ph_hi = N_PHASES;
    hipLaunchKernelGGL(fwd, dim3(grid), dim3(NWAVES * 64), LDS_BYTES, stream, a);
#else
    unsigned char* ws = (unsigned char*)d_ws;
    for (int p = 0; p < N_PHASES; ++p) {
        const int l = (p - PH_L0) / PH_PER_LAYER, q = (p - PH_L0) % PH_PER_LAYER;
        if (p >= PH_L0 && q == 1) {
#if NAIVE_MIX
            const float* const* in = (const float* const*)d_in;
            hipLaunchKernelGGL(nv_mix_pre, dim3(NTOK / 4), dim3(256), 0, stream, (const bf16*)(ws + WS_P), in[10] + l * 256, in[11] + l * 256, (float*)(ws + WS_NV_VN), (float*)(ws + WS_NV_DP));
            hipLaunchKernelGGL(nv_mix_main, dim3(NTOK * 4), dim3(256), 0, stream, (const bf16*)(ws + WS_P), (const float*)(ws + WS_NV_VN), (const float*)(ws + WS_NV_DP),
                               (const bf16*)(ws + WS_KB) + (size_t)l * 4096 * 256, (const bf16*)(ws + WS_VT) + (size_t)l * 256 * 4096, in[7] + l * 768, in[8] + l * 4 * 64 * 64, in[9] + l * 256,
                               in[12] + l * 4 * 128 * 128, in[13] + l * 4 * 128, (float*)(ws + WS_NV_Y));
            hipLaunchKernelGGL(nv_mix_norm, dim3(NTOK), dim3(256), 0, stream, (const float*)(ws + WS_NV_Y), in[15] + l * 1024, (bf16*)(ws + (size_t)T_G * TILE));
            continue;
#endif
        }
        a.ph_lo = p; a.ph_hi = p + 1;
        hipLaunchKernelGGL(fwd, dim3(grid), dim3(NWAVES * 64), LDS_BYTES, stream, a);
    }
#endif
}
```

```cpp
#include <hip/hip_runtime.h>
#include <cstdio>
#include <cstdint>

#ifndef MK_ONE_LAUNCH
#define MK_ONE_LAUNCH 1
#endif
#ifndef PHMASK
#define PHMASK 0xffff
#endif
#ifndef MXMASK
#define MXMASK 15
#endif
#ifndef NAIVE_MIX
#define NAIVE_MIX 0
#endif

namespace pg8 {
#define PG8_LAS __attribute__((address_space(3)))
typedef unsigned short bf16_t;
typedef short bf16x8 __attribute__((ext_vector_type(8)));
typedef float f32x4 __attribute__((ext_vector_type(4)));
typedef float f32x2 __attribute__((ext_vector_type(2)));
typedef unsigned u32x4 __attribute__((ext_vector_type(4)));
typedef unsigned u32x2 __attribute__((ext_vector_type(2)));
constexpr int BM = 256, BK = 64, HALF = 128, HTB = HALF * BK * 2  , STAGE_BYTES = 8 * HTB, NXCD = 8, WGM = 8;

__host__ __device__ __forceinline__ int lds_byte(int r, int c) { const int st = (r >> 4) * 2 + (c >> 5), rr = r & 15, cc = c & 31, ob = rr * 64 + cc * 2; return st * 1024 + (ob ^ (((ob >> 9) & 1) << 5)); }
__host__ __device__ __forceinline__ void stage_rc(int b, int& R, int& C) { const int st = b / 1024, sb = b % 1024, swz = sb ^ (((sb >> 9) & 1) << 5); R = (st >> 1) * 16 + swz / 64; C = (st & 1) * 32 + (swz % 64) / 2; }
__host__ __device__ __forceinline__ int perm32(int rho) { const int n = rho >> 4, i = rho & 15; return 8 * (i >> 2) + 4 * n + (i & 3); }

struct Unit { int pm, pn, lm, ln, a0; };
struct Gemm { const bf16_t* A; const bf16_t* Bt; int K; };

__device__ __forceinline__ void tile_of(int L, int nM, int nN, int& tm, int& tn) {
    const int nwg = nM * nN; int wgid = L; { const int q = nwg / NXCD, r = nwg % NXCD, xcd = wgid % NXCD, off = wgid / NXCD; wgid = (xcd < r ? xcd * (q + 1) : r * (q + 1) + (xcd - r) * q) + off; }
    const int nig = WGM * nN, gid = wgid / nig, fm = gid * WGM, gsz = (nM - fm) < WGM ? (nM - fm) : WGM;
    tm = fm + ((wgid % nig) % gsz); tn = (wgid % nig) / gsz;
}

__device__ __forceinline__ unsigned cvt_pk_bf16(float lo, float hi) { unsigned r; asm volatile("v_cvt_pk_bf16_f32 %0, %1, %2" : "=v"(r) : "v"(lo), "v"(hi)); return r; }


struct EpiBf16Sel {
    static constexpr bool PERM = true, AFTER_DRAIN = false;
    bf16_t* o0; bf16_t* o1; int ld0, ld1;
    __device__ __forceinline__ void operator()(const f32x4 (&acc)[2][2][4][2], const Unit& u, int wr, int wc, int fr, int fq) const {
        bf16_t* base = u.a0 == 0 ? o0 : o1; const int ldc = u.a0 == 0 ? ld0 : ld1;
        const int row0 = u.lm * BM + wr * 64 + fr, col0 = u.ln * BM + wc * 32 + 8 * fq;
#pragma unroll
        for (int ai = 0; ai < 2; ++ai)
#pragma unroll
            for (int m = 0; m < 4; ++m) { bf16_t* rowp = base + (size_t)(row0 + ai * HALF + m * 16) * ldc + col0;
#pragma unroll
                for (int bj = 0; bj < 2; ++bj) { const f32x4 v0 = acc[ai][bj][m][0], v1 = acc[ai][bj][m][1];
                    u32x4 w; w.x = cvt_pk_bf16(v0[0], v0[1]); w.y = cvt_pk_bf16(v0[2], v0[3]); w.z = cvt_pk_bf16(v1[0], v1[1]); w.w = cvt_pk_bf16(v1[2], v1[3]);
                    *(u32x4*)(rowp + bj * HALF) = w; } }
    }
};
struct EpiResF32 {
    static constexpr bool PERM = false, AFTER_DRAIN = false;
    const float* h; float* pre; float alpha;
    __device__ __forceinline__ void operator()(const f32x4 (&acc)[2][2][4][2], const Unit& u, int wr, int wc, int fr, int fq) const {
        const int row0 = u.lm * BM + wr * 64 + fr, col0 = u.ln * BM + wc * 32 + 4 * fq;
#pragma unroll
        for (int ai = 0; ai < 2; ++ai)
#pragma unroll
            for (int m = 0; m < 4; ++m) { const size_t off = (size_t)(row0 + ai * HALF + m * 16) * 1024 + col0;
#pragma unroll
                for (int bj = 0; bj < 2; ++bj)
#pragma unroll
                    for (int n = 0; n < 2; ++n) { const f32x4 hv = *(const f32x4*)(h + off + bj * HALF + n * 16); *(f32x4*)(pre + off + bj * HALF + n * 16) = hv * alpha + acc[ai][bj][m][n]; }
                asm volatile("" ::: "memory"); }
    }
};
struct EpiSwiglu {
    static constexpr bool PERM = true, AFTER_DRAIN = false;
    bf16_t* act; const float* b1;
    __device__ __forceinline__ void operator()(const f32x4 (&acc)[2][2][4][2], const Unit& u, int wr, int wc, int fr, int fq) const {
        const int row0 = u.lm * BM + wr * 64 + fr, lc0 = u.ln * HALF + wc * 32 + 8 * fq;
        const float* bb = b1 + (size_t)u.a0 * 2048 + lc0;
        const f32x4 bg0 = *(const f32x4*)(bb), bg1 = *(const f32x4*)(bb + 4), bl0 = *(const f32x4*)(bb + 1024), bl1 = *(const f32x4*)(bb + 1028);
#pragma unroll
        for (int ai = 0; ai < 2; ++ai)
#pragma unroll
            for (int m = 0; m < 4; ++m) {
                u32x4 w; unsigned* wp = (unsigned*)&w;
#pragma unroll
                for (int n = 0; n < 2; ++n) { const f32x4 g4 = acc[ai][0][m][n] + (n ? bg1 : bg0), l4 = acc[ai][1][m][n] + (n ? bl1 : bl0); float r4[4];
#pragma unroll
                    for (int j = 0; j < 4; ++j) { const float g = fminf(g4[j], 7.0f), li = fminf(fmaxf(l4[j], -7.0f), 7.0f);
                        const float sg = __builtin_amdgcn_rcpf(1.0f + __builtin_amdgcn_exp2f(g * (-1.702f * 1.4426950408889634f))); r4[j] = g * sg * (li + 1.0f); }
                    wp[2 * n] = cvt_pk_bf16(r4[0], r4[1]); wp[2 * n + 1] = cvt_pk_bf16(r4[2], r4[3]); }
                *(u32x4*)(act + (size_t)(row0 + ai * HALF + m * 16) * 1024 + lc0) = w; }
    }
};
struct EpiDown {
    static constexpr bool PERM = true, AFTER_DRAIN = false;
    bf16_t* ys; const float* b2;
    __device__ __forceinline__ void operator()(const f32x4 (&acc)[2][2][4][2], const Unit& u, int wr, int wc, int fr, int fq) const {
        const int row0 = u.lm * BM + wr * 64 + fr, col0 = u.ln * BM + wc * 32 + 8 * fq;
        f32x4 bv[2][2];
#pragma unroll
        for (int bj = 0; bj < 2; ++bj)
#pragma unroll
            for (int n = 0; n < 2; ++n) bv[bj][n] = *(const f32x4*)(b2 + (size_t)u.a0 * 1024 + col0 + bj * HALF + 4 * n);
#pragma unroll
        for (int ai = 0; ai < 2; ++ai)
#pragma unroll
            for (int m = 0; m < 4; ++m) { bf16_t* rowp = ys + (size_t)(row0 + ai * HALF + m * 16) * 1024 + col0;
#pragma unroll
                for (int bj = 0; bj < 2; ++bj) { const f32x4 v0 = acc[ai][bj][m][0] + bv[bj][0], v1 = acc[ai][bj][m][1] + bv[bj][1];
                    u32x4 w; w.x = cvt_pk_bf16(v0[0], v0[1]); w.y = cvt_pk_bf16(v0[2], v0[3]); w.z = cvt_pk_bf16(v1[0], v1[1]); w.w = cvt_pk_bf16(v1[2], v1[3]);
                    *(u32x4*)(rowp + bj * HALF) = w; } }
    }
};

template <class Epi, class Sched, bool ALIGN_EPI = false, bool SP2 = false>
__device__ __forceinline__ void gemm_phase(PG8_LAS unsigned char* lds, const Gemm g, const Sched& S, const Epi& E) {
    int tid_l = threadIdx.x; asm volatile("" : "+v"(tid_l));
    const int tid = tid_l, wid = __builtin_amdgcn_readfirstlane(tid >> 6), lane = tid & 63, wr = wid >> 2, wc = wid & 3, fr = lane & 15, fq = lane >> 4;
    const int K = g.K, nt = K / BK;
    unsigned voffA[2], voffB[2];
#pragma unroll
    for (int i = 0; i < 2; ++i) { int R, C; stage_rc(tid * 16 + i * 8192, R, C); const int Rb = Epi::PERM ? ((R & ~31) + perm32(R & 31)) : R;
        voffA[i] = (unsigned)(R * K + C) * 2u; voffB[i] = (unsigned)(Rb * K + C) * 2u; }
    const size_t kstep = (size_t)(BK * 2);
    const size_t hstep = (size_t)HALF * K * 2;
    const size_t tstep = 2 * hstep;
    const unsigned ldsw = (unsigned)wid * 1024u;
    const int aoff = lds_byte(wr * 64 + fr, fq * 8), boff = lds_byte(wc * 32 + fr, fq * 8);
#define PG8_SA(b, h) (((b) * 2 + (h)) * HTB)
#define PG8_SB(b, h) ((4 + (b) * 2 + (h)) * HTB)
#define PG8_STAGE(bufoff, gbase, voff) do { _Pragma("unroll") for (int _i = 0; _i < 2; ++_i) \
        __builtin_amdgcn_global_load_lds((const unsigned*)((const char*)(gbase) + (voff)[_i]), (PG8_LAS unsigned*)(lds + (bufoff) + ldsw + _i * 8192), 16, 0, 0); } while (0)
#define PG8_LDA(dst, b, h) do { _Pragma("unroll") for (int m = 0; m < 4; ++m) _Pragma("unroll") for (int k = 0; k < 2; ++k) dst[m][k] = *(const PG8_LAS bf16x8*)(lds + PG8_SA(b, h) + aoff + m * 2048 + k * 1024); } while (0)
#define PG8_LDB(dst, b, h) do { _Pragma("unroll") for (int n = 0; n < 2; ++n) _Pragma("unroll") for (int k = 0; k < 2; ++k) dst[n][k] = *(const PG8_LAS bf16x8*)(lds + PG8_SB(b, h) + boff + n * 2048 + k * 1024); } while (0)
#define PG8_MMA(ai, bj, At, Bt) do { __builtin_amdgcn_s_setprio(1); _Pragma("unroll") for (int m = 0; m < 4; ++m) _Pragma("unroll") for (int n = 0; n < 2; ++n) _Pragma("unroll") for (int k = 0; k < 2; ++k) \
        acc[ai][bj][m][n] = __builtin_amdgcn_mfma_f32_16x16x32_bf16(Bt[n][k], At[m][k], acc[ai][bj][m][n], 0, 0, 0); __builtin_amdgcn_s_setprio(0); } while (0)
#define PG8_WAIT_V(n) asm volatile("s_waitcnt vmcnt(" #n ")" ::: "memory")
#define PG8_WAIT_L(n) asm volatile("s_waitcnt lgkmcnt(" #n ")" ::: "memory")
#define PG8_BAR __builtin_amdgcn_s_barrier()
#define PG8_SCHED __builtin_amdgcn_sched_barrier(0)
    Unit cur, nxt; int ui = 0;
    if (!S.next(0, cur)) return;
    f32x4 acc[2][2][4][2];
#pragma unroll
    for (int a = 0; a < 2; ++a)
#pragma unroll
        for (int b = 0; b < 2; ++b)
#pragma unroll
            for (int m = 0; m < 4; ++m)
#pragma unroll
                for (int n = 0; n < 2; ++n) acc[a][b][m][n] = (f32x4){0.f, 0.f, 0.f, 0.f};
    bf16x8 At[4][2], B0[2][2], B1[2][2];
    const char* cA = (const char*)g.A + (size_t)cur.pm * tstep; const char* cB = (const char*)g.Bt + (size_t)cur.pn * tstep;
    S.a_ready(cur);
    if constexpr (SP2) {
        PG8_STAGE(PG8_SB(0, 0), cB, voffB); PG8_STAGE(PG8_SB(0, 1), cB + hstep, voffB); PG8_STAGE(PG8_SA(0, 0), cA, voffA); PG8_STAGE(PG8_SA(0, 1), cA + hstep, voffA);
        if (wr == 1) PG8_BAR;
        PG8_WAIT_V(2); PG8_BAR;
        PG8_STAGE(PG8_SB(1, 0), cB + kstep, voffB); PG8_STAGE(PG8_SA(1, 0), cA + kstep, voffA); PG8_STAGE(PG8_SB(1, 1), cB + hstep + kstep, voffB);
        PG8_WAIT_V(6); PG8_BAR;
    } else {
        PG8_STAGE(PG8_SB(0, 0), cB, voffB); PG8_STAGE(PG8_SA(0, 0), cA, voffA); PG8_STAGE(PG8_SB(0, 1), cB + hstep, voffB); PG8_STAGE(PG8_SA(0, 1), cA + hstep, voffA);
        if (wr == 1) PG8_BAR;
        PG8_WAIT_V(4); PG8_BAR;
        PG8_STAGE(PG8_SB(1, 0), cB + kstep, voffB); PG8_STAGE(PG8_SA(1, 0), cA + kstep, voffA); PG8_STAGE(PG8_SB(1, 1), cB + hstep + kstep, voffB);
        PG8_WAIT_V(6); PG8_BAR;
    }
    for (;;) {
        const bool has_next = S.next(ui + 1, nxt);
        const char* nA = has_next ? (const char*)g.A + (size_t)nxt.pm * tstep : cA; const char* nB = has_next ? (const char*)g.Bt + (size_t)nxt.pn * tstep : cB;
        for (int t = 0; t < nt; t += 2) {
            const bool last = (t == nt - 2);
            const char* a1 = cA + (size_t)(t + 1) * kstep;
            const char* a2 = last ? nA : cA + (size_t)(t + 2) * kstep; const char* b2 = last ? nB : cB + (size_t)(t + 2) * kstep;
            const char* a3 = a2 + kstep; const char* b3 = b2 + kstep;
            if (last && has_next) S.a_ready(nxt);
            if constexpr (SP2) {
            PG8_LDB(B0, 0, 0); PG8_LDB(B1, 0, 1); PG8_SCHED; PG8_LDA(At, 0, 0); PG8_STAGE(PG8_SA(1, 1), a1 + hstep, voffA);
            PG8_WAIT_V(8); PG8_WAIT_L(0); PG8_BAR; PG8_MMA(0, 0, At, B0); PG8_MMA(0, 1, At, B1); PG8_BAR; PG8_SCHED;
            PG8_LDA(At, 0, 1); PG8_STAGE(PG8_SB(0, 0), b2, voffB); PG8_STAGE(PG8_SB(0, 1), b2 + hstep, voffB); PG8_STAGE(PG8_SA(0, 0), a2, voffA);
            PG8_WAIT_V(8); PG8_WAIT_L(0); PG8_BAR; PG8_MMA(1, 0, At, B0); PG8_MMA(1, 1, At, B1); PG8_BAR; PG8_SCHED;
            PG8_LDB(B0, 1, 0); PG8_LDB(B1, 1, 1); PG8_SCHED; PG8_LDA(At, 1, 0); PG8_STAGE(PG8_SA(0, 1), a2 + hstep, voffA);
            PG8_WAIT_V(8); PG8_WAIT_L(0); PG8_BAR; PG8_MMA(0, 0, At, B0); PG8_MMA(0, 1, At, B1); PG8_BAR; PG8_SCHED;
            PG8_LDA(At, 1, 1); PG8_STAGE(PG8_SB(1, 0), b3, voffB); PG8_STAGE(PG8_SB(1, 1), b3 + hstep, voffB); PG8_STAGE(PG8_SA(1, 0), a3, voffA);
            PG8_WAIT_V(8); PG8_WAIT_L(0); PG8_BAR; PG8_MMA(1, 0, At, B0); PG8_MMA(1, 1, At, B1); PG8_BAR; PG8_SCHED;
            } else {
            PG8_LDB(B0, 0, 0); PG8_SCHED; PG8_LDA(At, 0, 0); PG8_STAGE(PG8_SA(1, 1), a1 + hstep, voffA);
            PG8_WAIT_L(8); PG8_BAR; PG8_WAIT_L(0); PG8_MMA(0, 0, At, B0); PG8_BAR; PG8_SCHED;
            PG8_LDB(B1, 0, 1); PG8_STAGE(PG8_SB(0, 0), b2, voffB);
            PG8_BAR; PG8_WAIT_L(0); PG8_MMA(0, 1, At, B1); PG8_BAR;
            PG8_LDA(At, 0, 1); PG8_STAGE(PG8_SA(0, 0), a2, voffA);
            PG8_BAR; PG8_WAIT_L(0); PG8_MMA(1, 0, At, B0); PG8_BAR; PG8_SCHED;
            PG8_STAGE(PG8_SB(0, 1), b2 + hstep, voffB);
            PG8_WAIT_V(6); PG8_BAR; PG8_MMA(1, 1, At, B1); PG8_BAR;
            PG8_LDB(B0, 1, 0); PG8_SCHED; PG8_LDA(At, 1, 0); PG8_STAGE(PG8_SA(0, 1), a2 + hstep, voffA);
            PG8_WAIT_L(8); PG8_BAR; PG8_WAIT_L(0); PG8_MMA(0, 0, At, B0); PG8_BAR; PG8_SCHED;
            PG8_LDB(B1, 1, 1); PG8_STAGE(PG8_SB(1, 0), b3, voffB);
            PG8_BAR; PG8_WAIT_L(0); PG8_MMA(0, 1, At, B1); PG8_BAR;
            PG8_LDA(At, 1, 1); PG8_STAGE(PG8_SA(1, 0), a3, voffA);
            PG8_BAR; PG8_WAIT_L(0); PG8_MMA(1, 0, At, B0); PG8_BAR; PG8_SCHED;
            PG8_STAGE(PG8_SB(1, 1), b3 + hstep, voffB);
            PG8_WAIT_V(6); PG8_BAR; PG8_MMA(1, 1, At, B1); PG8_BAR;
            }
        }
        if constexpr (ALIGN_EPI) { if (wr == 0) PG8_BAR; }
        if constexpr (!Epi::AFTER_DRAIN) { E(acc, cur, wr, wc, fr, fq); S.done(cur); }
        if (!has_next) break;
#pragma unroll
        for (int a = 0; a < 2; ++a)
#pragma unroll
            for (int b = 0; b < 2; ++b)
#pragma unroll
                for (int m = 0; m < 4; ++m)
#pragma unroll
                    for (int n = 0; n < 2; ++n) acc[a][b][m][n] = (f32x4){0.f, 0.f, 0.f, 0.f};
        cur = nxt; cA = nA; cB = nB; ++ui;
        if constexpr (ALIGN_EPI) { if (wr == 1) PG8_BAR; }
    }
    PG8_WAIT_V(0);
    if constexpr (!ALIGN_EPI) { if (wr == 0) PG8_BAR; }
    PG8_BAR;
    if constexpr (Epi::AFTER_DRAIN) { E.fused(acc, cur, wr, wc, fr, fq, lds, wid, lane); S.done(cur); }
#undef PG8_SA
#undef PG8_SB
#undef PG8_STAGE
#undef PG8_LDA
#undef PG8_LDB
#undef PG8_MMA
#undef PG8_WAIT_V
#undef PG8_WAIT_L
#undef PG8_BAR
#undef PG8_SCHED
}
}

#define GAS __attribute__((address_space(1)))
#define LAS __attribute__((address_space(3)))
typedef unsigned short bf16;
typedef unsigned v4u __attribute__((ext_vector_type(4)));
typedef unsigned v2u __attribute__((ext_vector_type(2)));
typedef float f32x4 __attribute__((ext_vector_type(4)));
typedef short bf16x8 __attribute__((ext_vector_type(8)));
typedef GAS unsigned gu32;
typedef GAS unsigned long long gu64;
#define RLX_AGENT __ATOMIC_RELAXED, __HIP_MEMORY_SCOPE_AGENT
#define LDS_WAIT() asm volatile("s_waitcnt lgkmcnt(0)" ::: "memory")
#define VM_WAIT() asm volatile("s_waitcnt vmcnt(0)" ::: "memory")
__device__ __forceinline__ unsigned long long rt() { return __builtin_amdgcn_s_memrealtime(); }
__device__ __forceinline__ unsigned f2bf(float f) { unsigned u = __builtin_bit_cast(unsigned, f); return (u + 0x7fffu + ((u >> 16) & 1u)) >> 16; }
__device__ __forceinline__ unsigned pk2(float lo, float hi) { return f2bf(lo) | (f2bf(hi) << 16); }

#define XB_TMO      128
#define XB_XCNT(j)  (256  + 64 * (j))
#define XB_XSUB(j)  (1280 + 64 * (j))
#define XB_XGEN(j)  (2304 + 64 * (j))
#define XB_TOP      3328
#define XB_TOPGEN   3392
#define XCD_BAR_WORDS 3456
#define XB_SPIN_CAP (1u << 18)

__device__ __forceinline__ unsigned xb_ld(unsigned* p)              { return __hip_atomic_load(p, __ATOMIC_RELAXED, __HIP_MEMORY_SCOPE_AGENT); }
__device__ __forceinline__ unsigned xb_add(unsigned* p, unsigned v) { return __hip_atomic_fetch_add(p, v, __ATOMIC_RELAXED, __HIP_MEMORY_SCOPE_AGENT); }
__device__ __forceinline__ unsigned xb_xcc_id() { return (unsigned)__builtin_amdgcn_s_getreg((3 << 11) | 20) & 0xFu; }
#define XB_SPIN(cond, bar) do { unsigned _sp = 0; while (cond) { __builtin_amdgcn_s_sleep(1); \
    if ((++_sp & 255u) == 0u) { if (xb_ld(&(bar)[XB_TMO])) break; if (_sp > XB_SPIN_CAP) { atomicAdd(&(bar)[XB_TMO], 1u); break; } } } } while (0)

struct XcdBarrier {
    unsigned* bar; unsigned x;
    volatile LAS unsigned* st;
};

__device__ __forceinline__ XcdBarrier xcd_barrier_post(unsigned* bar, volatile LAS unsigned* st) {
    XcdBarrier b; b.bar = bar; b.x = xb_xcc_id(); b.st = st;
    if (threadIdx.x == 0) (void)xb_add(&bar[XB_XCNT(b.x)], 1u);
    return b;
}
__device__ __forceinline__ void xcd_barrier_complete(unsigned* bar, unsigned x, unsigned& nloc, unsigned& nx) {
    const unsigned G = gridDim.x * gridDim.y * gridDim.z;
    unsigned sum, cnt, mine, sp = 0u;
    for (;;) {
        sum = 0u; cnt = 0u; mine = 0u;
#pragma unroll
        for (unsigned j = 0; j < 16; ++j) { const unsigned c = xb_ld(&bar[XB_XCNT(j)]); sum += c; cnt += (c > 0u) ? 1u : 0u; mine = (j == x) ? c : mine; }
        if (sum == G) break;
        __builtin_amdgcn_s_sleep(1);
        if ((++sp & 255u) == 0u) { if (xb_ld(&bar[XB_TMO])) break; if (sp > XB_SPIN_CAP) { atomicAdd(&bar[XB_TMO], 1u); break; } }
    }
    nloc = mine > 0u ? mine : 1u; nx = cnt > 0u ? cnt : 1u;
}

__device__ __forceinline__ void xcd_barrier(const XcdBarrier& b) {
    asm volatile("s_waitcnt vmcnt(0)" ::: "memory");
    __syncthreads();
    if (threadIdx.x == 0) {
        unsigned* bar = b.bar;
        __builtin_amdgcn_s_waitcnt(0);
        unsigned nloc = b.st[0], nx = b.st[1];
        if (nloc == 0u) { xcd_barrier_complete(bar, b.x, nloc, nx); b.st[0] = nloc; b.st[1] = nx; }
        const unsigned old = xb_add(&bar[XB_XSUB(b.x)], 1u);
        const unsigned gen = old / nloc;
        if (old + 1u == (gen + 1u) * nloc) {
            __builtin_amdgcn_fence(__ATOMIC_RELEASE, "agent");
            asm volatile("s_waitcnt vmcnt(0)" ::: "memory");
            const unsigned og = xb_add(&bar[XB_TOP], 1u);
            const unsigned tg = og / nx;
            if (og + 1u == (tg + 1u) * nx) xb_add(&bar[XB_TOPGEN], 1u);
            else XB_SPIN(xb_ld(&bar[XB_TOPGEN]) == tg, bar);
            __builtin_amdgcn_fence(__ATOMIC_ACQUIRE, "agent");
            xb_add(&bar[XB_XGEN(b.x)], 1u);
            asm volatile("s_waitcnt vmcnt(0)" ::: "memory");
        } else {
            XB_SPIN(xb_ld(&bar[XB_XGEN(b.x)]) == gen, bar);
            __builtin_amdgcn_fence(__ATOMIC_ACQUIRE, "agent");
            asm volatile("s_waitcnt vmcnt(0)" ::: "memory");
        }
    }
    __syncthreads();
}


constexpr int NWAVES = 8;
constexpr int NTOK = 32768, D = 1024, NPROJ = 1792, NLAYER = 4, NEXP = 32, SEQ = 2048, NBATCH = 16, NMEM = 256;
constexpr float LN_EPS = 1e-5f, RMS_EPS = 1e-6f;
constexpr float DN_ALPHA = 1.6817928305074292f;
constexpr int XP_TILES = NTOK * 4 / 256 + NEXP;

constexpr size_t MiB = 1u << 20, TILE = 512 * 1024;
constexpr size_t WS_CTL = 0, CTL_ZERO_BYTES = 1 * MiB;
constexpr size_t WS_WMB = 1 * MiB;
constexpr size_t WS_POOLT = WS_WMB + 512 * 1024;
constexpr size_t WS_WRT = WS_POOLT + 128 * 1024;
constexpr int T_WIN = 4, T_WOUT = T_WIN + 28, T_WKV = T_WOUT + 16, T_MEMN = T_WKV + 8, T_W1 = T_MEMN + 16, T_W2 = T_W1 + 1024, T_HB = T_W2 + 512, T_G = T_HB + 128,
              T_XP = T_G + 128, T_ACT = T_XP + XP_TILES, T_YS = T_ACT + XP_TILES, T_END = T_YS + XP_TILES;
constexpr size_t WS_P = (size_t)T_END * TILE;
constexpr size_t WS_HF = WS_P + 112 * MiB;
constexpr size_t WS_PRE = WS_HF + 128 * MiB;
constexpr size_t WS_KB = WS_PRE + 128 * MiB;
constexpr size_t WS_VT = WS_KB + 8 * MiB;
constexpr size_t WS_TOKES = WS_VT + 8 * MiB;
constexpr size_t WS_TOKG = WS_TOKES + 512 * 1024;
constexpr size_t WS_ROWIDX = WS_TOKG + 512 * 1024;
constexpr size_t WS_NV_VN = WS_ROWIDX + 512 * 1024;
constexpr size_t WS_NV_DP = WS_NV_VN + 32 * MiB;
constexpr size_t WS_NV_Y = WS_NV_DP + 32 * MiB;
constexpr size_t WS_END = WS_NV_Y + 128 * MiB;
constexpr int CW_TMO = 0, CW_CODE = 1;
constexpr int CW_BAR = 4096;
constexpr int CW_CNT = 16384;
static_assert((CW_CNT + NLAYER * NEXP * 16) * 4 <= (int)CTL_ZERO_BYTES, "CTL words inside the memset region");
constexpr int RING_OFF = 0, RING_BYTES = 131072;
constexpr int LDSCTL_OFF = 147456 - 1024, MISC_OFF = LDSCTL_OFF + 320, TOFF_OFF = MISC_OFF + 128;
constexpr int LDS_BYTES = 147456;
static_assert(TOFF_OFF + 160 <= LDS_BYTES, "LDS map");

__device__ __forceinline__ float bf2f(unsigned short b) { return __builtin_bit_cast(float, (unsigned)b << 16); }
__device__ __forceinline__ float wave_sum(float v) {
#pragma unroll
    for (int o = 1; o < 64; o <<= 1) v += __shfl_xor(v, o);
    return v;
}
__device__ __forceinline__ float gelu_tanh(float x) {
    const float u = 0.7978845608028654f * (x + 0.044715f * x * x * x);
    return x * __builtin_amdgcn_rcpf(1.0f + __builtin_amdgcn_exp2f(u * (-2.0f * 1.4426950408889634f)));
}

struct Frame {
    LAS unsigned char* lds;
    volatile LAS unsigned* MISC;
    gu32* ctl;
    unsigned char* ws;
    int tid, lane, wave, G;
    float* out;
};
struct Args { const float* in[27]; float* out; unsigned char* ws; int ph_lo, ph_hi; };
enum { I_X = 0, I_MEM, I_LN_IN_G, I_LN_IN_B, I_MEM_LN_G, I_MEM_LN_B, I_W_IN, I_CONV_W, I_POOL_W, I_POOL_SCALE, I_GMLP_LN_G, I_GMLP_LN_B, I_GMLP_W, I_GMLP_B, I_W_MEM_KV, I_GROUP_NORM_G, I_W_OUT,
       I_LN1_G, I_LN1_B, I_W_ROUTER, I_B_ROUTER, I_W1, I_B1, I_W2, I_B2, I_LN2_G, I_LN2_B };
#define RELANE(F) do { int t_ = threadIdx.x; asm volatile("" : "+v"(t_)); (F).tid = t_; (F).lane = t_ & 63; (F).wave = __builtin_amdgcn_readfirstlane(t_ >> 6); } while (0)
#define WSP(T, off) ((T*)(F.ws + (off)))
#define TILEP(t) ((bf16*)(F.ws + (size_t)(t) * TILE))

__device__ __forceinline__ void tr64(const float* W, int ldw, int k0, int n0, bf16* WT, int ldt, int drow0, LAS float* scr, int lane) {
    const int c4 = 4 * (lane & 15), kq = lane >> 4;
#pragma unroll
    for (int i = 0; i < 16; ++i) { const int kk = 4 * i + kq; const f32x4 v = *(const f32x4*)(W + (size_t)(k0 + kk) * ldw + n0 + c4);
        LAS float* s = scr + kk * 65 + c4; s[0] = v.x; s[1] = v.y; s[2] = v.z; s[3] = v.w; }
    LDS_WAIT(); asm volatile("" ::: "memory");
    const int ck = lane & 7;
#pragma unroll
    for (int j = 0; j < 8; ++j) { const int n = (lane >> 3) + 8 * j; const LAS float* s = scr + (8 * ck) * 65 + n;
        v4u o; o.x = pk2(s[0 * 65], s[1 * 65]); o.y = pk2(s[2 * 65], s[3 * 65]); o.z = pk2(s[4 * 65], s[5 * 65]); o.w = pk2(s[6 * 65], s[7 * 65]);
        *(v4u*)(WT + (size_t)(drow0 + n) * ldt + k0 + 8 * ck) = o; }
    LDS_WAIT(); asm volatile("" ::: "memory");
}
__device__ __forceinline__ void ln_affine(f32x4 (&v)[4], const float* gam, const float* bet, int lane) {
    float s = 0.f;
#pragma unroll
    for (int j = 0; j < 4; ++j) s += (v[j].x + v[j].y) + (v[j].z + v[j].w);
    const float mean = wave_sum(s) * (1.f / 1024.f); float s2 = 0.f;
#pragma unroll
    for (int j = 0; j < 4; ++j) { v[j] = v[j] - mean; s2 += (v[j].x * v[j].x + v[j].y * v[j].y) + (v[j].z * v[j].z + v[j].w * v[j].w); }
    const float rstd = 1.f / sqrtf(wave_sum(s2) * (1.f / 1024.f) + LN_EPS);
#pragma unroll
    for (int j = 0; j < 4; ++j) { const f32x4 g = *(const f32x4*)(gam + 4 * lane + 256 * j), b = *(const f32x4*)(bet + 4 * lane + 256 * j); v[j] = v[j] * rstd * g + b; }
}
__device__ __forceinline__ void store_row_bf16(bf16* orow, const f32x4 (&v)[4], int lane) {
#pragma unroll
    for (int j = 0; j < 4; ++j) { v2u o; o.x = pk2(v[j].x, v[j].y); o.y = pk2(v[j].z, v[j].w); *(v2u*)(orow + 4 * lane + 256 * j) = o; }
}
__device__ __forceinline__ void p0_prologue(Frame& F, const Args& A) {
    RELANE(F);
    LAS float* scr = (LAS float*)(F.lds + RING_OFF + F.wave * 16640);
    const int gw = blockIdx.x * NWAVES + F.wave, NGW = F.G * NWAVES;
    constexpr int NI_W1 = NLAYER * NEXP * 16 * 32, NI_W2 = NLAYER * NEXP * 16 * 16, NI_WIN = NLAYER * 16 * 28, NI_WOUT = NLAYER * 16 * 16, NI_WKV = NLAYER * 16 * 8, NI_POOL = NLAYER * 4;
    constexpr int NITEMS = NI_W1 + NI_W2 + NI_WIN + NI_WOUT + NI_WKV + NI_POOL;
    for (int it = gw; it < NITEMS; it += NGW) {
        int r = it;
        if (r < NI_W1) { const int le = r >> 9, rr = r & 511, kb = rr >> 5, nb = rr & 31; const int n0 = 64 * nb, nn = n0 & 1023;
            const int drow = (nn >> 7) * 256 + (n0 >= 1024 ? 128 : 0) + (nn & 127);
            tr64(A.in[I_W1] + (size_t)le * 1024 * 2048, 2048, 64 * kb, n0, TILEP(T_W1) + (size_t)le * 2048 * 1024, 1024, drow, scr, F.lane); continue; } r -= NI_W1;
        if (r < NI_W2) { const int le = r >> 8, rr = r & 255, kb = rr >> 4, nb = rr & 15;
            tr64(A.in[I_W2] + (size_t)le * 1024 * 1024, 1024, 64 * kb, 64 * nb, TILEP(T_W2) + (size_t)le * 1024 * 1024, 1024, 64 * nb, scr, F.lane); continue; } r -= NI_W2;
        if (r < NI_WIN) { const int l = r / 448, rr = r % 448, kb = rr / 28, nb = rr % 28;
            tr64(A.in[I_W_IN] + (size_t)l * 1024 * NPROJ, NPROJ, 64 * kb, 64 * nb, TILEP(T_WIN) + (size_t)l * NPROJ * 1024, 1024, 64 * nb, scr, F.lane); continue; } r -= NI_WIN;
        if (r < NI_WOUT) { const int l = r >> 8, rr = r & 255, kb = rr >> 4, nb = rr & 15;
            tr64(A.in[I_W_OUT] + (size_t)l * 1024 * 1024, 1024, 64 * kb, 64 * nb, TILEP(T_WOUT) + (size_t)l * 1024 * 1024, 1024, 64 * nb, scr, F.lane); continue; } r -= NI_WOUT;
        if (r < NI_WKV) { const int l = r >> 7, rr = r & 127, kb = rr >> 3, nb = rr & 7;
            tr64(A.in[I_W_MEM_KV] + (size_t)l * 1024 * 512, 512, 64 * kb, 64 * nb, TILEP(T_WKV) + (size_t)l * 512 * 1024, 1024, 64 * nb, scr, F.lane); continue; } r -= NI_WKV;
        tr64(A.in[I_POOL_W] + (size_t)r * 64 * 64, 64, 0, 0, WSP(bf16, WS_POOLT) + (size_t)r * 64 * 64, 64, 0, scr, F.lane);
    }
    const int gt = blockIdx.x * (NWAVES * 64) + F.tid, NGT = F.G * NWAVES * 64;
    for (int i = gt; i < NLAYER * 4 * 128 * 128; i += NGT) { const int j = i & 127, ii = (i >> 7) & 127; WSP(bf16, WS_WMB)[i] = (bf16)(((j >> 6) <= (ii >> 6)) ? f2bf(A.in[I_GMLP_W][i]) : 0u); }
    for (int i = gt; i < NLAYER * 32 * 1024; i += NGT) { const int k = i & 1023, e = (i >> 10) & 31, l = i >> 15; WSP(bf16, WS_WRT)[i] = (bf16)f2bf(A.in[I_W_ROUTER][((size_t)l * 1024 + k) * 32 + e]); }
    for (int m = gw; m < NTOK + NBATCH * NMEM; m += NGW) {
        const bool ismem = m >= NTOK; const int row = ismem ? m - NTOK : m;
        const float* src = (ismem ? A.in[I_MEM] : A.in[I_X]) + (size_t)row * D;
        f32x4 v[4];
#pragma unroll
        for (int j = 0; j < 4; ++j) v[j] = *(const f32x4*)(src + 4 * F.lane + 256 * j);
        ln_affine(v, ismem ? A.in[I_MEM_LN_G] : A.in[I_LN_IN_G], ismem ? A.in[I_MEM_LN_B] : A.in[I_LN_IN_B], F.lane);
        if (!ismem) {
            float* hf = WSP(float, WS_HF) + (size_t)row * D;
#pragma unroll
            for (int j = 0; j < 4; ++j) *(f32x4*)(hf + 4 * F.lane + 256 * j) = v[j];
        }
        store_row_bf16((ismem ? TILEP(T_MEMN) : TILEP(T_HB)) + (size_t)row * D, v, F.lane);
    }
}

struct DenseOrder {
    int nM, nN, G, c, a_t0, b_t0;
    __device__ __forceinline__ bool next(int i, pg8::Unit& u) const {
        const long L = (long)i * G + c; if (L >= (long)nM * nN) return false;
        int tm, tn; pg8::tile_of((int)L, nM, nN, tm, tn); u.pm = a_t0 + tm; u.pn = b_t0 + tn; u.lm = tm; u.ln = tn; u.a0 = 0; return true;
    }
    __device__ __forceinline__ void a_ready(const pg8::Unit&) const {}
    __device__ __forceinline__ void done(const pg8::Unit&) const {}
};
struct KvOrder {
    int G, c;
    __device__ __forceinline__ bool next(int i, pg8::Unit& u) const {
        const int L = i * G + c; if (L >= NLAYER * 32) return false;
        const int l = L >> 5, r = L & 31;
        if (r < 16) { u.pm = T_MEMN + r; u.pn = T_WKV + 2 * l; u.lm = l * 16 + r; u.ln = 0; u.a0 = 0; }
        else { u.pm = T_WKV + 2 * l + 1; u.pn = T_MEMN + (r - 16); u.lm = l; u.ln = r - 16; u.a0 = 1; }
        return true;
    }
    __device__ __forceinline__ void a_ready(const pg8::Unit&) const {}
    __device__ __forceinline__ void done(const pg8::Unit&) const {}
};
struct MoeOrder {
    int TM, NTN, G, c, a_t0, b_t0; const LAS int* toff;
    __device__ __forceinline__ bool next(int i, pg8::Unit& u) const {
        const long L = (long)i * G + c; if (L >= (long)TM * NTN) return false;
        int tm, tn; pg8::tile_of((int)L, TM, NTN, tm, tn);
        int e = 0;
#pragma unroll
        for (int j = 1; j < NEXP; ++j) e += (toff[j] <= tm) ? 1 : 0;
        e = __builtin_amdgcn_readfirstlane(e);
        u.pm = a_t0 + tm; u.pn = b_t0 + e * NTN + tn; u.lm = tm; u.ln = tn; u.a0 = e; return true;
    }
    __device__ __forceinline__ void a_ready(const pg8::Unit&) const {}
    __device__ __forceinline__ void done(const pg8::Unit&) const {}
};
__device__ __forceinline__ void compute_toff(Frame& F, int l) {
    RELANE(F);
    LAS int* toff = (LAS int*)(F.lds + TOFF_OFF);
    __syncthreads();
    if (F.wave == 0) {
        int t = 0;
        if (F.lane < NEXP) { const unsigned c = __hip_atomic_load(F.ctl + CW_CNT + (l * NEXP + F.lane) * 16, RLX_AGENT); t = (int)((c + 255u) >> 8); }
        int incl = t;
#pragma unroll
        for (int o = 1; o < 32; o <<= 1) { const int y = __shfl_up(incl, o); if ((F.lane & 31) >= o) incl += y; }
        if (F.lane < NEXP) toff[F.lane + 1] = incl;
        if (F.lane == 0) toff[0] = 0;
    }
    __syncthreads();
}

__device__ __forceinline__ void pd_phase(Frame& F, const Args& A, int l) {
    RELANE(F);
    LAS unsigned char* T = F.lds;
    LAS float* part = (LAS float*)(F.lds + 66048);
    LAS float* logit = (LAS float*)(F.lds + 82432);
    LAS int* cntl = (LAS int*)(F.lds + 86656);
    LAS int* basel = (LAS int*)(F.lds + 86784);
    LAS int* sel_e = (LAS int*)(F.lds + 86912);
    LAS int* sel_r = sel_e + 512; LAS float* sel_g = (LAS float*)(sel_r + 512);
    const float* gam = A.in[I_LN1_G] + l * D; const float* bet = A.in[I_LN1_B] + l * D;
    const bf16* wr = WSP(bf16, WS_WRT) + (size_t)l * NEXP * D; const float* br = A.in[I_B_ROUTER] + l * NEXP;
    const float* pre = WSP(float, WS_PRE); float* hf = WSP(float, WS_HF); bf16* hb = TILEP(T_HB);
    const int r16 = F.lane & 15, g4 = F.lane >> 4;
    for (int blk = blockIdx.x; blk < NTOK / 128; blk += F.G) {
        if (F.tid < NEXP) cntl[F.tid] = 0;
        __syncthreads();
        for (int it = 0; it < 4; ++it) {
            const int r0 = blk * 128 + it * 32;
#pragma unroll 1
            for (int q = 0; q < 4; ++q) {
                const int lr = F.wave * 4 + q; const size_t row = (size_t)(r0 + lr);
                f32x4 v[4];
#pragma unroll
                for (int j = 0; j < 4; ++j) v[j] = *(const f32x4*)(pre + row * D + 4 * F.lane + 256 * j);
                ln_affine(v, gam, bet, F.lane);
#pragma unroll
                for (int j = 0; j < 4; ++j) { *(f32x4*)(hf + row * D + 4 * F.lane + 256 * j) = v[j];
                    v2u o; o.x = pk2(v[j].x, v[j].y); o.y = pk2(v[j].z, v[j].w);
                    *(v2u*)(hb + row * D + 4 * F.lane + 256 * j) = o; *(LAS v2u*)(T + lr * 2064 + (4 * F.lane + 256 * j) * 2) = o; }
            }
            __syncthreads();
            {
                const int mt = F.wave & 1, kq = F.wave >> 1;
                f32x4 a0 = {0.f, 0.f, 0.f, 0.f}, a1 = {0.f, 0.f, 0.f, 0.f};
#pragma unroll
                for (int ks = 0; ks < 8; ++ks) { const int k0 = 256 * kq + 32 * ks + 8 * g4;
                    const bf16x8 a = *(const LAS bf16x8*)(T + (16 * mt + r16) * 2064 + k0 * 2);
                    const bf16x8 b0 = *(const bf16x8*)(wr + (size_t)r16 * D + k0), b1 = *(const bf16x8*)(wr + (size_t)(16 + r16) * D + k0);
                    a0 = __builtin_amdgcn_mfma_f32_16x16x32_bf16(a, b0, a0, 0, 0, 0); a1 = __builtin_amdgcn_mfma_f32_16x16x32_bf16(a, b1, a1, 0, 0, 0); }
#pragma unroll
                for (int i = 0; i < 4; ++i) { part[kq * 1024 + (16 * mt + 4 * g4 + i) * 32 + r16] = a0[i]; part[kq * 1024 + (16 * mt + 4 * g4 + i) * 32 + 16 + r16] = a1[i]; }
            }
            __syncthreads();
            for (int idx = F.tid; idx < 1024; idx += NWAVES * 64) { const int rr = idx >> 5, e = idx & 31;
                logit[rr * 33 + e] = ((part[idx] + part[1024 + idx]) + (part[2048 + idx] + part[3072 + idx])) + br[e]; }
            __syncthreads();
            if (F.tid < 32) {
                const LAS float* lg = logit + F.tid * 33; float tv[4]; int ti[4];
#pragma unroll
                for (int k = 0; k < 4; ++k) { float best = -3.0e38f; int bi = 0;
                    for (int e = 0; e < NEXP; ++e) { const float x = lg[e]; bool taken = false;
#pragma unroll
                        for (int kk = 0; kk < 4; ++kk) if (kk < k && ti[kk] == e) taken = true;
                        if (!taken && x > best) { best = x; bi = e; } }
                    tv[k] = best; ti[k] = bi; }
                float ex[4], sum = 0.f;
#pragma unroll
                for (int k = 0; k < 4; ++k) { ex[k] = __expf(tv[k] - tv[0]); sum += ex[k]; }
                const float inv = 1.0f / sum;
#pragma unroll
                for (int k = 0; k < 4; ++k) { const int p = (it * 32 + F.tid) * 4 + k; sel_e[p] = ti[k]; sel_r[p] = __hip_atomic_fetch_add(cntl + ti[k], 1, __ATOMIC_RELAXED, __HIP_MEMORY_SCOPE_WORKGROUP); sel_g[p] = ex[k] * inv; }
            }
        }
        __syncthreads();
        if (F.tid < NEXP) basel[F.tid] = (int)__hip_atomic_fetch_add(F.ctl + CW_CNT + (l * NEXP + F.tid) * 16, (unsigned)cntl[F.tid], RLX_AGENT);
        __syncthreads();
        { const int p = F.tid, e = sel_e[p], slot = basel[e] + sel_r[p];
          WSP(int, WS_TOKES)[(size_t)blk * 512 + p] = (e << 16) | slot; WSP(float, WS_TOKG)[(size_t)blk * 512 + p] = sel_g[p]; }
        __syncthreads();
    }
}
__device__ __forceinline__ void pe_phase(Frame& F, int l) {
    RELANE(F);
    compute_toff(F, l);
    const LAS int* toff = (const LAS int*)(F.lds + TOFF_OFF);
    const bf16* hb = TILEP(T_HB); bf16* xp = TILEP(T_XP);
    for (int blk = blockIdx.x; blk < NTOK / 128; blk += F.G) {
        const int p0 = blk * 512 + F.wave * 64;
        const int es = WSP(int, WS_TOKES)[p0 + F.lane];
        const int rowl = toff[es >> 16] * 256 + (es & 0xffff);
        WSP(int, WS_ROWIDX)[p0 + F.lane] = rowl;
#pragma unroll 4
        for (int p = 0; p < 64; ++p) { const int row = __shfl(rowl, p); const int t = (p0 + p) >> 2;
            const v4u a = *(const v4u*)(hb + (size_t)t * D + 8 * F.lane), b = *(const v4u*)(hb + (size_t)t * D + 512 + 8 * F.lane);
            *(v4u*)(xp + (size_t)row * D + 8 * F.lane) = a; *(v4u*)(xp + (size_t)row * D + 512 + 8 * F.lane) = b; }
    }
}
__device__ __forceinline__ void ph_phase(Frame& F, const Args& A, int l) {
    RELANE(F);
    const int gw = blockIdx.x * NWAVES + F.wave, NGW = F.G * NWAVES;
    const float* gam = A.in[I_LN2_G] + l * D; const float* bet = A.in[I_LN2_B] + l * D;
    float* hf = WSP(float, WS_HF); bf16* hb = TILEP(T_HB); const bf16* ys = TILEP(T_YS);
    for (int t = gw; t < NTOK; t += NGW) {
        int ri = 0; float gk = 0.f;
        if (F.lane < 4) { ri = WSP(int, WS_ROWIDX)[(size_t)t * 4 + F.lane]; gk = WSP(float, WS_TOKG)[(size_t)t * 4 + F.lane]; }
        f32x4 v[4];
#pragma unroll
        for (int j = 0; j < 4; ++j) v[j] = *(const f32x4*)(hf + (size_t)t * D + 4 * F.lane + 256 * j) * DN_ALPHA;
#pragma unroll
        for (int k = 0; k < 4; ++k) { const int row = __shfl(ri, k); const float g = __shfl(gk, k);
#pragma unroll
            for (int j = 0; j < 4; ++j) { const v2u raw = *(const v2u*)(ys + (size_t)row * D + 4 * F.lane + 256 * j);
                v[j].x += g * __builtin_bit_cast(float, raw.x << 16); v[j].y += g * __builtin_bit_cast(float, raw.x & 0xffff0000u);
                v[j].z += g * __builtin_bit_cast(float, raw.y << 16); v[j].w += g * __builtin_bit_cast(float, raw.y & 0xffff0000u); } }
        ln_affine(v, gam, bet, F.lane);
        if (l == NLAYER - 1) {
#pragma unroll
            for (int j = 0; j < 4; ++j) *(f32x4*)(F.out + (size_t)t * D + 4 * F.lane + 256 * j) = v[j];
        } else {
#pragma unroll
            for (int j = 0; j < 4; ++j) *(f32x4*)(hf + (size_t)t * D + 4 * F.lane + 256 * j) = v[j];
            store_row_bf16(hb + (size_t)t * D, v, F.lane);
        }
    }
}

constexpr int MX_VT = 0, MX_K = 65536, MX_V = 65536 + 32768;
__device__ __forceinline__ void unpack8(const v4u raw, float (&f)[8]) {
    f[0] = __builtin_bit_cast(float, raw.x << 16); f[1] = __builtin_bit_cast(float, raw.x & 0xffff0000u); f[2] = __builtin_bit_cast(float, raw.y << 16); f[3] = __builtin_bit_cast(float, raw.y & 0xffff0000u);
    f[4] = __builtin_bit_cast(float, raw.z << 16); f[5] = __builtin_bit_cast(float, raw.z & 0xffff0000u); f[6] = __builtin_bit_cast(float, raw.w << 16); f[7] = __builtin_bit_cast(float, raw.w & 0xffff0000u);
}
__device__ __forceinline__ void mix_finish(float (&val)[8][8], const float* gain, bf16* grow, int q) {
    float ss = 0.f;
#pragma unroll
    for (int cb = 0; cb < 8; ++cb)
#pragma unroll
        for (int i = 0; i < 8; ++i) ss += val[cb][i] * val[cb][i];
    ss += __shfl_xor(ss, 16); ss += __shfl_xor(ss, 32);
    const float rs = 1.0f / sqrtf(ss * (1.0f / 256.0f) + RMS_EPS);
#pragma unroll
    for (int cb = 0; cb < 8; ++cb) { const f32x4 g0 = *(const f32x4*)(gain + 32 * cb + 8 * q), g1 = *(const f32x4*)(gain + 32 * cb + 8 * q + 4);
        v4u o; o.x = pk2(val[cb][0] * rs * g0.x, val[cb][1] * rs * g0.y); o.y = pk2(val[cb][2] * rs * g0.z, val[cb][3] * rs * g0.w);
        o.z = pk2(val[cb][4] * rs * g1.x, val[cb][5] * rs * g1.y); o.w = pk2(val[cb][6] * rs * g1.z, val[cb][7] * rs * g1.w);
        *(v4u*)(grow + 32 * cb + 8 * q) = o; }
}
__device__ __forceinline__ void pb_phase(Frame& F, const Args& A, int l) {
    for (int u = blockIdx.x; u < NTOK / 128; u += F.G) {
    RELANE(F);
    const int r = F.lane & 15, q = F.lane >> 4, w = F.wave;
    const bf16* P = WSP(bf16, WS_P); bf16* G = TILEP(T_G);
    const float* gng = A.in[I_GROUP_NORM_G] + l * 1024;
        const int row = u * 128 + 16 * w + r, tseq = (u & 15) * 128 + 16 * w + r, b = u >> 4;
        const bf16* prow = P + (size_t)row * NPROJ; bf16* grow = G + (size_t)row * 1024;
        float val[8][8];
#if MXMASK & 1
        {
            const float* cw = A.in[I_CONV_W] + l * 768;
#pragma unroll
            for (int cb = 0; cb < 8; ++cb) { const int col = 32 * cb + 8 * q;
                float gb[8], zc[8], zh[8], z[8], acc[8];
                unpack8(*(const v4u*)(prow + col), gb);
#pragma unroll
                for (int i = 0; i < 8; ++i) acc[i] = 0.f;
#pragma unroll
                for (int d = 0; d < 3; ++d) {
                    if (tseq - 2 + d >= 0) { const bf16* pr = prow - (size_t)(2 - d) * NPROJ;
                        unpack8(*(const v4u*)(pr + 256 + col), zc); unpack8(*(const v4u*)(pr + 512 + col), zh);
                        const f32x4 w0 = *(const f32x4*)(cw + d * 256 + col), w1 = *(const f32x4*)(cw + d * 256 + col + 4);
#pragma unroll
                        for (int i = 0; i < 8; ++i) z[i] = zc[i] * zh[i];
                        acc[0] += w0.x * z[0]; acc[1] += w0.y * z[1]; acc[2] += w0.z * z[2]; acc[3] += w0.w * z[3]; acc[4] += w1.x * z[4]; acc[5] += w1.y * z[5]; acc[6] += w1.z * z[6]; acc[7] += w1.w * z[7]; } }
#pragma unroll
                for (int i = 0; i < 8; ++i) val[cb][i] = gb[i] * acc[i];
                asm volatile("" ::: "memory"); }
            mix_finish(val, gng, grow, q);
        }
#endif
        asm volatile("" ::: "memory"); __builtin_amdgcn_sched_barrier(0);
#if MXMASK & 2
        {
            const bf16* pt = WSP(bf16, WS_POOLT) + (size_t)l * 4 * 4096;
            bf16x8 dfr[4][2];
#pragma unroll
            for (int g = 0; g < 4; ++g)
#pragma unroll
                for (int ks = 0; ks < 2; ++ks) { const int col = 768 + g * 64 + 32 * ks + 8 * q, wlen = 2 << g;
                    float acc[8], x[8], t8[8];
                    unpack8(*(const v4u*)(prow + col), x);
#pragma unroll
                    for (int i = 0; i < 8; ++i) acc[i] = x[i];
                    for (int d = 1; d < wlen; ++d) if (tseq - d >= 0) { unpack8(*(const v4u*)(prow - (size_t)d * NPROJ + col), t8);
#pragma unroll
                        for (int i = 0; i < 8; ++i) acc[i] += t8[i]; }
                    const float inv = 1.0f / (float)((tseq + 1 < wlen) ? tseq + 1 : wlen);
                    v4u o; o.x = pk2(acc[0] * inv - x[0], acc[1] * inv - x[1]); o.y = pk2(acc[2] * inv - x[2], acc[3] * inv - x[3]);
                    o.z = pk2(acc[4] * inv - x[4], acc[5] * inv - x[5]); o.w = pk2(acc[6] * inv - x[6], acc[7] * inv - x[7]);
                    dfr[g][ks] = __builtin_bit_cast(bf16x8, o);
                    asm volatile("" ::: "memory"); }
            const float* psc = A.in[I_POOL_SCALE] + l * 256;
#pragma unroll
            for (int g = 0; g < 4; ++g)
#pragma unroll
                for (int mt2 = 0; mt2 < 2; ++mt2) { const f32x4 s0 = *(const f32x4*)(psc + g * 64 + 32 * mt2 + 8 * q), s1 = *(const f32x4*)(psc + g * 64 + 32 * mt2 + 8 * q + 4);
#pragma unroll
                    for (int e = 0; e < 2; ++e) { const int dd = 32 * mt2 + 8 * (r >> 2) + 4 * e + (r & 3);
                        f32x4 o = {0.f, 0.f, 0.f, 0.f};
#pragma unroll
                        for (int ks = 0; ks < 2; ++ks) { const bf16x8 a = *(const bf16x8*)(pt + (size_t)(g * 64 + dd) * 64 + 32 * ks + 8 * q);
                            o = __builtin_amdgcn_mfma_f32_16x16x32_bf16(a, dfr[g][ks], o, 0, 0, 0); }
                        const f32x4 sc = e ? s1 : s0;
                        val[2 * g + mt2][4 * e + 0] = o[0] * sc.x; val[2 * g + mt2][4 * e + 1] = o[1] * sc.y; val[2 * g + mt2][4 * e + 2] = o[2] * sc.z; val[2 * g + mt2][4 * e + 3] = o[3] * sc.w; } }
            mix_finish(val, gng + 256, grow + 256, q);
        }
#endif
        asm volatile("" ::: "memory"); __builtin_amdgcn_sched_barrier(0);
#if MXMASK & 4
        {
            const float* lg = A.in[I_GMLP_LN_G] + l * 256; const float* lb = A.in[I_GMLP_LN_B] + l * 256;
            const f32x4 g4 = *(const f32x4*)(lg + 4 * F.lane), b4 = *(const f32x4*)(lb + 4 * F.lane);
            const int hh_l = F.lane >> 4, mt2_l = (F.lane & 15) >> 3, q_l = (F.lane & 7) >> 1, e_l = F.lane & 1;
#pragma unroll 2
            for (int jp = 0; jp < 8; ++jp) { const int j = 16 * w + 2 * jp;
                const bf16* p0 = P + (size_t)(u * 128 + j) * NPROJ + 1280 + 4 * F.lane;
                const v2u ra = *(const v2u*)p0, rb = *(const v2u*)(p0 + NPROJ);
                float va[4], vb[4];
                va[0] = gelu_tanh(__builtin_bit_cast(float, ra.x << 16)); va[1] = gelu_tanh(__builtin_bit_cast(float, ra.x & 0xffff0000u)); va[2] = gelu_tanh(__builtin_bit_cast(float, ra.y << 16)); va[3] = gelu_tanh(__builtin_bit_cast(float, ra.y & 0xffff0000u));
                vb[0] = gelu_tanh(__builtin_bit_cast(float, rb.x << 16)); vb[1] = gelu_tanh(__builtin_bit_cast(float, rb.x & 0xffff0000u)); vb[2] = gelu_tanh(__builtin_bit_cast(float, rb.y << 16)); vb[3] = gelu_tanh(__builtin_bit_cast(float, rb.y & 0xffff0000u));
                const float ma = wave_sum((va[0] + va[1]) + (va[2] + va[3])) * (1.f / 256.f), mb = wave_sum((vb[0] + vb[1]) + (vb[2] + vb[3])) * (1.f / 256.f);
                float sa = 0.f, sb = 0.f;
#pragma unroll
                for (int c = 0; c < 4; ++c) { va[c] -= ma; vb[c] -= mb; sa += va[c] * va[c]; sb += vb[c] * vb[c]; }
                const float ra_ = 1.f / sqrtf(wave_sum(sa) * (1.f / 256.f) + LN_EPS), rb_ = 1.f / sqrtf(wave_sum(sb) * (1.f / 256.f) + LN_EPS);
                const int ks = j >> 5, gg = (j & 31) >> 3, jj = j & 7;
                LAS unsigned char* dst = F.lds + MX_VT + ((((hh_l * 2 + mt2_l) * 2 + e_l) * 4 + ks) * 64 + 16 * gg + 4 * q_l) * 16 + jj * 2;
                const float ga[4] = {g4.x, g4.y, g4.z, g4.w}, ba[4] = {b4.x, b4.y, b4.z, b4.w};
#pragma unroll
                for (int c = 0; c < 4; ++c) *(LAS unsigned*)(dst + c * 16) = pk2(va[c] * ra_ * ga[c] + ba[c], vb[c] * rb_ * ga[c] + ba[c]);
            }
            __syncthreads();
            const bf16* wm = WSP(bf16, WS_WMB) + (size_t)l * 4 * 128 * 128; const float* gbias = A.in[I_GMLP_B] + l * 512;
            const int nks = (w < 4) ? 2 : 4;
#pragma unroll
            for (int hh = 0; hh < 4; ++hh) {
                bf16x8 wf[4];
#pragma unroll
                for (int ks = 0; ks < 4; ++ks) wf[ks] = *(const bf16x8*)(wm + (size_t)(hh * 128 + 16 * w + r) * 128 + 32 * ks + 8 * q);
                const float bias = gbias[hh * 128 + 16 * w + r];
#pragma unroll
                for (int mt2 = 0; mt2 < 2; ++mt2) {
                    float uu[8]; unpack8(*(const v4u*)(prow + 1024 + hh * 64 + 32 * mt2 + 8 * q), uu);
#pragma unroll
                    for (int e = 0; e < 2; ++e) { f32x4 o = {0.f, 0.f, 0.f, 0.f};
#pragma unroll
                        for (int ks = 0; ks < 4; ++ks) if (ks < nks) { const bf16x8 a = *(const LAS bf16x8*)(F.lds + MX_VT + ((((hh * 2 + mt2) * 2 + e) * 4 + ks) * 64 + F.lane) * 16);
                            o = __builtin_amdgcn_mfma_f32_16x16x32_bf16(a, wf[ks], o, 0, 0, 0); }
#pragma unroll
                        for (int i = 0; i < 4; ++i) val[2 * hh + mt2][4 * e + i] = gelu_tanh(uu[4 * e + i]) * (o[i] + bias); } }
            }
            mix_finish(val, gng + 512, grow + 512, q);
        }
#endif
        asm volatile("" ::: "memory"); __builtin_amdgcn_sched_barrier(0);
#if MXMASK & 8
        {
            const bf16* kb = WSP(bf16, WS_KB) + ((size_t)l * 4096 + (size_t)b * 256) * 256;
            const bf16* vt = WSP(bf16, WS_VT) + (size_t)l * 256 * 4096 + (size_t)b * 256;
            float rsum[4];
#pragma unroll
            for (int hh = 0; hh < 4; ++hh) {
                __syncthreads();
#pragma unroll
                for (int i = 0; i < 4; ++i) { const int idx = F.tid + 512 * i;
                    { const int key = idx >> 3, cidx = idx & 7; const v4u x = *(const v4u*)(kb + (size_t)key * 256 + hh * 64 + 8 * cidx);
                      *(LAS v4u*)(F.lds + MX_K + ((((key >> 4) * 2 + (cidx >> 2)) * 64) + 16 * (cidx & 3) + (key & 15)) * 16) = x; }
                    { const int d = idx >> 5, c16 = idx & 31; const v4u x = *(const v4u*)(vt + (size_t)(hh * 64 + d) * 4096 + 8 * c16);
                      const int key0 = 8 * c16, s = key0 >> 5, kk = key0 & 31, half = kk >> 4, gA = (kk & 15) >> 2, mt2 = d >> 5, rem = d & 31, m = 4 * (rem >> 3) + (rem & 3), e = (rem >> 2) & 1;
                      LAS unsigned char* dst = F.lds + MX_V + ((((mt2 * 2 + e) * 8 + s) * 64) + 16 * gA + m) * 16 + half * 8;
                      v2u lo; lo.x = x.x; lo.y = x.y; v2u hi; hi.x = x.z; hi.y = x.w; *(LAS v2u*)dst = lo; *(LAS v2u*)(dst + 256) = hi; } }
                const bf16x8 q0 = *(const bf16x8*)(prow + 1536 + hh * 64 + 8 * q), q1 = *(const bf16x8*)(prow + 1536 + hh * 64 + 32 + 8 * q);
                __syncthreads();
                f32x4 st[16];
#pragma unroll
                for (int t = 0; t < 16; ++t) { const bf16x8 k0 = *(const LAS bf16x8*)(F.lds + MX_K + ((t * 2 + 0) * 64 + F.lane) * 16), k1 = *(const LAS bf16x8*)(F.lds + MX_K + ((t * 2 + 1) * 64 + F.lane) * 16);
                    f32x4 z = {0.f, 0.f, 0.f, 0.f}; z = __builtin_amdgcn_mfma_f32_16x16x32_bf16(k0, q0, z, 0, 0, 0); st[t] = __builtin_amdgcn_mfma_f32_16x16x32_bf16(k1, q1, z, 0, 0, 0); }
                float mx = -3.0e38f;
#pragma unroll
                for (int t = 0; t < 16; ++t) mx = fmaxf(fmaxf(mx, fmaxf(st[t][0], st[t][1])), fmaxf(st[t][2], st[t][3]));
                mx = fmaxf(mx, __shfl_xor(mx, 16)); mx = fmaxf(mx, __shfl_xor(mx, 32));
                float sum = 0.f; const float c2 = 0.125f * 1.4426950408889634f, mo = mx * c2;
#pragma unroll
                for (int t = 0; t < 16; ++t)
#pragma unroll
                    for (int i = 0; i < 4; ++i) { const float p = __builtin_amdgcn_exp2f(st[t][i] * c2 - mo); st[t][i] = p; sum += p; }
                sum += __shfl_xor(sum, 16); sum += __shfl_xor(sum, 32); rsum[hh] = 1.0f / sum;
                bf16x8 pb[8];
#pragma unroll
                for (int s = 0; s < 8; ++s) { v4u o; o.x = pk2(st[2 * s][0], st[2 * s][1]); o.y = pk2(st[2 * s][2], st[2 * s][3]); o.z = pk2(st[2 * s + 1][0], st[2 * s + 1][1]); o.w = pk2(st[2 * s + 1][2], st[2 * s + 1][3]);
                    pb[s] = __builtin_bit_cast(bf16x8, o); }
#pragma unroll
                for (int mt2 = 0; mt2 < 2; ++mt2)
#pragma unroll
                    for (int e = 0; e < 2; ++e) { f32x4 o = {0.f, 0.f, 0.f, 0.f};
#pragma unroll
                        for (int s = 0; s < 8; ++s) { const bf16x8 a = *(const LAS bf16x8*)(F.lds + MX_V + (((mt2 * 2 + e) * 8 + s) * 64 + F.lane) * 16);
                            o = __builtin_amdgcn_mfma_f32_16x16x32_bf16(a, pb[s], o, 0, 0, 0); }
#pragma unroll
                        for (int i = 0; i < 4; ++i) val[2 * hh + mt2][4 * e + i] = o[i] * rsum[hh]; }
            }
            mix_finish(val, gng + 768, grow + 768, q);
        }
#endif
        __syncthreads();
    }
}

#if NAIVE_MIX
__global__ void __launch_bounds__(256) nv_mix_pre(const bf16* P, const float* lng, const float* lnb, float* Vn, float* Dp) {
    const int row = blockIdx.x * 4 + (threadIdx.x >> 6), lane = threadIdx.x & 63;
    const bf16* p = P + (size_t)row * NPROJ;
    float v[4]; float s = 0.f;
    for (int i = 0; i < 4; ++i) { v[i] = gelu_tanh(bf2f(p[1280 + 4 * lane + i])); s += v[i]; }
    const float mean = wave_sum(s) * (1.f / 256.f); float s2 = 0.f;
    for (int i = 0; i < 4; ++i) { v[i] -= mean; s2 += v[i] * v[i]; }
    const float rstd = 1.f / sqrtf(wave_sum(s2) * (1.f / 256.f) + LN_EPS);
    for (int i = 0; i < 4; ++i) Vn[(size_t)row * 256 + 4 * lane + i] = v[i] * rstd * lng[4 * lane + i] + lnb[4 * lane + i];
    const int t = row % SEQ, w = 2 << (lane >> 4), cnt = (t + 1 < w) ? t + 1 : w;
    for (int i = 0; i < 4; ++i) { const int c = 4 * lane + i; float acc = 0.f;
        for (int d = 0; d < cnt; ++d) acc += bf2f(P[(size_t)(row - d) * NPROJ + 768 + c]);
        Dp[(size_t)row * 256 + c] = acc / (float)cnt - bf2f(p[768 + c]); }
}
__global__ void __launch_bounds__(256) nv_mix_main(const bf16* P, const float* Vn, const float* Dp, const bf16* Kb, const bf16* VT, const float* conv_w, const float* pool_w, const float* pool_scale,
                                                   const float* gmlp_w, const float* gmlp_b, float* Y) {
    const int row = blockIdx.x >> 2, grp = blockIdx.x & 3, c = threadIdx.x, t = row % SEQ;
    const bf16* p = P + (size_t)row * NPROJ; float y = 0.f;
    if (grp == 0) {
        float z[3];
        for (int d = 0; d < 3; ++d) { const int tt = t - 2 + d; z[d] = (tt >= 0) ? bf2f(P[(size_t)(row - 2 + d) * NPROJ + 256 + c]) * bf2f(P[(size_t)(row - 2 + d) * NPROJ + 512 + c]) : 0.f; }
        y = bf2f(p[c]) * (conv_w[c] * z[0] + conv_w[256 + c] * z[1] + conv_w[512 + c] * z[2]);
    } else if (grp == 1) {
        const int gi = c >> 6, dd = c & 63; float acc = 0.f;
        for (int cc = 0; cc < 64; ++cc) acc += Dp[(size_t)row * 256 + gi * 64 + cc] * pool_w[(gi * 64 + cc) * 64 + dd];
        y = acc * pool_scale[c];
    } else if (grp == 2) {
        const int hh = c >> 6, i = t & 127, jmax = ((i >> 6) + 1) * 64; const size_t blk0 = (size_t)(row - i); float acc = 0.f;
        for (int j = 0; j < jmax; ++j) acc += gmlp_w[(hh * 128 + i) * 128 + j] * Vn[(blk0 + j) * 256 + c];
        y = gelu_tanh(bf2f(p[1024 + c])) * (acc + gmlp_b[hh * 128 + i]);
    } else {
        const int hh = c >> 6, lane = c & 63, b = row / SEQ;
        const float q = bf2f(p[1536 + hh * 64 + lane]);
        float sc[4] = {0.f, 0.f, 0.f, 0.f};
        for (int d = 0; d < 64; ++d) { const float qd = __shfl(q, d);
            for (int m = 0; m < 4; ++m) sc[m] += qd * bf2f(Kb[(size_t)(b * 256 + lane + 64 * m) * 256 + hh * 64 + d]); }
        float mx = -3.0e38f;
        for (int m = 0; m < 4; ++m) { sc[m] *= 0.125f; mx = fmaxf(mx, sc[m]); }
        for (int o = 1; o < 64; o <<= 1) mx = fmaxf(mx, __shfl_xor(mx, o));
        float sum = 0.f;
        for (int m = 0; m < 4; ++m) { sc[m] = __expf(sc[m] - mx); sum += sc[m]; }
        sum = wave_sum(sum);
        float o = 0.f;
        for (int m = 0; m < 4; ++m) for (int j = 0; j < 64; ++j) { const float pj = __shfl(sc[m], j); o += pj * bf2f(VT[(size_t)(hh * 64 + lane) * 4096 + b * 256 + j + 64 * m]); }
        y = o / sum;
    }
    Y[(size_t)row * 1024 + grp * 256 + c] = y;
}
__global__ void __launch_bounds__(256) nv_mix_norm(const float* Y, const float* gng, bf16* G) {
    const int wv = blockIdx.x * 4 + (threadIdx.x >> 6), lane = threadIdx.x & 63, row = wv >> 2, grp = wv & 3;
    const float* y = Y + (size_t)row * 1024 + grp * 256; float v[4], s2 = 0.f;
    for (int i = 0; i < 4; ++i) { v[i] = y[4 * lane + i]; s2 += v[i] * v[i]; }
    const float r = 1.f / sqrtf(wave_sum(s2) * (1.f / 256.f) + RMS_EPS);
    for (int i = 0; i < 4; ++i) G[(size_t)row * 1024 + grp * 256 + 4 * lane + i] = (bf16)f2bf(v[i] * r * gng[grp * 256 + 4 * lane + i]);
}
#endif

constexpr int PH_PRO = 0, PH_KV = 1, PH_L0 = 2, PH_PER_LAYER = 8, N_PHASES = PH_L0 + NLAYER * PH_PER_LAYER;
__global__ void __launch_bounds__(NWAVES * 64, 2) fwd(Args args) {
    const Args& A = args;
    extern __shared__ __attribute__((aligned(16))) unsigned char lds[];
    Frame F;
    F.lds = (LAS unsigned char*)lds;
    F.MISC = (volatile LAS unsigned*)(F.lds + MISC_OFF);
    F.tid = threadIdx.x; F.lane = F.tid & 63; F.wave = __builtin_amdgcn_readfirstlane(F.tid >> 6);
    F.G = gridDim.x; F.ws = args.ws; F.ctl = (gu32*)(args.ws + WS_CTL); F.out = args.out;
    for (int u = F.tid; u < (LDS_BYTES - LDSCTL_OFF) / 4; u += NWAVES * 64) ((LAS unsigned*)(F.lds + LDSCTL_OFF))[u] = 0u;
    __syncthreads();
#if MK_ONE_LAUNCH
    XcdBarrier bar = xcd_barrier_post((unsigned*)(F.ctl + CW_BAR), F.MISC + 8);
#define GRID_BAR() xcd_barrier(bar)
#else
#define GRID_BAR() do { } while (0)
#endif
    const int lo = args.ph_lo, hi = args.ph_hi;
#define IN(k) (lo <= (k) && (k) < hi)
#define BOTH(k) (IN(k) && IN((k) + 1))
    const pg8::Gemm gm{(const pg8::bf16_t*)F.ws, (const pg8::bf16_t*)F.ws, D};
    const int c = (int)blockIdx.x;

    if (IN(PH_PRO) && (PHMASK & 1)) { p0_prologue(F, args); if (BOTH(PH_PRO)) GRID_BAR(); }
    if (IN(PH_KV) && (PHMASK & 2)) {
        KvOrder S{F.G, c};
        pg8::EpiBf16Sel E{WSP(bf16, WS_KB), WSP(bf16, WS_VT), 256, 4096};
        pg8::gemm_phase<pg8::EpiBf16Sel, KvOrder, true, true>(F.lds + RING_OFF, gm, S, E);
        if (BOTH(PH_KV)) GRID_BAR();
    }
    for (int l = 0; l < NLAYER; ++l) {
        const int pb = PH_L0 + l * PH_PER_LAYER;
        if (IN(pb + 0) && (PHMASK & 4)) {
            DenseOrder S{NTOK / 256, NPROJ / 256, F.G, c, T_HB, T_WIN + l * (NPROJ / 256)};
            pg8::EpiBf16Sel E{WSP(bf16, WS_P), WSP(bf16, WS_P), NPROJ, NPROJ};
            pg8::gemm_phase<pg8::EpiBf16Sel, DenseOrder, true, true>(F.lds + RING_OFF, gm, S, E);
            if (BOTH(pb + 0)) GRID_BAR();
        }
        if (IN(pb + 1) && (PHMASK & 512)) {
            pb_phase(F, args, l);
            if (BOTH(pb + 1)) GRID_BAR();
        }
        if (IN(pb + 2) && (PHMASK & 8)) {
            DenseOrder S{NTOK / 256, D / 256, F.G, c, T_G, T_WOUT + l * (D / 256)};
            pg8::EpiResF32 E{WSP(float, WS_HF), WSP(float, WS_PRE), DN_ALPHA};
            pg8::gemm_phase<pg8::EpiResF32, DenseOrder, true, true>(F.lds + RING_OFF, gm, S, E);
            if (BOTH(pb + 2)) GRID_BAR();
        }
        if (IN(pb + 3) && (PHMASK & 16)) { pd_phase(F, args, l); if (BOTH(pb + 3)) GRID_BAR(); }
        if (IN(pb + 4) && (PHMASK & 32)) { pe_phase(F, l); if (BOTH(pb + 4)) GRID_BAR(); }
        if (IN(pb + 5) && (PHMASK & 64)) {
            compute_toff(F, l);
            const LAS int* toff = (const LAS int*)(F.lds + TOFF_OFF);
            MoeOrder S{__builtin_amdgcn_readfirstlane(toff[NEXP]), 8, F.G, c, T_XP, T_W1 + l * NEXP * 8, toff};
            pg8::EpiSwiglu E{TILEP(T_ACT), A.in[I_B1] + (size_t)l * NEXP * 2048};
            pg8::gemm_phase<pg8::EpiSwiglu, MoeOrder, true, true>(F.lds + RING_OFF, gm, S, E);
            if (BOTH(pb + 5)) GRID_BAR();
        }
        if (IN(pb + 6) && (PHMASK & 128)) {
            compute_toff(F, l);
            const LAS int* toff = (const LAS int*)(F.lds + TOFF_OFF);
            MoeOrder S{__builtin_amdgcn_readfirstlane(toff[NEXP]), 4, F.G, c, T_ACT, T_W2 + l * NEXP * 4, toff};
            pg8::EpiDown E{TILEP(T_YS), A.in[I_B2] + (size_t)l * NEXP * 1024};
            pg8::gemm_phase<pg8::EpiDown, MoeOrder, true, true>(F.lds + RING_OFF, gm, S, E);
            if (BOTH(pb + 6)) GRID_BAR();
        }
        if (IN(pb + 7) && (PHMASK & 256)) { ph_phase(F, args, l); if (BOTH(pb + 7)) GRID_BAR(); }
    }
#undef IN
#undef BOTH
}

extern "C" void kernel_launch(void* const* d_in, const int* in_sizes, int n_in, void* d_out, int out_size, void* d_ws, size_t ws_size, hipStream_t stream) {
    static int grid = 0;
    if (grid == 0) {
        if (n_in != 27 || out_size != NTOK * D || ws_size < WS_END) { fprintf(stderr, "kernel_launch: unexpected problem (n_in %d, out %d, ws %zu < %zu)\n", n_in, out_size, ws_size, (size_t)WS_END); grid = -1; return; }
        int dev = 0, cus = 0, per_cu = 0;
        if (hipGetDevice(&dev) != hipSuccess || hipDeviceGetAttribute(&cus, hipDeviceAttributeMultiprocessorCount, dev) != hipSuccess) { grid = -1; return; }
        if (hipFuncSetAttribute((const void*)fwd, hipFuncAttributeMaxDynamicSharedMemorySize, LDS_BYTES) != hipSuccess) { fprintf(stderr, "kernel_launch: hipFuncSetAttribute failed\n"); grid = -1; return; }
        if (hipOccupancyMaxActiveBlocksPerMultiprocessor(&per_cu, (const void*)fwd, NWAVES * 64, LDS_BYTES) != hipSuccess || per_cu < 1) fprintf(stderr, "kernel_launch: occupancy query says %d\n", per_cu);
        (void)hipGetLastError();
        grid = cus;
    }
    if (grid < 0) return;
    if (hipMemsetAsync((char*)d_ws + WS_CTL, 0, CTL_ZERO_BYTES, stream) != hipSuccess) return;
    Args a{};
    for (int i = 0; i < 27; ++i) a.in[i] = (const float*)d_in[i];
    a.out = (float*)d_out; a.ws = (unsigned char*)d_ws;
#if MK_ONE_LAUNCH
    a.ph_lo = 0; a.ph_hi = N_PHASES;
    hipLaunchKernelGGL(fwd, dim3(grid), dim3(NWAVES * 64), LDS_BYTES, stream, a);
#else
    unsigned char* ws = (unsigned char*)d_ws;
    for (int p = 0; p < N_PHASES; ++p) {
        const int l = (p - PH_L0) / PH_PER_LAYER, q = (p - PH_L0) % PH_PER_LAYER;
        if (p >= PH_L0 && q == 1) {
#if NAIVE_MIX
            const float* const* in = (const float* const*)d_in;
            hipLaunchKernelGGL(nv_mix_pre, dim3(NTOK / 4), dim3(256), 0, stream, (const bf16*)(ws + WS_P), in[10] + l * 256, in[11] + l * 256, (float*)(ws + WS_NV_VN), (float*)(ws + WS_NV_DP));
            hipLaunchKernelGGL(nv_mix_main, dim3(NTOK * 4), dim3(256), 0, stream, (const bf16*)(ws + WS_P), (const float*)(ws + WS_NV_VN), (const float*)(ws + WS_NV_DP),
                               (const bf16*)(ws + WS_KB) + (size_t)l * 4096 * 256, (const bf16*)(ws + WS_VT) + (size_t)l * 256 * 4096, in[7] + l * 768, in[8] + l * 4 * 64 * 64, in[9] + l * 256,
                               in[12] + l * 4 * 128 * 128, in[13] + l * 4 * 128, (float*)(ws + WS_NV_Y));
            hipLaunchKernelGGL(nv_mix_norm, dim3(NTOK), dim3(256), 0, stream, (const float*)(ws + WS_NV_Y), in[15] + l * 1024, (bf16*)(ws + (size_t)T_G * TILE));
            continue;
#endif
        }
        a.ph_lo = p; a.ph_hi = p + 1;
        hipLaunchKernelGGL(fwd, dim3(grid), dim3(NWAVES * 64), LDS_BYTES, stream, a);
    }
#endif
}
```

```cpp
#include <hip/hip_runtime.h>
#include <cstdio>
#include <cstdint>

#ifndef MK_ONE_LAUNCH
#define MK_ONE_LAUNCH 1
#endif
#ifndef PHMASK
#define PHMASK 0xffff
#endif
#ifndef MXMASK
#define MXMASK 15
#endif
#ifndef DUP_PHASE
#define DUP_PHASE -1
#endif
#ifndef NAIVE_MIX
#define NAIVE_MIX 0
#endif

namespace pg8 {
#define PG8_LAS __attribute__((address_space(3)))
typedef unsigned short bf16_t;
typedef short bf16x8 __attribute__((ext_vector_type(8)));
typedef float f32x4 __attribute__((ext_vector_type(4)));
typedef float f32x2 __attribute__((ext_vector_type(2)));
typedef unsigned u32x4 __attribute__((ext_vector_type(4)));
typedef unsigned u32x2 __attribute__((ext_vector_type(2)));
constexpr int BM = 256, BK = 64, HALF = 128, HTB = HALF * BK * 2  , STAGE_BYTES = 8 * HTB, NXCD = 8, WGM = 8;

__host__ __device__ __forceinline__ int lds_byte(int r, int c) { const int st = (r >> 4) * 2 + (c >> 5), rr = r & 15, cc = c & 31, ob = rr * 64 + cc * 2; return st * 1024 + (ob ^ (((ob >> 9) & 1) << 5)); }
__host__ __device__ __forceinline__ void stage_rc(int b, int& R, int& C) { const int st = b / 1024, sb = b % 1024, swz = sb ^ (((sb >> 9) & 1) << 5); R = (st >> 1) * 16 + swz / 64; C = (st & 1) * 32 + (swz % 64) / 2; }
__host__ __device__ __forceinline__ int perm32(int rho) { const int n = rho >> 4, i = rho & 15; return 8 * (i >> 2) + 4 * n + (i & 3); }

struct Unit { int pm, pn, lm, ln, a0; };
struct Gemm { const bf16_t* A; const bf16_t* Bt; int K; };

__device__ __forceinline__ void tile_of(int L, int nM, int nN, int& tm, int& tn) {
    const int nwg = nM * nN; int wgid = L; { const int q = nwg / NXCD, r = nwg % NXCD, xcd = wgid % NXCD, off = wgid / NXCD; wgid = (xcd < r ? xcd * (q + 1) : r * (q + 1) + (xcd - r) * q) + off; }
    const int nig = WGM * nN, gid = wgid / nig, fm = gid * WGM, gsz = (nM - fm) < WGM ? (nM - fm) : WGM;
    tm = fm + ((wgid % nig) % gsz); tn = (wgid % nig) / gsz;
}

typedef int v8i __attribute__((ext_vector_type(8)));
__device__ __forceinline__ v8i cat8(bf16x8 a, bf16x8 b) { typedef short s16x16 __attribute__((ext_vector_type(16))); return __builtin_bit_cast(v8i, __builtin_shufflevector(a, b, 0, 1, 2, 3, 4, 5, 6, 7, 8, 9, 10, 11, 12, 13, 14, 15)); }
__device__ __forceinline__ bf16x8 half8(v8i x, int k) { typedef int v4i __attribute__((ext_vector_type(4))); return __builtin_bit_cast(bf16x8, k ? __builtin_shufflevector(x, x, 4, 5, 6, 7) : __builtin_shufflevector(x, x, 0, 1, 2, 3)); }
__device__ __forceinline__ void mfma_fp8_acc(f32x4& acc, const v8i& a, const v8i& b) { asm volatile("v_mfma_f32_16x16x128_f8f6f4 %0, %1, %2, %0" : "+v"(acc) : "v"(a), "v"(b)); }
__device__ __forceinline__ unsigned cvt4_fp8(float a, float b, float c, float d) {
    a = __builtin_amdgcn_fmed3f(a, -448.f, 448.f); b = __builtin_amdgcn_fmed3f(b, -448.f, 448.f); c = __builtin_amdgcn_fmed3f(c, -448.f, 448.f); d = __builtin_amdgcn_fmed3f(d, -448.f, 448.f);
    int r = __builtin_amdgcn_cvt_pk_fp8_f32(a, b, 0, false); r = __builtin_amdgcn_cvt_pk_fp8_f32(c, d, r, true); return (unsigned)r; }
__device__ __forceinline__ unsigned cvt_pk_bf16(float lo, float hi) { unsigned r; asm volatile("v_cvt_pk_bf16_f32 %0, %1, %2" : "=v"(r) : "v"(lo), "v"(hi)); return r; }


struct EpiBf16Sel {
    static constexpr bool PERM = true, AFTER_DRAIN = false;
    bf16_t* o0; bf16_t* o1; int ld0, ld1;
    __device__ __forceinline__ void operator()(const f32x4 (&acc)[2][2][4][2], const Unit& u, int wr, int wc, int fr, int fq) const {
        bf16_t* base = u.a0 == 0 ? o0 : o1; const int ldc = u.a0 == 0 ? ld0 : ld1;
        const int row0 = u.lm * BM + wr * 64 + fr, col0 = u.ln * BM + wc * 32 + 8 * fq;
#pragma unroll
        for (int ai = 0; ai < 2; ++ai)
#pragma unroll
            for (int m = 0; m < 4; ++m) { bf16_t* rowp = base + (size_t)(row0 + ai * HALF + m * 16) * ldc + col0;
#pragma unroll
                for (int bj = 0; bj < 2; ++bj) { const f32x4 v0 = acc[ai][bj][m][0], v1 = acc[ai][bj][m][1];
                    u32x4 w; w.x = cvt_pk_bf16(v0[0], v0[1]); w.y = cvt_pk_bf16(v0[2], v0[3]); w.z = cvt_pk_bf16(v1[0], v1[1]); w.w = cvt_pk_bf16(v1[2], v1[3]);
                    *(u32x4*)(rowp + bj * HALF) = w; } }
    }
};
struct EpiResF32 {
    static constexpr bool PERM = false, AFTER_DRAIN = false;
    const float* h; float* pre; float alpha;
    __device__ __forceinline__ void operator()(const f32x4 (&acc)[2][2][4][2], const Unit& u, int wr, int wc, int fr, int fq) const {
        const int row0 = u.lm * BM + wr * 64 + fr, col0 = u.ln * BM + wc * 32 + 4 * fq;
#pragma unroll
        for (int ai = 0; ai < 2; ++ai)
#pragma unroll
            for (int m = 0; m < 4; ++m) { const size_t off = (size_t)(row0 + ai * HALF + m * 16) * 1024 + col0;
#pragma unroll
                for (int bj = 0; bj < 2; ++bj)
#pragma unroll
                    for (int n = 0; n < 2; ++n) { const f32x4 hv = *(const f32x4*)(h + off + bj * HALF + n * 16); *(f32x4*)(pre + off + bj * HALF + n * 16) = hv * alpha + acc[ai][bj][m][n]; }
                asm volatile("" ::: "memory"); }
    }
};
struct EpiSwiglu {
    static constexpr bool PERM = true, AFTER_DRAIN = false;
    unsigned char* act; const float* b1;
    __device__ __forceinline__ void operator()(const f32x4 (&acc)[2][2][4][2], const Unit& u, int wr, int wc, int fr, int fq) const {
        const int row0 = u.lm * BM + wr * 64 + fr, lc0 = u.ln * HALF + wc * 32 + 8 * fq;
        const float* bb = b1 + (size_t)u.a0 * 2048 + lc0;
        const f32x4 bg0 = *(const f32x4*)(bb), bg1 = *(const f32x4*)(bb + 4), bl0 = *(const f32x4*)(bb + 1024), bl1 = *(const f32x4*)(bb + 1028);
        constexpr float DS = 1.0f / 512.0f;
#pragma unroll
        for (int ai = 0; ai < 2; ++ai)
#pragma unroll
            for (int m = 0; m < 4; ++m) {
                u32x2 w; unsigned* wp = (unsigned*)&w;
#pragma unroll
                for (int n = 0; n < 2; ++n) { const f32x4 g4 = acc[ai][0][m][n] * DS + (n ? bg1 : bg0), l4 = acc[ai][1][m][n] * DS + (n ? bl1 : bl0); float r4[4];
#pragma unroll
                    for (int j = 0; j < 4; ++j) { const float g = fminf(g4[j], 7.0f), li = fminf(fmaxf(l4[j], -7.0f), 7.0f);
                        const float sg = __builtin_amdgcn_rcpf(1.0f + __builtin_amdgcn_exp2f(g * (-1.702f * 1.4426950408889634f))); r4[j] = g * sg * (li + 1.0f) * 4.0f; }
                    wp[n] = cvt4_fp8(r4[0], r4[1], r4[2], r4[3]); }
                *(u32x2*)(act + (size_t)(row0 + ai * HALF + m * 16) * 1024 + lc0) = w; }
    }
};
struct EpiDown {
    static constexpr bool PERM = true, AFTER_DRAIN = false;
    bf16_t* ys; const float* b2;
    __device__ __forceinline__ void operator()(const f32x4 (&acc)[2][2][4][2], const Unit& u, int wr, int wc, int fr, int fq) const {
        const int row0 = u.lm * BM + wr * 64 + fr, col0 = u.ln * BM + wc * 32 + 8 * fq;
        f32x4 bv[2][2];
#pragma unroll
        for (int bj = 0; bj < 2; ++bj)
#pragma unroll
            for (int n = 0; n < 2; ++n) bv[bj][n] = *(const f32x4*)(b2 + (size_t)u.a0 * 1024 + col0 + bj * HALF + 4 * n);
#pragma unroll
        for (int ai = 0; ai < 2; ++ai)
#pragma unroll
            for (int m = 0; m < 4; ++m) { bf16_t* rowp = ys + (size_t)(row0 + ai * HALF + m * 16) * 1024 + col0;
#pragma unroll
                for (int bj = 0; bj < 2; ++bj) { const f32x4 v0 = acc[ai][bj][m][0] * (1.0f / 256.0f) + bv[bj][0], v1 = acc[ai][bj][m][1] * (1.0f / 256.0f) + bv[bj][1];
                    u32x4 w; w.x = cvt_pk_bf16(v0[0], v0[1]); w.y = cvt_pk_bf16(v0[2], v0[3]); w.z = cvt_pk_bf16(v1[0], v1[1]); w.w = cvt_pk_bf16(v1[2], v1[3]);
                    *(u32x4*)(rowp + bj * HALF) = w; } }
    }
};

template <class Epi, class Sched, bool ALIGN_EPI = false, bool SP2 = false, bool FP8 = false>
__device__ __forceinline__ void gemm_phase(PG8_LAS unsigned char* lds, const Gemm g, const Sched& S, const Epi& E) {
    int tid_l = threadIdx.x; asm volatile("" : "+v"(tid_l));
    const int tid = tid_l, wid = __builtin_amdgcn_readfirstlane(tid >> 6), lane = tid & 63, wr = wid >> 2, wc = wid & 3, fr = lane & 15, fq = lane >> 4;
    const int RB = g.K * (FP8 ? 1 : 2), nt = RB / 128;
    unsigned voffA[2], voffB[2];
#pragma unroll
    for (int i = 0; i < 2; ++i) { int R, C; stage_rc(tid * 16 + i * 8192, R, C); const int Rb = Epi::PERM ? ((R & ~31) + perm32(R & 31)) : R;
        voffA[i] = (unsigned)(R * RB + C * 2); voffB[i] = (unsigned)(Rb * RB + C * 2); }
    const size_t kstep = (size_t)(BK * 2);
    const size_t hstep = (size_t)HALF * RB;
    const size_t tstep = 2 * hstep;
    const unsigned ldsw = (unsigned)wid * 1024u;
    const int aoff = lds_byte(wr * 64 + fr, fq * 8), boff = lds_byte(wc * 32 + fr, fq * 8);
#define PG8_SA(b, h) (((b) * 2 + (h)) * HTB)
#define PG8_SB(b, h) ((4 + (b) * 2 + (h)) * HTB)
#define PG8_STAGE(bufoff, gbase, voff) do { _Pragma("unroll") for (int _i = 0; _i < 2; ++_i) \
        __builtin_amdgcn_global_load_lds((const unsigned*)((const char*)(gbase) + (voff)[_i]), (PG8_LAS unsigned*)(lds + (bufoff) + ldsw + _i * 8192), 16, 0, 0); } while (0)
#define PG8_LDA(dst, b, h) do { _Pragma("unroll") for (int m = 0; m < 4; ++m) dst[m] = cat8(*(const PG8_LAS bf16x8*)(lds + PG8_SA(b, h) + aoff + m * 2048), *(const PG8_LAS bf16x8*)(lds + PG8_SA(b, h) + aoff + m * 2048 + 1024)); } while (0)
#define PG8_LDB(dst, b, h) do { _Pragma("unroll") for (int n = 0; n < 2; ++n) dst[n] = cat8(*(const PG8_LAS bf16x8*)(lds + PG8_SB(b, h) + boff + n * 2048), *(const PG8_LAS bf16x8*)(lds + PG8_SB(b, h) + boff + n * 2048 + 1024)); } while (0)
#define PG8_MMA(ai, bj, At, Bt) do { __builtin_amdgcn_s_setprio(1); _Pragma("unroll") for (int m = 0; m < 4; ++m) _Pragma("unroll") for (int n = 0; n < 2; ++n) { \
        if constexpr (FP8) mfma_fp8_acc(acc[ai][bj][m][n], Bt[n], At[m]); \
        else { _Pragma("unroll") for (int k = 0; k < 2; ++k) acc[ai][bj][m][n] = __builtin_amdgcn_mfma_f32_16x16x32_bf16(half8(Bt[n], k), half8(At[m], k), acc[ai][bj][m][n], 0, 0, 0); } } \
        __builtin_amdgcn_s_setprio(0); } while (0)
#define PG8_WAIT_V(n) asm volatile("s_waitcnt vmcnt(" #n ")" ::: "memory")
#define PG8_WAIT_L(n) asm volatile("s_waitcnt lgkmcnt(" #n ")" ::: "memory")
#define PG8_BAR __builtin_amdgcn_s_barrier()
#define PG8_SCHED __builtin_amdgcn_sched_barrier(0)
    Unit cur, nxt; int ui = 0;
    if (!S.next(0, cur)) return;
    f32x4 acc[2][2][4][2];
#pragma unroll
    for (int a = 0; a < 2; ++a)
#pragma unroll
        for (int b = 0; b < 2; ++b)
#pragma unroll
            for (int m = 0; m < 4; ++m)
#pragma unroll
                for (int n = 0; n < 2; ++n) acc[a][b][m][n] = (f32x4){0.f, 0.f, 0.f, 0.f};
    v8i At[4], B0[2], B1[2];
    const char* cA = (const char*)g.A + (size_t)cur.pm * tstep; const char* cB = (const char*)g.Bt + (size_t)cur.pn * tstep;
    S.a_ready(cur);
    if constexpr (SP2) {
        PG8_STAGE(PG8_SB(0, 0), cB, voffB); PG8_STAGE(PG8_SB(0, 1), cB + hstep, voffB); PG8_STAGE(PG8_SA(0, 0), cA, voffA); PG8_STAGE(PG8_SA(0, 1), cA + hstep, voffA);
        if (wr == 1) PG8_BAR;
        PG8_WAIT_V(2); PG8_BAR;
        PG8_STAGE(PG8_SB(1, 0), cB + kstep, voffB); PG8_STAGE(PG8_SA(1, 0), cA + kstep, voffA); PG8_STAGE(PG8_SB(1, 1), cB + hstep + kstep, voffB);
        PG8_WAIT_V(6); PG8_BAR;
    } else {
        PG8_STAGE(PG8_SB(0, 0), cB, voffB); PG8_STAGE(PG8_SA(0, 0), cA, voffA); PG8_STAGE(PG8_SB(0, 1), cB + hstep, voffB); PG8_STAGE(PG8_SA(0, 1), cA + hstep, voffA);
        if (wr == 1) PG8_BAR;
        PG8_WAIT_V(4); PG8_BAR;
        PG8_STAGE(PG8_SB(1, 0), cB + kstep, voffB); PG8_STAGE(PG8_SA(1, 0), cA + kstep, voffA); PG8_STAGE(PG8_SB(1, 1), cB + hstep + kstep, voffB);
        PG8_WAIT_V(6); PG8_BAR;
    }
    for (;;) {
        const bool has_next = S.next(ui + 1, nxt);
        const char* nA = has_next ? (const char*)g.A + (size_t)nxt.pm * tstep : cA; const char* nB = has_next ? (const char*)g.Bt + (size_t)nxt.pn * tstep : cB;
#pragma nounroll
        for (int t = 0; t < nt; t += 2) {
            const bool last = (t == nt - 2);
            const char* a1 = cA + (size_t)(t + 1) * kstep;
            const char* a2 = last ? nA : cA + (size_t)(t + 2) * kstep; const char* b2 = last ? nB : cB + (size_t)(t + 2) * kstep;
            const char* a3 = a2 + kstep; const char* b3 = b2 + kstep;
            if (last && has_next) S.a_ready(nxt);
            if constexpr (SP2) {
            PG8_LDB(B0, 0, 0); PG8_LDB(B1, 0, 1); PG8_SCHED; PG8_LDA(At, 0, 0); PG8_STAGE(PG8_SA(1, 1), a1 + hstep, voffA);
            PG8_WAIT_V(8); PG8_WAIT_L(0); PG8_BAR; PG8_MMA(0, 0, At, B0); PG8_MMA(0, 1, At, B1); PG8_BAR; PG8_SCHED;
            PG8_LDA(At, 0, 1); PG8_STAGE(PG8_SB(0, 0), b2, voffB); PG8_STAGE(PG8_SB(0, 1), b2 + hstep, voffB); PG8_STAGE(PG8_SA(0, 0), a2, voffA);
            PG8_WAIT_V(8); PG8_WAIT_L(0); PG8_BAR; PG8_MMA(1, 0, At, B0); PG8_MMA(1, 1, At, B1); PG8_BAR; PG8_SCHED;
            PG8_LDB(B0, 1, 0); PG8_LDB(B1, 1, 1); PG8_SCHED; PG8_LDA(At, 1, 0); PG8_STAGE(PG8_SA(0, 1), a2 + hstep, voffA);
            PG8_WAIT_V(8); PG8_WAIT_L(0); PG8_BAR; PG8_MMA(0, 0, At, B0); PG8_MMA(0, 1, At, B1); PG8_BAR; PG8_SCHED;
            PG8_LDA(At, 1, 1); PG8_STAGE(PG8_SB(1, 0), b3, voffB); PG8_STAGE(PG8_SB(1, 1), b3 + hstep, voffB); PG8_STAGE(PG8_SA(1, 0), a3, voffA);
            PG8_WAIT_V(8); PG8_WAIT_L(0); PG8_BAR; PG8_MMA(1, 0, At, B0); PG8_MMA(1, 1, At, B1); PG8_BAR; PG8_SCHED;
            } else {
            PG8_LDB(B0, 0, 0); PG8_SCHED; PG8_LDA(At, 0, 0); PG8_STAGE(PG8_SA(1, 1), a1 + hstep, voffA);
            PG8_WAIT_L(8); PG8_BAR; PG8_WAIT_L(0); PG8_MMA(0, 0, At, B0); PG8_BAR; PG8_SCHED;
            PG8_LDB(B1, 0, 1); PG8_STAGE(PG8_SB(0, 0), b2, voffB);
            PG8_BAR; PG8_WAIT_L(0); PG8_MMA(0, 1, At, B1); PG8_BAR;
            PG8_LDA(At, 0, 1); PG8_STAGE(PG8_SA(0, 0), a2, voffA);
            PG8_BAR; PG8_WAIT_L(0); PG8_MMA(1, 0, At, B0); PG8_BAR; PG8_SCHED;
            PG8_STAGE(PG8_SB(0, 1), b2 + hstep, voffB);
            PG8_WAIT_V(6); PG8_BAR; PG8_MMA(1, 1, At, B1); PG8_BAR;
            PG8_LDB(B0, 1, 0); PG8_SCHED; PG8_LDA(At, 1, 0); PG8_STAGE(PG8_SA(0, 1), a2 + hstep, voffA);
            PG8_WAIT_L(8); PG8_BAR; PG8_WAIT_L(0); PG8_MMA(0, 0, At, B0); PG8_BAR; PG8_SCHED;
            PG8_LDB(B1, 1, 1); PG8_STAGE(PG8_SB(1, 0), b3, voffB);
            PG8_BAR; PG8_WAIT_L(0); PG8_MMA(0, 1, At, B1); PG8_BAR;
            PG8_LDA(At, 1, 1); PG8_STAGE(PG8_SA(1, 0), a3, voffA);
            PG8_BAR; PG8_WAIT_L(0); PG8_MMA(1, 0, At, B0); PG8_BAR; PG8_SCHED;
            PG8_STAGE(PG8_SB(1, 1), b3 + hstep, voffB);
            PG8_WAIT_V(6); PG8_BAR; PG8_MMA(1, 1, At, B1); PG8_BAR;
            }
        }
        if constexpr (ALIGN_EPI) { if (wr == 0) PG8_BAR; }
        if constexpr (FP8) asm volatile("s_nop 15\n\ts_nop 15" ::: "memory");
        if constexpr (!Epi::AFTER_DRAIN) { E(acc, cur, wr, wc, fr, fq); S.done(cur); }
        if (!has_next) break;
#pragma unroll
        for (int a = 0; a < 2; ++a)
#pragma unroll
            for (int b = 0; b < 2; ++b)
#pragma unroll
                for (int m = 0; m < 4; ++m)
#pragma unroll
                    for (int n = 0; n < 2; ++n) acc[a][b][m][n] = (f32x4){0.f, 0.f, 0.f, 0.f};
        cur = nxt; cA = nA; cB = nB; ++ui;
        if constexpr (ALIGN_EPI) { if (wr == 1) PG8_BAR; }
    }
    PG8_WAIT_V(0);
    if constexpr (!ALIGN_EPI) { if (wr == 0) PG8_BAR; }
    PG8_BAR;
    if constexpr (Epi::AFTER_DRAIN) { E.fused(acc, cur, wr, wc, fr, fq, lds, wid, lane); S.done(cur); }
#undef PG8_SA
#undef PG8_SB
#undef PG8_STAGE
#undef PG8_LDA
#undef PG8_LDB
#undef PG8_MMA
#undef PG8_WAIT_V
#undef PG8_WAIT_L
#undef PG8_BAR
#undef PG8_SCHED
}
}

#define GAS __attribute__((address_space(1)))
#define LAS __attribute__((address_space(3)))
typedef unsigned short bf16;
typedef unsigned v4u __attribute__((ext_vector_type(4)));
typedef unsigned v2u __attribute__((ext_vector_type(2)));
typedef float f32x4 __attribute__((ext_vector_type(4)));
typedef short bf16x8 __attribute__((ext_vector_type(8)));
typedef GAS unsigned gu32;
typedef GAS unsigned long long gu64;
#define RLX_AGENT __ATOMIC_RELAXED, __HIP_MEMORY_SCOPE_AGENT
#define LDS_WAIT() asm volatile("s_waitcnt lgkmcnt(0)" ::: "memory")
#define VM_WAIT() asm volatile("s_waitcnt vmcnt(0)" ::: "memory")
__device__ __forceinline__ unsigned long long rt() { return __builtin_amdgcn_s_memrealtime(); }
__device__ __forceinline__ unsigned f2bf(float f) { unsigned u = __builtin_bit_cast(unsigned, f); return (u + 0x7fffu + ((u >> 16) & 1u)) >> 16; }
__device__ __forceinline__ unsigned pk2(float lo, float hi) { return f2bf(lo) | (f2bf(hi) << 16); }

#define XB_TMO      128
#define XB_XCNT(j)  (256  + 64 * (j))
#define XB_XSUB(j)  (1280 + 64 * (j))
#define XB_XGEN(j)  (2304 + 64 * (j))
#define XB_TOP      3328
#define XB_TOPGEN   3392
#define XCD_BAR_WORDS 3456
#define XB_SPIN_CAP (1u << 18)

__device__ __forceinline__ unsigned xb_ld(unsigned* p)              { return __hip_atomic_load(p, __ATOMIC_RELAXED, __HIP_MEMORY_SCOPE_AGENT); }
__device__ __forceinline__ unsigned xb_add(unsigned* p, unsigned v) { return __hip_atomic_fetch_add(p, v, __ATOMIC_RELAXED, __HIP_MEMORY_SCOPE_AGENT); }
__device__ __forceinline__ unsigned xb_xcc_id() { return (unsigned)__builtin_amdgcn_s_getreg((3 << 11) | 20) & 0xFu; }
#define XB_SPIN(cond, bar) do { unsigned _sp = 0; while (cond) { __builtin_amdgcn_s_sleep(1); \
    if ((++_sp & 255u) == 0u) { if (xb_ld(&(bar)[XB_TMO])) break; if (_sp > XB_SPIN_CAP) { atomicAdd(&(bar)[XB_TMO], 1u); break; } } } } while (0)

struct XcdBarrier {
    unsigned* bar; unsigned x;
    volatile LAS unsigned* st;
};

__device__ __forceinline__ XcdBarrier xcd_barrier_post(unsigned* bar, volatile LAS unsigned* st) {
    XcdBarrier b; b.bar = bar; b.x = xb_xcc_id(); b.st = st;
    if (threadIdx.x == 0) (void)xb_add(&bar[XB_XCNT(b.x)], 1u);
    return b;
}
__device__ __forceinline__ void xcd_barrier_complete(unsigned* bar, unsigned x, unsigned& nloc, unsigned& nx) {
    const unsigned G = gridDim.x * gridDim.y * gridDim.z;
    unsigned sum, cnt, mine, sp = 0u;
    for (;;) {
        sum = 0u; cnt = 0u; mine = 0u;
#pragma unroll
        for (unsigned j = 0; j < 16; ++j) { const unsigned c = xb_ld(&bar[XB_XCNT(j)]); sum += c; cnt += (c > 0u) ? 1u : 0u; mine = (j == x) ? c : mine; }
        if (sum == G) break;
        __builtin_amdgcn_s_sleep(1);
        if ((++sp & 255u) == 0u) { if (xb_ld(&bar[XB_TMO])) break; if (sp > XB_SPIN_CAP) { atomicAdd(&bar[XB_TMO], 1u); break; } }
    }
    nloc = mine > 0u ? mine : 1u; nx = cnt > 0u ? cnt : 1u;
}

__device__ __forceinline__ void xcd_barrier(const XcdBarrier& b) {
    asm volatile("s_waitcnt vmcnt(0)" ::: "memory");
    __syncthreads();
    if (threadIdx.x == 0) {
        unsigned* bar = b.bar;
        __builtin_amdgcn_s_waitcnt(0);
        unsigned nloc = b.st[0], nx = b.st[1];
        if (nloc == 0u) { xcd_barrier_complete(bar, b.x, nloc, nx); b.st[0] = nloc; b.st[1] = nx; }
        const unsigned old = xb_add(&bar[XB_XSUB(b.x)], 1u);
        const unsigned gen = old / nloc;
        if (old + 1u == (gen + 1u) * nloc) {
            __builtin_amdgcn_fence(__ATOMIC_RELEASE, "agent");
            asm volatile("s_waitcnt vmcnt(0)" ::: "memory");
            const unsigned og = xb_add(&bar[XB_TOP], 1u);
            const unsigned tg = og / nx;
            if (og + 1u == (tg + 1u) * nx) xb_add(&bar[XB_TOPGEN], 1u);
            else XB_SPIN(xb_ld(&bar[XB_TOPGEN]) == tg, bar);
            __builtin_amdgcn_fence(__ATOMIC_ACQUIRE, "agent");
            xb_add(&bar[XB_XGEN(b.x)], 1u);
            asm volatile("s_waitcnt vmcnt(0)" ::: "memory");
        } else {
            XB_SPIN(xb_ld(&bar[XB_XGEN(b.x)]) == gen, bar);
            __builtin_amdgcn_fence(__ATOMIC_ACQUIRE, "agent");
            asm volatile("s_waitcnt vmcnt(0)" ::: "memory");
        }
    }
    __syncthreads();
}


constexpr int NWAVES = 8;
constexpr int NTOK = 32768, D = 1024, NPROJ = 1792, NLAYER = 4, NEXP = 32, SEQ = 2048, NBATCH = 16, NMEM = 256;
constexpr float LN_EPS = 1e-5f, RMS_EPS = 1e-6f;
constexpr float DN_ALPHA = 1.6817928305074292f;
constexpr int XP_TILES = NTOK * 4 / 256 + NEXP;

constexpr size_t MiB = 1u << 20, TILE = 512 * 1024;
constexpr size_t WS_CTL = 0, CTL_ZERO_BYTES = 1 * MiB;
constexpr size_t WS_WMB = 1 * MiB;
constexpr size_t WS_POOLT = WS_WMB + 512 * 1024;
constexpr size_t WS_WRT = WS_POOLT + 128 * 1024;
constexpr int T_WIN = 4, T_WOUT = T_WIN + 28, T_WKV = T_WOUT + 16, T_MEMN = T_WKV + 8, T_HB = T_MEMN + 16, T_G = T_HB + 128, T_END = T_G + 128;
constexpr size_t QT = 256 * 1024;
constexpr size_t WS_W18 = (size_t)T_END * TILE;
constexpr size_t WS_W28 = WS_W18 + 256 * MiB;
constexpr size_t WS_H8 = WS_W28 + 128 * MiB;
constexpr size_t WS_XP8 = WS_H8 + 32 * MiB;
constexpr size_t WS_ACT8 = WS_XP8 + (size_t)XP_TILES * QT;
constexpr size_t WS_YS = WS_ACT8 + (size_t)XP_TILES * QT;
constexpr size_t WS_P = WS_YS + (size_t)XP_TILES * TILE;
#define Q8(off) ((int)((off) / QT))
constexpr size_t WS_HF = WS_P + 112 * MiB;
constexpr size_t WS_PRE = WS_HF + 128 * MiB;
constexpr size_t WS_KB = WS_PRE + 128 * MiB;
constexpr size_t WS_VT = WS_KB + 8 * MiB;
constexpr size_t WS_TOKES = WS_VT + 8 * MiB;
constexpr size_t WS_TOKG = WS_TOKES + 512 * 1024;
constexpr size_t WS_ROWIDX = WS_TOKG + 512 * 1024;
constexpr size_t WS_NV_VN = WS_ROWIDX + 512 * 1024;
constexpr size_t WS_NV_DP = WS_NV_VN + 32 * MiB;
constexpr size_t WS_NV_Y = WS_NV_DP + 32 * MiB;
constexpr size_t WS_END = WS_NV_Y + 128 * MiB;
constexpr int CW_TMO = 0, CW_CODE = 1;
constexpr int CW_BAR = 4096;
constexpr int CW_CNT = 16384;
static_assert((CW_CNT + NLAYER * NEXP * 16) * 4 <= (int)CTL_ZERO_BYTES, "CTL words inside the memset region");
constexpr int RING_OFF = 0, RING_BYTES = 131072;
constexpr int LDSCTL_OFF = 147456 - 1024, MISC_OFF = LDSCTL_OFF + 320, TOFF_OFF = MISC_OFF + 128;
constexpr int LDS_BYTES = 147456;
static_assert(TOFF_OFF + 160 <= LDS_BYTES, "LDS map");

__device__ __forceinline__ float bf2f(unsigned short b) { return __builtin_bit_cast(float, (unsigned)b << 16); }
__device__ __forceinline__ float wave_sum(float v) {
#pragma unroll
    for (int o = 1; o < 64; o <<= 1) v += __shfl_xor(v, o);
    return v;
}
__device__ __forceinline__ float gelu_tanh(float x) {
    const float u = 0.7978845608028654f * (x + 0.044715f * x * x * x);
    return x * __builtin_amdgcn_rcpf(1.0f + __builtin_amdgcn_exp2f(u * (-2.0f * 1.4426950408889634f)));
}

struct Frame {
    LAS unsigned char* lds;
    volatile LAS unsigned* MISC;
    gu32* ctl;
    unsigned char* ws;
    int tid, lane, wave, G;
    float* out;
};
struct Args { const float* in[27]; float* out; unsigned char* ws; int ph_lo, ph_hi; };
enum { I_X = 0, I_MEM, I_LN_IN_G, I_LN_IN_B, I_MEM_LN_G, I_MEM_LN_B, I_W_IN, I_CONV_W, I_POOL_W, I_POOL_SCALE, I_GMLP_LN_G, I_GMLP_LN_B, I_GMLP_W, I_GMLP_B, I_W_MEM_KV, I_GROUP_NORM_G, I_W_OUT,
       I_LN1_G, I_LN1_B, I_W_ROUTER, I_B_ROUTER, I_W1, I_B1, I_W2, I_B2, I_LN2_G, I_LN2_B };
#define RELANE(F) do { int t_ = threadIdx.x; asm volatile("" : "+v"(t_)); (F).tid = t_; (F).lane = t_ & 63; (F).wave = __builtin_amdgcn_readfirstlane(t_ >> 6); } while (0)
#define WSP(T, off) ((T*)(F.ws + (off)))
#define TILEP(t) ((bf16*)(F.ws + (size_t)(t) * TILE))

__device__ __forceinline__ void tr64(const float* W, int ldw, int k0, int n0, bf16* WT, int ldt, int drow0, LAS float* scr, int lane) {
    const int c4 = 4 * (lane & 15), kq = lane >> 4;
#pragma unroll
    for (int i = 0; i < 16; ++i) { const int kk = 4 * i + kq; const f32x4 v = *(const f32x4*)(W + (size_t)(k0 + kk) * ldw + n0 + c4);
        LAS float* s = scr + kk * 65 + c4; s[0] = v.x; s[1] = v.y; s[2] = v.z; s[3] = v.w; }
    LDS_WAIT(); asm volatile("" ::: "memory");
    const int ck = lane & 7;
#pragma unroll
    for (int j = 0; j < 8; ++j) { const int n = (lane >> 3) + 8 * j; const LAS float* s = scr + (8 * ck) * 65 + n;
        v4u o; o.x = pk2(s[0 * 65], s[1 * 65]); o.y = pk2(s[2 * 65], s[3 * 65]); o.z = pk2(s[4 * 65], s[5 * 65]); o.w = pk2(s[6 * 65], s[7 * 65]);
        *(v4u*)(WT + (size_t)(drow0 + n) * ldt + k0 + 8 * ck) = o; }
    LDS_WAIT(); asm volatile("" ::: "memory");
}
__device__ __forceinline__ void tr64_fp8(const float* W, int ldw, int k0, int n0, unsigned char* WT, int drow0, float scale, LAS float* scr, int lane) {
    const int c4 = 4 * (lane & 15), kq = lane >> 4;
#pragma unroll
    for (int i = 0; i < 16; ++i) { const int kk = 4 * i + kq; const f32x4 v = *(const f32x4*)(W + (size_t)(k0 + kk) * ldw + n0 + c4);
        LAS float* s = scr + kk * 65 + c4; s[0] = v.x; s[1] = v.y; s[2] = v.z; s[3] = v.w; }
    LDS_WAIT(); asm volatile("" ::: "memory");
    const int ck = lane & 7;
#pragma unroll
    for (int j = 0; j < 8; ++j) { const int n = (lane >> 3) + 8 * j; const LAS float* s = scr + (8 * ck) * 65 + n;
        v2u o; o.x = pg8::cvt4_fp8(s[0 * 65] * scale, s[1 * 65] * scale, s[2 * 65] * scale, s[3 * 65] * scale); o.y = pg8::cvt4_fp8(s[4 * 65] * scale, s[5 * 65] * scale, s[6 * 65] * scale, s[7 * 65] * scale);
        *(v2u*)(WT + (size_t)(drow0 + n) * 1024 + k0 + 8 * ck) = o; }
    LDS_WAIT(); asm volatile("" ::: "memory");
}
__device__ __forceinline__ void ln_affine(f32x4 (&v)[4], const float* gam, const float* bet, int lane) {
    float s = 0.f;
#pragma unroll
    for (int j = 0; j < 4; ++j) s += (v[j].x + v[j].y) + (v[j].z + v[j].w);
    const float mean = wave_sum(s) * (1.f / 1024.f); float s2 = 0.f;
#pragma unroll
    for (int j = 0; j < 4; ++j) { v[j] = v[j] - mean; s2 += (v[j].x * v[j].x + v[j].y * v[j].y) + (v[j].z * v[j].z + v[j].w * v[j].w); }
    const float rstd = 1.f / sqrtf(wave_sum(s2) * (1.f / 1024.f) + LN_EPS);
#pragma unroll
    for (int j = 0; j < 4; ++j) { const f32x4 g = *(const f32x4*)(gam + 4 * lane + 256 * j), b = *(const f32x4*)(bet + 4 * lane + 256 * j); v[j] = v[j] * rstd * g + b; }
}
__device__ __forceinline__ void store_row_bf16(bf16* orow, const f32x4 (&v)[4], int lane) {
#pragma unroll
    for (int j = 0; j < 4; ++j) { v2u o; o.x = pk2(v[j].x, v[j].y); o.y = pk2(v[j].z, v[j].w); *(v2u*)(orow + 4 * lane + 256 * j) = o; }
}
__device__ __forceinline__ void p0_prologue(Frame& F, const Args& A) {
    RELANE(F);
    LAS float* scr = (LAS float*)(F.lds + RING_OFF + F.wave * 16640);
    const int gw = blockIdx.x * NWAVES + F.wave, NGW = F.G * NWAVES;
    constexpr int NI_W1 = NLAYER * NEXP * 16 * 32, NI_W2 = NLAYER * NEXP * 16 * 16, NI_WIN = NLAYER * 16 * 28, NI_WOUT = NLAYER * 16 * 16, NI_WKV = NLAYER * 16 * 8, NI_POOL = NLAYER * 4;
    constexpr int NITEMS = NI_W1 + NI_W2 + NI_WIN + NI_WOUT + NI_WKV + NI_POOL;
    for (int it = gw; it < NITEMS; it += NGW) {
        int r = it;
        if (r < NI_W1) { const int le = r >> 9, rr = r & 511, kb = rr >> 5, nb = rr & 31; const int n0 = 64 * nb, nn = n0 & 1023;
            const int drow = (nn >> 7) * 256 + (n0 >= 1024 ? 128 : 0) + (nn & 127);
            tr64_fp8(A.in[I_W1] + (size_t)le * 1024 * 2048, 2048, 64 * kb, n0, F.ws + WS_W18 + (size_t)le * 2048 * 1024, drow, 32.0f, scr, F.lane); continue; } r -= NI_W1;
        if (r < NI_W2) { const int le = r >> 8, rr = r & 255, kb = rr >> 4, nb = rr & 15;
            tr64_fp8(A.in[I_W2] + (size_t)le * 1024 * 1024, 1024, 64 * kb, 64 * nb, F.ws + WS_W28 + (size_t)le * 1024 * 1024, 64 * nb, 64.0f, scr, F.lane); continue; } r -= NI_W2;
        if (r < NI_WIN) { const int l = r / 448, rr = r % 448, kb = rr / 28, nb = rr % 28;
            tr64(A.in[I_W_IN] + (size_t)l * 1024 * NPROJ, NPROJ, 64 * kb, 64 * nb, TILEP(T_WIN) + (size_t)l * NPROJ * 1024, 1024, 64 * nb, scr, F.lane); continue; } r -= NI_WIN;
        if (r < NI_WOUT) { const int l = r >> 8, rr = r & 255, kb = rr >> 4, nb = rr & 15;
            tr64(A.in[I_W_OUT] + (size_t)l * 1024 * 1024, 1024, 64 * kb, 64 * nb, TILEP(T_WOUT) + (size_t)l * 1024 * 1024, 1024, 64 * nb, scr, F.lane); continue; } r -= NI_WOUT;
        if (r < NI_WKV) { const int l = r >> 7, rr = r & 127, kb = rr >> 3, nb = rr & 7;
            tr64(A.in[I_W_MEM_KV] + (size_t)l * 1024 * 512, 512, 64 * kb, 64 * nb, TILEP(T_WKV) + (size_t)l * 512 * 1024, 1024, 64 * nb, scr, F.lane); continue; } r -= NI_WKV;
        tr64(A.in[I_POOL_W] + (size_t)r * 64 * 64, 64, 0, 0, WSP(bf16, WS_POOLT) + (size_t)r * 64 * 64, 64, 0, scr, F.lane);
    }
    const int gt = blockIdx.x * (NWAVES * 64) + F.tid, NGT = F.G * NWAVES * 64;
    for (int i = gt; i < NLAYER * 4 * 128 * 128; i += NGT) { const int j = i & 127, ii = (i >> 7) & 127; WSP(bf16, WS_WMB)[i] = (bf16)(((j >> 6) <= (ii >> 6)) ? f2bf(A.in[I_GMLP_W][i]) : 0u); }
    for (int i = gt; i < NLAYER * 32 * 1024; i += NGT) { const int k = i & 1023, e = (i >> 10) & 31, l = i >> 15; WSP(bf16, WS_WRT)[i] = (bf16)f2bf(A.in[I_W_ROUTER][((size_t)l * 1024 + k) * 32 + e]); }
    for (int m = gw; m < NTOK + NBATCH * NMEM; m += NGW) {
        const bool ismem = m >= NTOK; const int row = ismem ? m - NTOK : m;
        const float* src = (ismem ? A.in[I_MEM] : A.in[I_X]) + (size_t)row * D;
        f32x4 v[4];
#pragma unroll
        for (int j = 0; j < 4; ++j) v[j] = *(const f32x4*)(src + 4 * F.lane + 256 * j);
        ln_affine(v, ismem ? A.in[I_MEM_LN_G] : A.in[I_LN_IN_G], ismem ? A.in[I_MEM_LN_B] : A.in[I_LN_IN_B], F.lane);
        if (!ismem) {
            float* hf = WSP(float, WS_HF) + (size_t)row * D;
#pragma unroll
            for (int j = 0; j < 4; ++j) *(f32x4*)(hf + 4 * F.lane + 256 * j) = v[j];
        }
        store_row_bf16((ismem ? TILEP(T_MEMN) : TILEP(T_HB)) + (size_t)row * D, v, F.lane);
    }
}

struct DenseOrder {
    int nM, nN, G, c, a_t0, b_t0;
    __device__ __forceinline__ bool next(int i, pg8::Unit& u) const {
        const long L = (long)i * G + c; if (L >= (long)nM * nN) return false;
        int tm, tn; pg8::tile_of((int)L, nM, nN, tm, tn); u.pm = a_t0 + tm; u.pn = b_t0 + tn; u.lm = tm; u.ln = tn; u.a0 = 0; return true;
    }
    __device__ __forceinline__ void a_ready(const pg8::Unit&) const {}
    __device__ __forceinline__ void done(const pg8::Unit&) const {}
};
struct KvOrder {
    int G, c;
    __device__ __forceinline__ bool next(int i, pg8::Unit& u) const {
        const int L = i * G + c; if (L >= NLAYER * 32) return false;
        const int l = L >> 5, r = L & 31;
        if (r < 16) { u.pm = T_MEMN + r; u.pn = T_WKV + 2 * l; u.lm = l * 16 + r; u.ln = 0; u.a0 = 0; }
        else { u.pm = T_WKV + 2 * l + 1; u.pn = T_MEMN + (r - 16); u.lm = l; u.ln = r - 16; u.a0 = 1; }
        return true;
    }
    __device__ __forceinline__ void a_ready(const pg8::Unit&) const {}
    __device__ __forceinline__ void done(const pg8::Unit&) const {}
};
struct MoeOrder {
    int TM, NTN, G, c, a_t0, b_t0; const LAS int* toff;
    __device__ __forceinline__ bool next(int i, pg8::Unit& u) const {
        const long L = (long)i * G + c; if (L >= (long)TM * NTN) return false;
        int tm, tn; pg8::tile_of((int)L, TM, NTN, tm, tn);
        int e = 0;
#pragma unroll
        for (int j = 1; j < NEXP; ++j) e += (toff[j] <= tm) ? 1 : 0;
        e = __builtin_amdgcn_readfirstlane(e);
        u.pm = a_t0 + tm; u.pn = b_t0 + e * NTN + tn; u.lm = tm; u.ln = tn; u.a0 = e; return true;
    }
    __device__ __forceinline__ void a_ready(const pg8::Unit&) const {}
    __device__ __forceinline__ void done(const pg8::Unit&) const {}
};
__device__ __forceinline__ void compute_toff(Frame& F, int l) {
    RELANE(F);
    LAS int* toff = (LAS int*)(F.lds + TOFF_OFF);
    __syncthreads();
    if (F.wave == 0) {
        int t = 0;
        if (F.lane < NEXP) { const unsigned c = __hip_atomic_load(F.ctl + CW_CNT + (l * NEXP + F.lane) * 16, RLX_AGENT); t = (int)((c + 255u) >> 8); }
        int incl = t;
#pragma unroll
        for (int o = 1; o < 32; o <<= 1) { const int y = __shfl_up(incl, o); if ((F.lane & 31) >= o) incl += y; }
        if (F.lane < NEXP) toff[F.lane + 1] = incl;
        if (F.lane == 0) toff[0] = 0;
    }
    __syncthreads();
}

__device__ __forceinline__ void pd_phase(Frame& F, const Args& A, int l) {
    RELANE(F);
    LAS unsigned char* T = F.lds;
    LAS float* part = (LAS float*)(F.lds + 66048);
    LAS float* logit = (LAS float*)(F.lds + 82432);
    LAS int* cntl = (LAS int*)(F.lds + 86656);
    LAS int* basel = (LAS int*)(F.lds + 86784);
    LAS int* sel_e = (LAS int*)(F.lds + 86912);
    LAS int* sel_r = sel_e + 512; LAS float* sel_g = (LAS float*)(sel_r + 512);
    const float* gam = A.in[I_LN1_G] + l * D; const float* bet = A.in[I_LN1_B] + l * D;
    const bf16* wr = WSP(bf16, WS_WRT) + (size_t)l * NEXP * D; const float* br = A.in[I_B_ROUTER] + l * NEXP;
    const float* pre = WSP(float, WS_PRE); float* hf = WSP(float, WS_HF); bf16* hb = TILEP(T_HB); unsigned char* h8 = F.ws + WS_H8;
    const int r16 = F.lane & 15, g4 = F.lane >> 4;
    for (int blk = blockIdx.x; blk < NTOK / 128; blk += F.G) {
        if (F.tid < NEXP) cntl[F.tid] = 0;
        __syncthreads();
        for (int it = 0; it < 4; ++it) {
            const int r0 = blk * 128 + it * 32;
#pragma unroll 1
            for (int q = 0; q < 4; ++q) {
                const int lr = F.wave * 4 + q; const size_t row = (size_t)(r0 + lr);
                f32x4 v[4];
#pragma unroll
                for (int j = 0; j < 4; ++j) v[j] = *(const f32x4*)(pre + row * D + 4 * F.lane + 256 * j);
                ln_affine(v, gam, bet, F.lane);
#pragma unroll
                for (int j = 0; j < 4; ++j) { *(f32x4*)(hf + row * D + 4 * F.lane + 256 * j) = v[j];
                    v2u o; o.x = pk2(v[j].x, v[j].y); o.y = pk2(v[j].z, v[j].w);
                    *(v2u*)(hb + row * D + 4 * F.lane + 256 * j) = o; *(LAS v2u*)(T + lr * 2064 + (4 * F.lane + 256 * j) * 2) = o;
                    *(unsigned*)(h8 + row * D + 4 * F.lane + 256 * j) = pg8::cvt4_fp8(v[j].x * 16.0f, v[j].y * 16.0f, v[j].z * 16.0f, v[j].w * 16.0f); }
            }
            __syncthreads();
            {
                const int mt = F.wave & 1, kq = F.wave >> 1;
                f32x4 a0 = {0.f, 0.f, 0.f, 0.f}, a1 = {0.f, 0.f, 0.f, 0.f};
#pragma unroll
                for (int ks = 0; ks < 8; ++ks) { const int k0 = 256 * kq + 32 * ks + 8 * g4;
                    const bf16x8 a = *(const LAS bf16x8*)(T + (16 * mt + r16) * 2064 + k0 * 2);
                    const bf16x8 b0 = *(const bf16x8*)(wr + (size_t)r16 * D + k0), b1 = *(const bf16x8*)(wr + (size_t)(16 + r16) * D + k0);
                    a0 = __builtin_amdgcn_mfma_f32_16x16x32_bf16(a, b0, a0, 0, 0, 0); a1 = __builtin_amdgcn_mfma_f32_16x16x32_bf16(a, b1, a1, 0, 0, 0); }
#pragma unroll
                for (int i = 0; i < 4; ++i) { part[kq * 1024 + (16 * mt + 4 * g4 + i) * 32 + r16] = a0[i]; part[kq * 1024 + (16 * mt + 4 * g4 + i) * 32 + 16 + r16] = a1[i]; }
            }
            __syncthreads();
            for (int idx = F.tid; idx < 1024; idx += NWAVES * 64) { const int rr = idx >> 5, e = idx & 31;
                logit[rr * 33 + e] = ((part[idx] + part[1024 + idx]) + (part[2048 + idx] + part[3072 + idx])) + br[e]; }
            __syncthreads();
            if (F.tid < 32) {
                const LAS float* lg = logit + F.tid * 33; float tv[4]; int ti[4];
#pragma unroll
                for (int k = 0; k < 4; ++k) { float best = -3.0e38f; int bi = 0;
                    for (int e = 0; e < NEXP; ++e) { const float x = lg[e]; bool taken = false;
#pragma unroll
                        for (int kk = 0; kk < 4; ++kk) if (kk < k && ti[kk] == e) taken = true;
                        if (!taken && x > best) { best = x; bi = e; } }
                    tv[k] = best; ti[k] = bi; }
                float ex[4], sum = 0.f;
#pragma unroll
                for (int k = 0; k < 4; ++k) { ex[k] = __expf(tv[k] - tv[0]); sum += ex[k]; }
                const float inv = 1.0f / sum;
#pragma unroll
                for (int k = 0; k < 4; ++k) { const int p = (it * 32 + F.tid) * 4 + k; sel_e[p] = ti[k]; sel_r[p] = __hip_atomic_fetch_add(cntl + ti[k], 1, __ATOMIC_RELAXED, __HIP_MEMORY_SCOPE_WORKGROUP); sel_g[p] = ex[k] * inv; }
            }
        }
        __syncthreads();
        if (F.tid < NEXP) basel[F.tid] = (int)__hip_atomic_fetch_add(F.ctl + CW_CNT + (l * NEXP + F.tid) * 16, (unsigned)cntl[F.tid], RLX_AGENT);
        __syncthreads();
        { const int p = F.tid, e = sel_e[p], slot = basel[e] + sel_r[p];
          WSP(int, WS_TOKES)[(size_t)blk * 512 + p] = (e << 16) | slot; WSP(float, WS_TOKG)[(size_t)blk * 512 + p] = sel_g[p]; }
        __syncthreads();
    }
}
__device__ __forceinline__ void pe_phase(Frame& F, int l) {
    RELANE(F);
    compute_toff(F, l);
    const LAS int* toff = (const LAS int*)(F.lds + TOFF_OFF);
    const unsigned char* h8 = F.ws + WS_H8; unsigned char* xp = F.ws + WS_XP8;
    for (int blk = blockIdx.x; blk < NTOK / 128; blk += F.G) {
        const int p0 = blk * 512 + F.wave * 64;
        const int es = WSP(int, WS_TOKES)[p0 + F.lane];
        const int rowl = toff[es >> 16] * 256 + (es & 0xffff);
        WSP(int, WS_ROWIDX)[p0 + F.lane] = rowl;
#pragma unroll 8
        for (int p = 0; p < 64; ++p) { const int row = __shfl(rowl, p); const int t = (p0 + p) >> 2;
            const v4u a = *(const v4u*)(h8 + (size_t)t * D + 16 * F.lane);
            *(v4u*)(xp + (size_t)row * D + 16 * F.lane) = a; }
    }
}
__device__ __forceinline__ void ph_phase(Frame& F, const Args& A, int l) {
    RELANE(F);
    const int gw = blockIdx.x * NWAVES + F.wave, NGW = F.G * NWAVES;
    const float* gam = A.in[I_LN2_G] + l * D; const float* bet = A.in[I_LN2_B] + l * D;
    float* hf = WSP(float, WS_HF); bf16* hb = TILEP(T_HB); const bf16* ys = WSP(bf16, WS_YS);
    for (int t = gw; t < NTOK; t += NGW) {
        int ri = 0; float gk = 0.f;
        if (F.lane < 4) { ri = WSP(int, WS_ROWIDX)[(size_t)t * 4 + F.lane]; gk = WSP(float, WS_TOKG)[(size_t)t * 4 + F.lane]; }
        f32x4 v[4];
#pragma unroll
        for (int j = 0; j < 4; ++j) v[j] = *(const f32x4*)(hf + (size_t)t * D + 4 * F.lane + 256 * j) * DN_ALPHA;
#pragma unroll
        for (int k = 0; k < 4; ++k) { const int row = __shfl(ri, k); const float g = __shfl(gk, k);
#pragma unroll
            for (int j = 0; j < 4; ++j) { const v2u raw = *(const v2u*)(ys + (size_t)row * D + 4 * F.lane + 256 * j);
                v[j].x += g * __builtin_bit_cast(float, raw.x << 16); v[j].y += g * __builtin_bit_cast(float, raw.x & 0xffff0000u);
                v[j].z += g * __builtin_bit_cast(float, raw.y << 16); v[j].w += g * __builtin_bit_cast(float, raw.y & 0xffff0000u); } }
        ln_affine(v, gam, bet, F.lane);
        if (l == NLAYER - 1) {
#pragma unroll
            for (int j = 0; j < 4; ++j) *(f32x4*)(F.out + (size_t)t * D + 4 * F.lane + 256 * j) = v[j];
        } else {
#pragma unroll
            for (int j = 0; j < 4; ++j) *(f32x4*)(hf + (size_t)t * D + 4 * F.lane + 256 * j) = v[j];
            store_row_bf16(hb + (size_t)t * D, v, F.lane);
        }
    }
}

constexpr int MX_VT = 0, MX_K = 65536, MX_V = 65536 + 32768;
__device__ __forceinline__ void unpack8(const v4u raw, float (&f)[8]) {
    f[0] = __builtin_bit_cast(float, raw.x << 16); f[1] = __builtin_bit_cast(float, raw.x & 0xffff0000u); f[2] = __builtin_bit_cast(float, raw.y << 16); f[3] = __builtin_bit_cast(float, raw.y & 0xffff0000u);
    f[4] = __builtin_bit_cast(float, raw.z << 16); f[5] = __builtin_bit_cast(float, raw.z & 0xffff0000u); f[6] = __builtin_bit_cast(float, raw.w << 16); f[7] = __builtin_bit_cast(float, raw.w & 0xffff0000u);
}
__device__ __forceinline__ void mix_finish(float (&val)[8][8], const float* gain, bf16* grow, int q) {
    float ss = 0.f;
#pragma unroll
    for (int cb = 0; cb < 8; ++cb)
#pragma unroll
        for (int i = 0; i < 8; ++i) ss += val[cb][i] * val[cb][i];
    ss += __shfl_xor(ss, 16); ss += __shfl_xor(ss, 32);
    const float rs = 1.0f / sqrtf(ss * (1.0f / 256.0f) + RMS_EPS);
#pragma unroll
    for (int cb = 0; cb < 8; ++cb) { const f32x4 g0 = *(const f32x4*)(gain + 32 * cb + 8 * q), g1 = *(const f32x4*)(gain + 32 * cb + 8 * q + 4);
        v4u o; o.x = pk2(val[cb][0] * rs * g0.x, val[cb][1] * rs * g0.y); o.y = pk2(val[cb][2] * rs * g0.z, val[cb][3] * rs * g0.w);
        o.z = pk2(val[cb][4] * rs * g1.x, val[cb][5] * rs * g1.y); o.w = pk2(val[cb][6] * rs * g1.z, val[cb][7] * rs * g1.w);
        *(v4u*)(grow + 32 * cb + 8 * q) = o; }
}
__device__ __forceinline__ void pb_phase(Frame& F, const Args& A, int l) {
    for (int u = blockIdx.x; u < NTOK / 128; u += F.G) {
    RELANE(F);
    const int r = F.lane & 15, q = F.lane >> 4, w = F.wave;
    const bf16* P = WSP(bf16, WS_P); bf16* G = TILEP(T_G);
    const float* gng = A.in[I_GROUP_NORM_G] + l * 1024;
        const int row = u * 128 + 16 * w + r, tseq = (u & 15) * 128 + 16 * w + r, b = u >> 4;
        const bf16* prow = P + (size_t)row * NPROJ; bf16* grow = G + (size_t)row * 1024;
        float val[8][8];
#if MXMASK & 1
        {
            const float* cw = A.in[I_CONV_W] + l * 768;
#pragma unroll
            for (int cb = 0; cb < 8; ++cb) { const int col = 32 * cb + 8 * q;
                float gb[8], zc[8], zh[8], z[8], acc[8];
                unpack8(*(const v4u*)(prow + col), gb);
#pragma unroll
                for (int i = 0; i < 8; ++i) acc[i] = 0.f;
#pragma unroll
                for (int d = 0; d < 3; ++d) {
                    if (tseq - 2 + d >= 0) { const bf16* pr = prow - (size_t)(2 - d) * NPROJ;
                        unpack8(*(const v4u*)(pr + 256 + col), zc); unpack8(*(const v4u*)(pr + 512 + col), zh);
                        const f32x4 w0 = *(const f32x4*)(cw + d * 256 + col), w1 = *(const f32x4*)(cw + d * 256 + col + 4);
#pragma unroll
                        for (int i = 0; i < 8; ++i) z[i] = zc[i] * zh[i];
                        acc[0] += w0.x * z[0]; acc[1] += w0.y * z[1]; acc[2] += w0.z * z[2]; acc[3] += w0.w * z[3]; acc[4] += w1.x * z[4]; acc[5] += w1.y * z[5]; acc[6] += w1.z * z[6]; acc[7] += w1.w * z[7]; } }
#pragma unroll
                for (int i = 0; i < 8; ++i) val[cb][i] = gb[i] * acc[i];
                asm volatile("" ::: "memory"); }
            mix_finish(val, gng, grow, q);
        }
#endif
        asm volatile("" ::: "memory"); __builtin_amdgcn_sched_barrier(0);
#if MXMASK & 2
        {
            const bf16* pt = WSP(bf16, WS_POOLT) + (size_t)l * 4 * 4096;
            bf16x8 dfr[4][2];
#pragma unroll
            for (int g = 0; g < 4; ++g)
#pragma unroll
                for (int ks = 0; ks < 2; ++ks) { const int col = 768 + g * 64 + 32 * ks + 8 * q, wlen = 2 << g;
                    float acc[8], x[8], t8[8];
                    unpack8(*(const v4u*)(prow + col), x);
#pragma unroll
                    for (int i = 0; i < 8; ++i) acc[i] = x[i];
                    for (int d = 1; d < wlen; ++d) if (tseq - d >= 0) { unpack8(*(const v4u*)(prow - (size_t)d * NPROJ + col), t8);
#pragma unroll
                        for (int i = 0; i < 8; ++i) acc[i] += t8[i]; }
                    const float inv = 1.0f / (float)((tseq + 1 < wlen) ? tseq + 1 : wlen);
                    v4u o; o.x = pk2(acc[0] * inv - x[0], acc[1] * inv - x[1]); o.y = pk2(acc[2] * inv - x[2], acc[3] * inv - x[3]);
                    o.z = pk2(acc[4] * inv - x[4], acc[5] * inv - x[5]); o.w = pk2(acc[6] * inv - x[6], acc[7] * inv - x[7]);
                    dfr[g][ks] = __builtin_bit_cast(bf16x8, o);
                    asm volatile("" ::: "memory"); }
            const float* psc = A.in[I_POOL_SCALE] + l * 256;
#pragma unroll
            for (int g = 0; g < 4; ++g)
#pragma unroll
                for (int mt2 = 0; mt2 < 2; ++mt2) { const f32x4 s0 = *(const f32x4*)(psc + g * 64 + 32 * mt2 + 8 * q), s1 = *(const f32x4*)(psc + g * 64 + 32 * mt2 + 8 * q + 4);
#pragma unroll
                    for (int e = 0; e < 2; ++e) { const int dd = 32 * mt2 + 8 * (r >> 2) + 4 * e + (r & 3);
                        f32x4 o = {0.f, 0.f, 0.f, 0.f};
#pragma unroll
                        for (int ks = 0; ks < 2; ++ks) { const bf16x8 a = *(const bf16x8*)(pt + (size_t)(g * 64 + dd) * 64 + 32 * ks + 8 * q);
                            o = __builtin_amdgcn_mfma_f32_16x16x32_bf16(a, dfr[g][ks], o, 0, 0, 0); }
                        const f32x4 sc = e ? s1 : s0;
                        val[2 * g + mt2][4 * e + 0] = o[0] * sc.x; val[2 * g + mt2][4 * e + 1] = o[1] * sc.y; val[2 * g + mt2][4 * e + 2] = o[2] * sc.z; val[2 * g + mt2][4 * e + 3] = o[3] * sc.w; } }
            mix_finish(val, gng + 256, grow + 256, q);
        }
#endif
        asm volatile("" ::: "memory"); __builtin_amdgcn_sched_barrier(0);
#if MXMASK & 4
        {
            const float* lg = A.in[I_GMLP_LN_G] + l * 256; const float* lb = A.in[I_GMLP_LN_B] + l * 256;
            const f32x4 g4 = *(const f32x4*)(lg + 4 * F.lane), b4 = *(const f32x4*)(lb + 4 * F.lane);
            const int hh_l = F.lane >> 4, mt2_l = (F.lane & 15) >> 3, q_l = (F.lane & 7) >> 1, e_l = F.lane & 1;
#pragma unroll 2
            for (int jp = 0; jp < 8; ++jp) { const int j = 16 * w + 2 * jp;
                const bf16* p0 = P + (size_t)(u * 128 + j) * NPROJ + 1280 + 4 * F.lane;
                const v2u ra = *(const v2u*)p0, rb = *(const v2u*)(p0 + NPROJ);
                float va[4], vb[4];
                va[0] = gelu_tanh(__builtin_bit_cast(float, ra.x << 16)); va[1] = gelu_tanh(__builtin_bit_cast(float, ra.x & 0xffff0000u)); va[2] = gelu_tanh(__builtin_bit_cast(float, ra.y << 16)); va[3] = gelu_tanh(__builtin_bit_cast(float, ra.y & 0xffff0000u));
                vb[0] = gelu_tanh(__builtin_bit_cast(float, rb.x << 16)); vb[1] = gelu_tanh(__builtin_bit_cast(float, rb.x & 0xffff0000u)); vb[2] = gelu_tanh(__builtin_bit_cast(float, rb.y << 16)); vb[3] = gelu_tanh(__builtin_bit_cast(float, rb.y & 0xffff0000u));
                const float ma = wave_sum((va[0] + va[1]) + (va[2] + va[3])) * (1.f / 256.f), mb = wave_sum((vb[0] + vb[1]) + (vb[2] + vb[3])) * (1.f / 256.f);
                float sa = 0.f, sb = 0.f;
#pragma unroll
                for (int c = 0; c < 4; ++c) { va[c] -= ma; vb[c] -= mb; sa += va[c] * va[c]; sb += vb[c] * vb[c]; }
                const float ra_ = 1.f / sqrtf(wave_sum(sa) * (1.f / 256.f) + LN_EPS), rb_ = 1.f / sqrtf(wave_sum(sb) * (1.f / 256.f) + LN_EPS);
                const int ks = j >> 5, gg = (j & 31) >> 3, jj = j & 7;
                LAS unsigned char* dst = F.lds + MX_VT + ((((hh_l * 2 + mt2_l) * 2 + e_l) * 4 + ks) * 64 + 16 * gg + 4 * q_l) * 16 + jj * 2;
                const float ga[4] = {g4.x, g4.y, g4.z, g4.w}, ba[4] = {b4.x, b4.y, b4.z, b4.w};
#pragma unroll
                for (int c = 0; c < 4; ++c) *(LAS unsigned*)(dst + c * 16) = pk2(va[c] * ra_ * ga[c] + ba[c], vb[c] * rb_ * ga[c] + ba[c]);
            }
            __syncthreads();
            const bf16* wm = WSP(bf16, WS_WMB) + (size_t)l * 4 * 128 * 128; const float* gbias = A.in[I_GMLP_B] + l * 512;
            const int nks = (w < 4) ? 2 : 4;
#pragma unroll
            for (int hh = 0; hh < 4; ++hh) {
                bf16x8 wf[4];
#pragma unroll
                for (int ks = 0; ks < 4; ++ks) wf[ks] = *(const bf16x8*)(wm + (size_t)(hh * 128 + 16 * w + r) * 128 + 32 * ks + 8 * q);
                const float bias = gbias[hh * 128 + 16 * w + r];
#pragma unroll
                for (int mt2 = 0; mt2 < 2; ++mt2) {
                    float uu[8]; unpack8(*(const v4u*)(prow + 1024 + hh * 64 + 32 * mt2 + 8 * q), uu);
#pragma unroll
                    for (int e = 0; e < 2; ++e) { f32x4 o = {0.f, 0.f, 0.f, 0.f};
#pragma unroll
                        for (int ks = 0; ks < 4; ++ks) if (ks < nks) { const bf16x8 a = *(const LAS bf16x8*)(F.lds + MX_VT + ((((hh * 2 + mt2) * 2 + e) * 4 + ks) * 64 + F.lane) * 16);
                            o = __builtin_amdgcn_mfma_f32_16x16x32_bf16(a, wf[ks], o, 0, 0, 0); }
#pragma unroll
                        for (int i = 0; i < 4; ++i) val[2 * hh + mt2][4 * e + i] = gelu_tanh(uu[4 * e + i]) * (o[i] + bias); } }
            }
            mix_finish(val, gng + 512, grow + 512, q);
        }
#endif
        asm volatile("" ::: "memory"); __builtin_amdgcn_sched_barrier(0);
#if MXMASK & 8
        {
            const bf16* kb = WSP(bf16, WS_KB) + ((size_t)l * 4096 + (size_t)b * 256) * 256;
            const bf16* vt = WSP(bf16, WS_VT) + (size_t)l * 256 * 4096 + (size_t)b * 256;
            float rsum[4];
#pragma unroll
            for (int hh = 0; hh < 4; ++hh) {
                __syncthreads();
#pragma unroll
                for (int i = 0; i < 4; ++i) { const int idx = F.tid + 512 * i;
                    { const int key = idx >> 3, cidx = idx & 7; const v4u x = *(const v4u*)(kb + (size_t)key * 256 + hh * 64 + 8 * cidx);
                      *(LAS v4u*)(F.lds + MX_K + ((((key >> 4) * 2 + (cidx >> 2)) * 64) + 16 * (cidx & 3) + (key & 15)) * 16) = x; }
                    { const int d = idx >> 5, c16 = idx & 31; const v4u x = *(const v4u*)(vt + (size_t)(hh * 64 + d) * 4096 + 8 * c16);
                      const int key0 = 8 * c16, s = key0 >> 5, kk = key0 & 31, half = kk >> 4, gA = (kk & 15) >> 2, mt2 = d >> 5, rem = d & 31, m = 4 * (rem >> 3) + (rem & 3), e = (rem >> 2) & 1;
                      LAS unsigned char* dst = F.lds + MX_V + ((((mt2 * 2 + e) * 8 + s) * 64) + 16 * gA + m) * 16 + half * 8;
                      v2u lo; lo.x = x.x; lo.y = x.y; v2u hi; hi.x = x.z; hi.y = x.w; *(LAS v2u*)dst = lo; *(LAS v2u*)(dst + 256) = hi; } }
                const bf16x8 q0 = *(const bf16x8*)(prow + 1536 + hh * 64 + 8 * q), q1 = *(const bf16x8*)(prow + 1536 + hh * 64 + 32 + 8 * q);
                __syncthreads();
                f32x4 st[16];
#pragma unroll
                for (int t = 0; t < 16; ++t) { const bf16x8 k0 = *(const LAS bf16x8*)(F.lds + MX_K + ((t * 2 + 0) * 64 + F.lane) * 16), k1 = *(const LAS bf16x8*)(F.lds + MX_K + ((t * 2 + 1) * 64 + F.lane) * 16);
                    f32x4 z = {0.f, 0.f, 0.f, 0.f}; z = __builtin_amdgcn_mfma_f32_16x16x32_bf16(k0, q0, z, 0, 0, 0); st[t] = __builtin_amdgcn_mfma_f32_16x16x32_bf16(k1, q1, z, 0, 0, 0); }
                float mx = -3.0e38f;
#pragma unroll
                for (int t = 0; t < 16; ++t) mx = fmaxf(fmaxf(mx, fmaxf(st[t][0], st[t][1])), fmaxf(st[t][2], st[t][3]));
                mx = fmaxf(mx, __shfl_xor(mx, 16)); mx = fmaxf(mx, __shfl_xor(mx, 32));
                float sum = 0.f; const float c2 = 0.125f * 1.4426950408889634f, mo = mx * c2;
#pragma unroll
                for (int t = 0; t < 16; ++t)
#pragma unroll
                    for (int i = 0; i < 4; ++i) { const float p = __builtin_amdgcn_exp2f(st[t][i] * c2 - mo); st[t][i] = p; sum += p; }
                sum += __shfl_xor(sum, 16); sum += __shfl_xor(sum, 32); rsum[hh] = 1.0f / sum;
                bf16x8 pb[8];
#pragma unroll
                for (int s = 0; s < 8; ++s) { v4u o; o.x = pk2(st[2 * s][0], st[2 * s][1]); o.y = pk2(st[2 * s][2], st[2 * s][3]); o.z = pk2(st[2 * s + 1][0], st[2 * s + 1][1]); o.w = pk2(st[2 * s + 1][2], st[2 * s + 1][3]);
                    pb[s] = __builtin_bit_cast(bf16x8, o); }
#pragma unroll
                for (int mt2 = 0; mt2 < 2; ++mt2)
#pragma unroll
                    for (int e = 0; e < 2; ++e) { f32x4 o = {0.f, 0.f, 0.f, 0.f};
#pragma unroll
                        for (int s = 0; s < 8; ++s) { const bf16x8 a = *(const LAS bf16x8*)(F.lds + MX_V + (((mt2 * 2 + e) * 8 + s) * 64 + F.lane) * 16);
                            o = __builtin_amdgcn_mfma_f32_16x16x32_bf16(a, pb[s], o, 0, 0, 0); }
#pragma unroll
                        for (int i = 0; i < 4; ++i) val[2 * hh + mt2][4 * e + i] = o[i] * rsum[hh]; }
            }
            mix_finish(val, gng + 768, grow + 768, q);
        }
#endif
        __syncthreads();
    }
}

#if NAIVE_MIX
__global__ void __launch_bounds__(256) nv_mix_pre(const bf16* P, const float* lng, const float* lnb, float* Vn, float* Dp) {
    const int row = blockIdx.x * 4 + (threadIdx.x >> 6), lane = threadIdx.x & 63;
    const bf16* p = P + (size_t)row * NPROJ;
    float v[4]; float s = 0.f;
    for (int i = 0; i < 4; ++i) { v[i] = gelu_tanh(bf2f(p[1280 + 4 * lane + i])); s += v[i]; }
    const float mean = wave_sum(s) * (1.f / 256.f); float s2 = 0.f;
    for (int i = 0; i < 4; ++i) { v[i] -= mean; s2 += v[i] * v[i]; }
    const float rstd = 1.f / sqrtf(wave_sum(s2) * (1.f / 256.f) + LN_EPS);
    for (int i = 0; i < 4; ++i) Vn[(size_t)row * 256 + 4 * lane + i] = v[i] * rstd * lng[4 * lane + i] + lnb[4 * lane + i];
    const int t = row % SEQ, w = 2 << (lane >> 4), cnt = (t + 1 < w) ? t + 1 : w;
    for (int i = 0; i < 4; ++i) { const int c = 4 * lane + i; float acc = 0.f;
        for (int d = 0; d < cnt; ++d) acc += bf2f(P[(size_t)(row - d) * NPROJ + 768 + c]);
        Dp[(size_t)row * 256 + c] = acc / (float)cnt - bf2f(p[768 + c]); }
}
__global__ void __launch_bounds__(256) nv_mix_main(const bf16* P, const float* Vn, const float* Dp, const bf16* Kb, const bf16* VT, const float* conv_w, const float* pool_w, const float* pool_scale,
                                                   const float* gmlp_w, const float* gmlp_b, float* Y) {
    const int row = blockIdx.x >> 2, grp = blockIdx.x & 3, c = threadIdx.x, t = row % SEQ;
    const bf16* p = P + (size_t)row * NPROJ; float y = 0.f;
    if (grp == 0) {
        float z[3];
        for (int d = 0; d < 3; ++d) { const int tt = t - 2 + d; z[d] = (tt >= 0) ? bf2f(P[(size_t)(row - 2 + d) * NPROJ + 256 + c]) * bf2f(P[(size_t)(row - 2 + d) * NPROJ + 512 + c]) : 0.f; }
        y = bf2f(p[c]) * (conv_w[c] * z[0] + conv_w[256 + c] * z[1] + conv_w[512 + c] * z[2]);
    } else if (grp == 1) {
        const int gi = c >> 6, dd = c & 63; float acc = 0.f;
        for (int cc = 0; cc < 64; ++cc) acc += Dp[(size_t)row * 256 + gi * 64 + cc] * pool_w[(gi * 64 + cc) * 64 + dd];
        y = acc * pool_scale[c];
    } else if (grp == 2) {
        const int hh = c >> 6, i = t & 127, jmax = ((i >> 6) + 1) * 64; const size_t blk0 = (size_t)(row - i); float acc = 0.f;
        for (int j = 0; j < jmax; ++j) acc += gmlp_w[(hh * 128 + i) * 128 + j] * Vn[(blk0 + j) * 256 + c];
        y = gelu_tanh(bf2f(p[1024 + c])) * (acc + gmlp_b[hh * 128 + i]);
    } else {
        const int hh = c >> 6, lane = c & 63, b = row / SEQ;
        const float q = bf2f(p[1536 + hh * 64 + lane]);
        float sc[4] = {0.f, 0.f, 0.f, 0.f};
        for (int d = 0; d < 64; ++d) { const float qd = __shfl(q, d);
            for (int m = 0; m < 4; ++m) sc[m] += qd * bf2f(Kb[(size_t)(b * 256 + lane + 64 * m) * 256 + hh * 64 + d]); }
        float mx = -3.0e38f;
        for (int m = 0; m < 4; ++m) { sc[m] *= 0.125f; mx = fmaxf(mx, sc[m]); }
        for (int o = 1; o < 64; o <<= 1) mx = fmaxf(mx, __shfl_xor(mx, o));
        float sum = 0.f;
        for (int m = 0; m < 4; ++m) { sc[m] = __expf(sc[m] - mx); sum += sc[m]; }
        sum = wave_sum(sum);
        float o = 0.f;
        for (int m = 0; m < 4; ++m) for (int j = 0; j < 64; ++j) { const float pj = __shfl(sc[m], j); o += pj * bf2f(VT[(size_t)(hh * 64 + lane) * 4096 + b * 256 + j + 64 * m]); }
        y = o / sum;
    }
    Y[(size_t)row * 1024 + grp * 256 + c] = y;
}
__global__ void __launch_bounds__(256) nv_mix_norm(const float* Y, const float* gng, bf16* G) {
    const int wv = blockIdx.x * 4 + (threadIdx.x >> 6), lane = threadIdx.x & 63, row = wv >> 2, grp = wv & 3;
    const float* y = Y + (size_t)row * 1024 + grp * 256; float v[4], s2 = 0.f;
    for (int i = 0; i < 4; ++i) { v[i] = y[4 * lane + i]; s2 += v[i] * v[i]; }
    const float r = 1.f / sqrtf(wave_sum(s2) * (1.f / 256.f) + RMS_EPS);
    for (int i = 0; i < 4; ++i) G[(size_t)row * 1024 + grp * 256 + 4 * lane + i] = (bf16)f2bf(v[i] * r * gng[grp * 256 + 4 * lane + i]);
}
#endif

constexpr int PH_PRO = 0, PH_KV = 1, PH_L0 = 2, PH_PER_LAYER = 8, N_PHASES = PH_L0 + NLAYER * PH_PER_LAYER;
__global__ void __launch_bounds__(NWAVES * 64, 2) fwd(Args args) {
    const Args& A = args;
    extern __shared__ __attribute__((aligned(16))) unsigned char lds[];
    Frame F;
    F.lds = (LAS unsigned char*)lds;
    F.MISC = (volatile LAS unsigned*)(F.lds + MISC_OFF);
    F.tid = threadIdx.x; F.lane = F.tid & 63; F.wave = __builtin_amdgcn_readfirstlane(F.tid >> 6);
    F.G = gridDim.x; F.ws = args.ws; F.ctl = (gu32*)(args.ws + WS_CTL); F.out = args.out;
    for (int u = F.tid; u < (LDS_BYTES - LDSCTL_OFF) / 4; u += NWAVES * 64) ((LAS unsigned*)(F.lds + LDSCTL_OFF))[u] = 0u;
    __syncthreads();
#if MK_ONE_LAUNCH
    XcdBarrier bar = xcd_barrier_post((unsigned*)(F.ctl + CW_BAR), F.MISC + 8);
#define GRID_BAR() xcd_barrier(bar)
#else
#define GRID_BAR() do { } while (0)
#endif
    const int lo = args.ph_lo, hi = args.ph_hi;
#define IN(k) (lo <= (k) && (k) < hi)
#define REP(q) for (int rep_ = 0; rep_ < ((DUP_PHASE == (q)) ? 2 : 1); ++rep_)
#define BOTH(k) (IN(k) && IN((k) + 1))
    const pg8::Gemm gm{(const pg8::bf16_t*)F.ws, (const pg8::bf16_t*)F.ws, D};
    const int c = (int)blockIdx.x;

    REP(100) if (IN(PH_PRO) && (PHMASK & 1)) { p0_prologue(F, args); if (BOTH(PH_PRO)) GRID_BAR(); }
    REP(101) if (IN(PH_KV) && (PHMASK & 2)) {
        KvOrder S{F.G, c};
        pg8::EpiBf16Sel E{WSP(bf16, WS_KB), WSP(bf16, WS_VT), 256, 4096};
        pg8::gemm_phase<pg8::EpiBf16Sel, KvOrder, true, true>(F.lds + RING_OFF, gm, S, E);
        if (BOTH(PH_KV)) GRID_BAR();
    }
    for (int l = 0; l < NLAYER; ++l) {
        const int pb = PH_L0 + l * PH_PER_LAYER;
        REP(0) if (IN(pb + 0) && (PHMASK & 4)) {
            DenseOrder S{NTOK / 256, NPROJ / 256, F.G, c, T_HB, T_WIN + l * (NPROJ / 256)};
            pg8::EpiBf16Sel E{WSP(bf16, WS_P), WSP(bf16, WS_P), NPROJ, NPROJ};
            pg8::gemm_phase<pg8::EpiBf16Sel, DenseOrder, true, true>(F.lds + RING_OFF, gm, S, E);
            if (BOTH(pb + 0)) GRID_BAR();
        }
        REP(1) if (IN(pb + 1) && (PHMASK & 512)) {
            pb_phase(F, args, l);
            if (BOTH(pb + 1)) GRID_BAR();
        }
        REP(2) if (IN(pb + 2) && (PHMASK & 8)) {
            DenseOrder S{NTOK / 256, D / 256, F.G, c, T_G, T_WOUT + l * (D / 256)};
            pg8::EpiResF32 E{WSP(float, WS_HF), WSP(float, WS_PRE), DN_ALPHA};
            pg8::gemm_phase<pg8::EpiResF32, DenseOrder, true, true>(F.lds + RING_OFF, gm, S, E);
            if (BOTH(pb + 2)) GRID_BAR();
        }
        if (IN(pb + 3) && (PHMASK & 16)) { pd_phase(F, args, l); if (BOTH(pb + 3)) GRID_BAR(); }
        REP(4) if (IN(pb + 4) && (PHMASK & 32)) { pe_phase(F, l); if (BOTH(pb + 4)) GRID_BAR(); }
        REP(5) if (IN(pb + 5) && (PHMASK & 64)) {
            compute_toff(F, l);
            const LAS int* toff = (const LAS int*)(F.lds + TOFF_OFF);
            MoeOrder S{__builtin_amdgcn_readfirstlane(toff[NEXP]), 8, F.G, c, Q8(WS_XP8), Q8(WS_W18) + l * NEXP * 8, toff};
            pg8::EpiSwiglu E{F.ws + WS_ACT8, A.in[I_B1] + (size_t)l * NEXP * 2048};
            pg8::gemm_phase<pg8::EpiSwiglu, MoeOrder, true, true, true>(F.lds + RING_OFF, gm, S, E);
            if (BOTH(pb + 5)) GRID_BAR();
        }
        REP(6) if (IN(pb + 6) && (PHMASK & 128)) {
            compute_toff(F, l);
            const LAS int* toff = (const LAS int*)(F.lds + TOFF_OFF);
            MoeOrder S{__builtin_amdgcn_readfirstlane(toff[NEXP]), 4, F.G, c, Q8(WS_ACT8), Q8(WS_W28) + l * NEXP * 4, toff};
            pg8::EpiDown E{WSP(bf16, WS_YS), A.in[I_B2] + (size_t)l * NEXP * 1024};
            pg8::gemm_phase<pg8::EpiDown, MoeOrder, true, true, true>(F.lds + RING_OFF, gm, S, E);
            if (BOTH(pb + 6)) GRID_BAR();
        }
        if (IN(pb + 7) && (PHMASK & 256)) { ph_phase(F, args, l); if (BOTH(pb + 7)) GRID_BAR(); }
    }
#undef IN
#undef BOTH
}

extern "C" void kernel_launch(void* const* d_in, const int* in_sizes, int n_in, void* d_out, int out_size, void* d_ws, size_t ws_size, hipStream_t stream) {
    static int grid = 0;
    if (grid == 0) {
        if (n_in != 27 || out_size != NTOK * D || ws_size < WS_END) { fprintf(stderr, "kernel_launch: unexpected problem (n_in %d, out %d, ws %zu < %zu)\n", n_in, out_size, ws_size, (size_t)WS_END); grid = -1; return; }
        int dev = 0, cus = 0, per_cu = 0;
        if (hipGetDevice(&dev) != hipSuccess || hipDeviceGetAttribute(&cus, hipDeviceAttributeMultiprocessorCount, dev) != hipSuccess) { grid = -1; return; }
        if (hipFuncSetAttribute((const void*)fwd, hipFuncAttributeMaxDynamicSharedMemorySize, LDS_BYTES) != hipSuccess) { fprintf(stderr, "kernel_launch: hipFuncSetAttribute failed\n"); grid = -1; return; }
        if (hipOccupancyMaxActiveBlocksPerMultiprocessor(&per_cu, (const void*)fwd, NWAVES * 64, LDS_BYTES) != hipSuccess || per_cu < 1) fprintf(stderr, "kernel_launch: occupancy query says %d\n", per_cu);
        (void)hipGetLastError();
        grid = cus;
    }
    if (grid < 0) return;
    if (hipMemsetAsync((char*)d_ws + WS_CTL, 0, CTL_ZERO_BYTES, stream) != hipSuccess) return;
    Args a{};
    for (int i = 0; i < 27; ++i) a.in[i] = (const float*)d_in[i];
    a.out = (float*)d_out; a.ws = (unsigned char*)d_ws;
#if MK_ONE_LAUNCH
    a.ph_lo = 0; a.ph_hi = N_PHASES;
    hipLaunchKernelGGL(fwd, dim3(grid), dim3(NWAVES * 64), LDS_BYTES, stream, a);
#else
    unsigned char* ws = (unsigned char*)d_ws;
    for (int p = 0; p < N_PHASES; ++p) {
        const int l = (p - PH_L0) / PH_PER_LAYER, q = (p - PH_L0) % PH_PER_LAYER;
        if (p >= PH_L0 && q == 1) {
#if NAIVE_MIX
            const float* const* in = (const float* const*)d_in;
            hipLaunchKernelGGL(nv_mix_pre, dim3(NTOK / 4), dim3(256), 0, stream, (const bf16*)(ws + WS_P), in[10] + l * 256, in[11] + l * 256, (float*)(ws + WS_NV_VN), (float*)(ws + WS_NV_DP));
            hipLaunchKernelGGL(nv_mix_main, dim3(NTOK * 4), dim3(256), 0, stream, (const bf16*)(ws + WS_P), (const float*)(ws + WS_NV_VN), (const float*)(ws + WS_NV_DP),
                               (const bf16*)(ws + WS_KB) + (size_t)l * 4096 * 256, (const bf16*)(ws + WS_VT) + (size_t)l * 256 * 4096, in[7] + l * 768, in[8] + l * 4 * 64 * 64, in[9] + l * 256,
                               in[12] + l * 4 * 128 * 128, in[13] + l * 4 * 128, (float*)(ws + WS_NV_Y));
            hipLaunchKernelGGL(nv_mix_norm, dim3(NTOK), dim3(256), 0, stream, (const float*)(ws + WS_NV_Y), in[15] + l * 1024, (bf16*)(ws + (size_t)T_G * TILE));
            continue;
#endif
        }
        a.ph_lo = p; a.ph_hi = p + 1;
        hipLaunchKernelGGL(fwd, dim3(grid), dim3(NWAVES * 64), LDS_BYTES, stream, a);
    }
#endif
}
```

```cpp
#include <hip/hip_runtime.h>
#include <cstdio>
#include <cstdint>

#ifndef MK_ONE_LAUNCH
#define MK_ONE_LAUNCH 1
#endif
#ifndef PHMASK
#define PHMASK 0xffff
#endif
#ifndef MXMASK
#define MXMASK 15
#endif
#ifndef DUP_PHASE
#define DUP_PHASE -1
#endif
#ifndef NAIVE_MIX
#define NAIVE_MIX 0
#endif

namespace pg8 {
#define PG8_LAS __attribute__((address_space(3)))
typedef unsigned short bf16_t;
typedef short bf16x8 __attribute__((ext_vector_type(8)));
typedef float f32x4 __attribute__((ext_vector_type(4)));
typedef float f32x2 __attribute__((ext_vector_type(2)));
typedef unsigned u32x4 __attribute__((ext_vector_type(4)));
typedef unsigned u32x2 __attribute__((ext_vector_type(2)));
constexpr int BM = 256, BK = 64, HALF = 128, HTB = HALF * BK * 2  , STAGE_BYTES = 8 * HTB, NXCD = 8, WGM = 8;

__host__ __device__ __forceinline__ int lds_byte(int r, int c) { const int st = (r >> 4) * 2 + (c >> 5), rr = r & 15, cc = c & 31, ob = rr * 64 + cc * 2; return st * 1024 + (ob ^ (((ob >> 9) & 1) << 5)); }
__host__ __device__ __forceinline__ void stage_rc(int b, int& R, int& C) { const int st = b / 1024, sb = b % 1024, swz = sb ^ (((sb >> 9) & 1) << 5); R = (st >> 1) * 16 + swz / 64; C = (st & 1) * 32 + (swz % 64) / 2; }
__host__ __device__ __forceinline__ int perm32(int rho) { const int n = rho >> 4, i = rho & 15; return 8 * (i >> 2) + 4 * n + (i & 3); }

struct Unit { int pm, pn, lm, ln, a0; };
struct Gemm { const bf16_t* A; const bf16_t* Bt; int K; };

__device__ __forceinline__ void tile_of(int L, int nM, int nN, int& tm, int& tn) {
    const int nwg = nM * nN; int wgid = L; { const int q = nwg / NXCD, r = nwg % NXCD, xcd = wgid % NXCD, off = wgid / NXCD; wgid = (xcd < r ? xcd * (q + 1) : r * (q + 1) + (xcd - r) * q) + off; }
    const int nig = WGM * nN, gid = wgid / nig, fm = gid * WGM, gsz = (nM - fm) < WGM ? (nM - fm) : WGM;
    tm = fm + ((wgid % nig) % gsz); tn = (wgid % nig) / gsz;
}

typedef int v8i __attribute__((ext_vector_type(8)));
__device__ __forceinline__ v8i cat8(bf16x8 a, bf16x8 b) { typedef short s16x16 __attribute__((ext_vector_type(16))); return __builtin_bit_cast(v8i, __builtin_shufflevector(a, b, 0, 1, 2, 3, 4, 5, 6, 7, 8, 9, 10, 11, 12, 13, 14, 15)); }
__device__ __forceinline__ bf16x8 half8(v8i x, int k) { typedef int v4i __attribute__((ext_vector_type(4))); return __builtin_bit_cast(bf16x8, k ? __builtin_shufflevector(x, x, 4, 5, 6, 7) : __builtin_shufflevector(x, x, 0, 1, 2, 3)); }
__device__ __forceinline__ void mfma_fp8_acc(f32x4& acc, const v8i& a, const v8i& b) { asm volatile("v_mfma_f32_16x16x128_f8f6f4 %0, %1, %2, %0" : "+v"(acc) : "v"(a), "v"(b)); }
__device__ __forceinline__ unsigned cvt4_fp8(float a, float b, float c, float d) {
    a = __builtin_amdgcn_fmed3f(a, -448.f, 448.f); b = __builtin_amdgcn_fmed3f(b, -448.f, 448.f); c = __builtin_amdgcn_fmed3f(c, -448.f, 448.f); d = __builtin_amdgcn_fmed3f(d, -448.f, 448.f);
    int r = __builtin_amdgcn_cvt_pk_fp8_f32(a, b, 0, false); r = __builtin_amdgcn_cvt_pk_fp8_f32(c, d, r, true); return (unsigned)r; }
__device__ __forceinline__ unsigned cvt_pk_bf16(float lo, float hi) { unsigned r; asm volatile("v_cvt_pk_bf16_f32 %0, %1, %2" : "=v"(r) : "v"(lo), "v"(hi)); return r; }


struct EpiBf16Sel {
    static constexpr bool PERM = true, AFTER_DRAIN = false;
    bf16_t* o0; bf16_t* o1; int ld0, ld1;
    __device__ __forceinline__ void operator()(const f32x4 (&acc)[2][2][4][2], const Unit& u, int wr, int wc, int fr, int fq) const {
        bf16_t* base = u.a0 == 0 ? o0 : o1; const int ldc = u.a0 == 0 ? ld0 : ld1;
        const int row0 = u.lm * BM + wr * 64 + fr, col0 = u.ln * BM + wc * 32 + 8 * fq;
#pragma unroll
        for (int ai = 0; ai < 2; ++ai)
#pragma unroll
            for (int m = 0; m < 4; ++m) { bf16_t* rowp = base + (size_t)(row0 + ai * HALF + m * 16) * ldc + col0;
#pragma unroll
                for (int bj = 0; bj < 2; ++bj) { const f32x4 v0 = acc[ai][bj][m][0], v1 = acc[ai][bj][m][1];
                    u32x4 w; w.x = cvt_pk_bf16(v0[0], v0[1]); w.y = cvt_pk_bf16(v0[2], v0[3]); w.z = cvt_pk_bf16(v1[0], v1[1]); w.w = cvt_pk_bf16(v1[2], v1[3]);
                    *(u32x4*)(rowp + bj * HALF) = w; } }
    }
};
struct EpiResBf16 {
    static constexpr bool PERM = true, AFTER_DRAIN = false;
    const bf16_t* h; bf16_t* pre; float alpha;
    __device__ __forceinline__ void operator()(const f32x4 (&acc)[2][2][4][2], const Unit& u, int wr, int wc, int fr, int fq) const {
        const int row0 = u.lm * BM + wr * 64 + fr, col0 = u.ln * BM + wc * 32 + 8 * fq;
#pragma unroll
        for (int ai = 0; ai < 2; ++ai)
#pragma unroll
            for (int m = 0; m < 4; ++m) { const size_t off = (size_t)(row0 + ai * HALF + m * 16) * 1024 + col0;
#pragma unroll
                for (int bj = 0; bj < 2; ++bj) { const u32x4 hv = *(const u32x4*)(h + off + bj * HALF); const f32x4 a0 = acc[ai][bj][m][0], a1 = acc[ai][bj][m][1];
                    u32x4 w;
                    w.x = cvt_pk_bf16(__builtin_bit_cast(float, hv.x << 16) * alpha + a0[0], __builtin_bit_cast(float, hv.x & 0xffff0000u) * alpha + a0[1]);
                    w.y = cvt_pk_bf16(__builtin_bit_cast(float, hv.y << 16) * alpha + a0[2], __builtin_bit_cast(float, hv.y & 0xffff0000u) * alpha + a0[3]);
                    w.z = cvt_pk_bf16(__builtin_bit_cast(float, hv.z << 16) * alpha + a1[0], __builtin_bit_cast(float, hv.z & 0xffff0000u) * alpha + a1[1]);
                    w.w = cvt_pk_bf16(__builtin_bit_cast(float, hv.w << 16) * alpha + a1[2], __builtin_bit_cast(float, hv.w & 0xffff0000u) * alpha + a1[3]);
                    *(u32x4*)(pre + off + bj * HALF) = w; }
                asm volatile("" ::: "memory"); }
    }
};
struct EpiSwiglu {
    static constexpr bool PERM = true, AFTER_DRAIN = false;
    unsigned char* act; const float* b1;
    __device__ __forceinline__ void operator()(const f32x4 (&acc)[2][2][4][2], const Unit& u, int wr, int wc, int fr, int fq) const {
        const int row0 = u.lm * BM + wr * 64 + fr, lc0 = u.ln * HALF + wc * 32 + 8 * fq;
        const float* bb = b1 + (size_t)u.a0 * 2048 + lc0;
        const f32x4 bg0 = *(const f32x4*)(bb), bg1 = *(const f32x4*)(bb + 4), bl0 = *(const f32x4*)(bb + 1024), bl1 = *(const f32x4*)(bb + 1028);
        constexpr float DS = 1.0f / 512.0f;
#pragma unroll
        for (int ai = 0; ai < 2; ++ai)
#pragma unroll
            for (int m = 0; m < 4; ++m) {
                u32x2 w; unsigned* wp = (unsigned*)&w;
#pragma unroll
                for (int n = 0; n < 2; ++n) { const f32x4 g4 = acc[ai][0][m][n] * DS + (n ? bg1 : bg0), l4 = acc[ai][1][m][n] * DS + (n ? bl1 : bl0); float r4[4];
#pragma unroll
                    for (int j = 0; j < 4; ++j) { const float g = fminf(g4[j], 7.0f), li = fminf(fmaxf(l4[j], -7.0f), 7.0f);
                        const float sg = __builtin_amdgcn_rcpf(1.0f + __builtin_amdgcn_exp2f(g * (-1.702f * 1.4426950408889634f))); r4[j] = g * sg * (li + 1.0f) * 4.0f; }
                    wp[n] = cvt4_fp8(r4[0], r4[1], r4[2], r4[3]); }
                *(u32x2*)(act + (size_t)(row0 + ai * HALF + m * 16) * 1024 + lc0) = w; }
    }
};
struct EpiDown {
    static constexpr bool PERM = true, AFTER_DRAIN = false;
    bf16_t* ys; const float* b2;
    __device__ __forceinline__ void operator()(const f32x4 (&acc)[2][2][4][2], const Unit& u, int wr, int wc, int fr, int fq) const {
        const int row0 = u.lm * BM + wr * 64 + fr, col0 = u.ln * BM + wc * 32 + 8 * fq;
        f32x4 bv[2][2];
#pragma unroll
        for (int bj = 0; bj < 2; ++bj)
#pragma unroll
            for (int n = 0; n < 2; ++n) bv[bj][n] = *(const f32x4*)(b2 + (size_t)u.a0 * 1024 + col0 + bj * HALF + 4 * n);
#pragma unroll
        for (int ai = 0; ai < 2; ++ai)
#pragma unroll
            for (int m = 0; m < 4; ++m) { bf16_t* rowp = ys + (size_t)(row0 + ai * HALF + m * 16) * 1024 + col0;
#pragma unroll
                for (int bj = 0; bj < 2; ++bj) { const f32x4 v0 = acc[ai][bj][m][0] * (1.0f / 256.0f) + bv[bj][0], v1 = acc[ai][bj][m][1] * (1.0f / 256.0f) + bv[bj][1];
                    u32x4 w; w.x = cvt_pk_bf16(v0[0], v0[1]); w.y = cvt_pk_bf16(v0[2], v0[3]); w.z = cvt_pk_bf16(v1[0], v1[1]); w.w = cvt_pk_bf16(v1[2], v1[3]);
                    *(u32x4*)(rowp + bj * HALF) = w; } }
    }
};

template <class Epi, class Sched, bool ALIGN_EPI = false, bool SP2 = false, bool FP8 = false>
__device__ __forceinline__ void gemm_phase(PG8_LAS unsigned char* lds, const Gemm g, const Sched& S, const Epi& E) {
    int tid_l = threadIdx.x; asm volatile("" : "+v"(tid_l));
    const int tid = tid_l, wid = __builtin_amdgcn_readfirstlane(tid >> 6), lane = tid & 63, wr = wid >> 2, wc = wid & 3, fr = lane & 15, fq = lane >> 4;
    const int RB = g.K * (FP8 ? 1 : 2), nt = RB / 128;
    unsigned voffA[2], voffB[2];
#pragma unroll
    for (int i = 0; i < 2; ++i) { int R, C; stage_rc(tid * 16 + i * 8192, R, C); const int Rb = Epi::PERM ? ((R & ~31) + perm32(R & 31)) : R;
        voffA[i] = (unsigned)(R * RB + C * 2); voffB[i] = (unsigned)(Rb * RB + C * 2); }
    const size_t kstep = (size_t)(BK * 2);
    const size_t hstep = (size_t)HALF * RB;
    const size_t tstep = 2 * hstep;
    const unsigned ldsw = (unsigned)wid * 1024u;
    const int aoff = lds_byte(wr * 64 + fr, fq * 8), boff = lds_byte(wc * 32 + fr, fq * 8);
#define PG8_SA(b, h) (((b) * 2 + (h)) * HTB)
#define PG8_SB(b, h) ((4 + (b) * 2 + (h)) * HTB)
#define PG8_STAGE(bufoff, gbase, voff) do { _Pragma("unroll") for (int _i = 0; _i < 2; ++_i) \
        __builtin_amdgcn_global_load_lds((const unsigned*)((const char*)(gbase) + (voff)[_i]), (PG8_LAS unsigned*)(lds + (bufoff) + ldsw + _i * 8192), 16, 0, 0); } while (0)
#define PG8_LDA(dst, b, h) do { _Pragma("unroll") for (int m = 0; m < 4; ++m) dst[m] = cat8(*(const PG8_LAS bf16x8*)(lds + PG8_SA(b, h) + aoff + m * 2048), *(const PG8_LAS bf16x8*)(lds + PG8_SA(b, h) + aoff + m * 2048 + 1024)); } while (0)
#define PG8_LDB(dst, b, h) do { _Pragma("unroll") for (int n = 0; n < 2; ++n) dst[n] = cat8(*(const PG8_LAS bf16x8*)(lds + PG8_SB(b, h) + boff + n * 2048), *(const PG8_LAS bf16x8*)(lds + PG8_SB(b, h) + boff + n * 2048 + 1024)); } while (0)
#define PG8_MMA(ai, bj, At, Bt) do { __builtin_amdgcn_s_setprio(1); _Pragma("unroll") for (int m = 0; m < 4; ++m) _Pragma("unroll") for (int n = 0; n < 2; ++n) { \
        if constexpr (FP8) mfma_fp8_acc(acc[ai][bj][m][n], Bt[n], At[m]); \
        else { _Pragma("unroll") for (int k = 0; k < 2; ++k) acc[ai][bj][m][n] = __builtin_amdgcn_mfma_f32_16x16x32_bf16(half8(Bt[n], k), half8(At[m], k), acc[ai][bj][m][n], 0, 0, 0); } } \
        __builtin_amdgcn_s_setprio(0); } while (0)
#define PG8_WAIT_V(n) asm volatile("s_waitcnt vmcnt(" #n ")" ::: "memory")
#define PG8_WAIT_L(n) asm volatile("s_waitcnt lgkmcnt(" #n ")" ::: "memory")
#define PG8_BAR __builtin_amdgcn_s_barrier()
#define PG8_SCHED __builtin_amdgcn_sched_barrier(0)
    Unit cur, nxt; int ui = 0;
    if (!S.next(0, cur)) return;
    f32x4 acc[2][2][4][2];
#pragma unroll
    for (int a = 0; a < 2; ++a)
#pragma unroll
        for (int b = 0; b < 2; ++b)
#pragma unroll
            for (int m = 0; m < 4; ++m)
#pragma unroll
                for (int n = 0; n < 2; ++n) acc[a][b][m][n] = (f32x4){0.f, 0.f, 0.f, 0.f};
    v8i At[4], B0[2], B1[2];
    const char* cA = (const char*)g.A + (size_t)cur.pm * tstep; const char* cB = (const char*)g.Bt + (size_t)cur.pn * tstep;
    S.a_ready(cur);
    if constexpr (SP2) {
        PG8_STAGE(PG8_SB(0, 0), cB, voffB); PG8_STAGE(PG8_SB(0, 1), cB + hstep, voffB); PG8_STAGE(PG8_SA(0, 0), cA, voffA); PG8_STAGE(PG8_SA(0, 1), cA + hstep, voffA);
        if (wr == 1) PG8_BAR;
        PG8_WAIT_V(2); PG8_BAR;
        PG8_STAGE(PG8_SB(1, 0), cB + kstep, voffB); PG8_STAGE(PG8_SA(1, 0), cA + kstep, voffA); PG8_STAGE(PG8_SB(1, 1), cB + hstep + kstep, voffB);
        PG8_WAIT_V(6); PG8_BAR;
    } else {
        PG8_STAGE(PG8_SB(0, 0), cB, voffB); PG8_STAGE(PG8_SA(0, 0), cA, voffA); PG8_STAGE(PG8_SB(0, 1), cB + hstep, voffB); PG8_STAGE(PG8_SA(0, 1), cA + hstep, voffA);
        if (wr == 1) PG8_BAR;
        PG8_WAIT_V(4); PG8_BAR;
        PG8_STAGE(PG8_SB(1, 0), cB + kstep, voffB); PG8_STAGE(PG8_SA(1, 0), cA + kstep, voffA); PG8_STAGE(PG8_SB(1, 1), cB + hstep + kstep, voffB);
        PG8_WAIT_V(6); PG8_BAR;
    }
    for (;;) {
        const bool has_next = S.next(ui + 1, nxt);
        const char* nA = has_next ? (const char*)g.A + (size_t)nxt.pm * tstep : cA; const char* nB = has_next ? (const char*)g.Bt + (size_t)nxt.pn * tstep : cB;
#pragma nounroll
        for (int t = 0; t < nt; t += 2) {
            const bool last = (t == nt - 2);
            const char* a1 = cA + (size_t)(t + 1) * kstep;
            const char* a2 = last ? nA : cA + (size_t)(t + 2) * kstep; const char* b2 = last ? nB : cB + (size_t)(t + 2) * kstep;
            const char* a3 = a2 + kstep; const char* b3 = b2 + kstep;
            if (last && has_next) S.a_ready(nxt);
            if constexpr (SP2) {
            PG8_LDB(B0, 0, 0); PG8_LDB(B1, 0, 1); PG8_SCHED; PG8_LDA(At, 0, 0); PG8_STAGE(PG8_SA(1, 1), a1 + hstep, voffA);
            PG8_WAIT_V(8); PG8_WAIT_L(0); PG8_BAR; PG8_MMA(0, 0, At, B0); PG8_MMA(0, 1, At, B1); PG8_BAR; PG8_SCHED;
            PG8_LDA(At, 0, 1); PG8_STAGE(PG8_SB(0, 0), b2, voffB); PG8_STAGE(PG8_SB(0, 1), b2 + hstep, voffB); PG8_STAGE(PG8_SA(0, 0), a2, voffA);
            PG8_WAIT_V(8); PG8_WAIT_L(0); PG8_BAR; PG8_MMA(1, 0, At, B0); PG8_MMA(1, 1, At, B1); PG8_BAR; PG8_SCHED;
            PG8_LDB(B0, 1, 0); PG8_LDB(B1, 1, 1); PG8_SCHED; PG8_LDA(At, 1, 0); PG8_STAGE(PG8_SA(0, 1), a2 + hstep, voffA);
            PG8_WAIT_V(8); PG8_WAIT_L(0); PG8_BAR; PG8_MMA(0, 0, At, B0); PG8_MMA(0, 1, At, B1); PG8_BAR; PG8_SCHED;
            PG8_LDA(At, 1, 1); PG8_STAGE(PG8_SB(1, 0), b3, voffB); PG8_STAGE(PG8_SB(1, 1), b3 + hstep, voffB); PG8_STAGE(PG8_SA(1, 0), a3, voffA);
            PG8_WAIT_V(8); PG8_WAIT_L(0); PG8_BAR; PG8_MMA(1, 0, At, B0); PG8_MMA(1, 1, At, B1); PG8_BAR; PG8_SCHED;
            } else {
            PG8_LDB(B0, 0, 0); PG8_SCHED; PG8_LDA(At, 0, 0); PG8_STAGE(PG8_SA(1, 1), a1 + hstep, voffA);
            PG8_WAIT_L(8); PG8_BAR; PG8_WAIT_L(0); PG8_MMA(0, 0, At, B0); PG8_BAR; PG8_SCHED;
            PG8_LDB(B1, 0, 1); PG8_STAGE(PG8_SB(0, 0), b2, voffB);
            PG8_BAR; PG8_WAIT_L(0); PG8_MMA(0, 1, At, B1); PG8_BAR;
            PG8_LDA(At, 0, 1); PG8_STAGE(PG8_SA(0, 0), a2, voffA);
            PG8_BAR; PG8_WAIT_L(0); PG8_MMA(1, 0, At, B0); PG8_BAR; PG8_SCHED;
            PG8_STAGE(PG8_SB(0, 1), b2 + hstep, voffB);
            PG8_WAIT_V(6); PG8_BAR; PG8_MMA(1, 1, At, B1); PG8_BAR;
            PG8_LDB(B0, 1, 0); PG8_SCHED; PG8_LDA(At, 1, 0); PG8_STAGE(PG8_SA(0, 1), a2 + hstep, voffA);
            PG8_WAIT_L(8); PG8_BAR; PG8_WAIT_L(0); PG8_MMA(0, 0, At, B0); PG8_BAR; PG8_SCHED;
            PG8_LDB(B1, 1, 1); PG8_STAGE(PG8_SB(1, 0), b3, voffB);
            PG8_BAR; PG8_WAIT_L(0); PG8_MMA(0, 1, At, B1); PG8_BAR;
            PG8_LDA(At, 1, 1); PG8_STAGE(PG8_SA(1, 0), a3, voffA);
            PG8_BAR; PG8_WAIT_L(0); PG8_MMA(1, 0, At, B0); PG8_BAR; PG8_SCHED;
            PG8_STAGE(PG8_SB(1, 1), b3 + hstep, voffB);
            PG8_WAIT_V(6); PG8_BAR; PG8_MMA(1, 1, At, B1); PG8_BAR;
            }
        }
        if constexpr (ALIGN_EPI) { if (wr == 0) PG8_BAR; }
        if constexpr (FP8) asm volatile("s_nop 15\n\ts_nop 15" ::: "memory");
        if constexpr (!Epi::AFTER_DRAIN) { E(acc, cur, wr, wc, fr, fq); S.done(cur); }
        if (!has_next) break;
#pragma unroll
        for (int a = 0; a < 2; ++a)
#pragma unroll
            for (int b = 0; b < 2; ++b)
#pragma unroll
                for (int m = 0; m < 4; ++m)
#pragma unroll
                    for (int n = 0; n < 2; ++n) acc[a][b][m][n] = (f32x4){0.f, 0.f, 0.f, 0.f};
        cur = nxt; cA = nA; cB = nB; ++ui;
        if constexpr (ALIGN_EPI) { if (wr == 1) PG8_BAR; }
    }
    PG8_WAIT_V(0);
    if constexpr (!ALIGN_EPI) { if (wr == 0) PG8_BAR; }
    PG8_BAR;
    if constexpr (Epi::AFTER_DRAIN) { E.fused(acc, cur, wr, wc, fr, fq, lds, wid, lane); S.done(cur); }
#undef PG8_SA
#undef PG8_SB
#undef PG8_STAGE
#undef PG8_LDA
#undef PG8_LDB
#undef PG8_MMA
#undef PG8_WAIT_V
#undef PG8_WAIT_L
#undef PG8_BAR
#undef PG8_SCHED
}
}

#define GAS __attribute__((address_space(1)))
#define LAS __attribute__((address_space(3)))
typedef unsigned short bf16;
typedef unsigned v4u __attribute__((ext_vector_type(4)));
typedef unsigned v2u __attribute__((ext_vector_type(2)));
typedef float f32x4 __attribute__((ext_vector_type(4)));
typedef short bf16x8 __attribute__((ext_vector_type(8)));
typedef GAS unsigned gu32;
typedef GAS unsigned long long gu64;
#define RLX_AGENT __ATOMIC_RELAXED, __HIP_MEMORY_SCOPE_AGENT
#define LDS_WAIT() asm volatile("s_waitcnt lgkmcnt(0)" ::: "memory")
#define VM_WAIT() asm volatile("s_waitcnt vmcnt(0)" ::: "memory")
__device__ __forceinline__ unsigned long long rt() { return __builtin_amdgcn_s_memrealtime(); }
__device__ __forceinline__ unsigned f2bf(float f) { unsigned u = __builtin_bit_cast(unsigned, f); return (u + 0x7fffu + ((u >> 16) & 1u)) >> 16; }
__device__ __forceinline__ unsigned pk2(float lo, float hi) { return f2bf(lo) | (f2bf(hi) << 16); }

#define XB_TMO      128
#define XB_XCNT(j)  (256  + 64 * (j))
#define XB_XSUB(j)  (1280 + 64 * (j))
#define XB_XGEN(j)  (2304 + 64 * (j))
#define XB_TOP      3328
#define XB_TOPGEN   3392
#define XCD_BAR_WORDS 3456
#define XB_SPIN_CAP (1u << 18)

__device__ __forceinline__ unsigned xb_ld(unsigned* p)              { return __hip_atomic_load(p, __ATOMIC_RELAXED, __HIP_MEMORY_SCOPE_AGENT); }
__device__ __forceinline__ unsigned xb_add(unsigned* p, unsigned v) { return __hip_atomic_fetch_add(p, v, __ATOMIC_RELAXED, __HIP_MEMORY_SCOPE_AGENT); }
__device__ __forceinline__ unsigned xb_xcc_id() { return (unsigned)__builtin_amdgcn_s_getreg((3 << 11) | 20) & 0xFu; }
#define XB_SPIN(cond, bar) do { unsigned _sp = 0; while (cond) { __builtin_amdgcn_s_sleep(1); \
    if ((++_sp & 255u) == 0u) { if (xb_ld(&(bar)[XB_TMO])) break; if (_sp > XB_SPIN_CAP) { atomicAdd(&(bar)[XB_TMO], 1u); break; } } } } while (0)

struct XcdBarrier {
    unsigned* bar; unsigned x;
    volatile LAS unsigned* st;
};

__device__ __forceinline__ XcdBarrier xcd_barrier_post(unsigned* bar, volatile LAS unsigned* st) {
    XcdBarrier b; b.bar = bar; b.x = xb_xcc_id(); b.st = st;
    if (threadIdx.x == 0) (void)xb_add(&bar[XB_XCNT(b.x)], 1u);
    return b;
}
__device__ __forceinline__ void xcd_barrier_complete(unsigned* bar, unsigned x, unsigned& nloc, unsigned& nx) {
    const unsigned G = gridDim.x * gridDim.y * gridDim.z;
    unsigned sum, cnt, mine, sp = 0u;
    for (;;) {
        sum = 0u; cnt = 0u; mine = 0u;
#pragma unroll
        for (unsigned j = 0; j < 16; ++j) { const unsigned c = xb_ld(&bar[XB_XCNT(j)]); sum += c; cnt += (c > 0u) ? 1u : 0u; mine = (j == x) ? c : mine; }
        if (sum == G) break;
        __builtin_amdgcn_s_sleep(1);
        if ((++sp & 255u) == 0u) { if (xb_ld(&bar[XB_TMO])) break; if (sp > XB_SPIN_CAP) { atomicAdd(&bar[XB_TMO], 1u); break; } }
    }
    nloc = mine > 0u ? mine : 1u; nx = cnt > 0u ? cnt : 1u;
}

__device__ __forceinline__ void xcd_barrier(const XcdBarrier& b) {
    asm volatile("s_waitcnt vmcnt(0)" ::: "memory");
    __syncthreads();
    if (threadIdx.x == 0) {
        unsigned* bar = b.bar;
        __builtin_amdgcn_s_waitcnt(0);
        unsigned nloc = b.st[0], nx = b.st[1];
        if (nloc == 0u) { xcd_barrier_complete(bar, b.x, nloc, nx); b.st[0] = nloc; b.st[1] = nx; }
        const unsigned old = xb_add(&bar[XB_XSUB(b.x)], 1u);
        const unsigned gen = old / nloc;
        if (old + 1u == (gen + 1u) * nloc) {
            __builtin_amdgcn_fence(__ATOMIC_RELEASE, "agent");
            asm volatile("s_waitcnt vmcnt(0)" ::: "memory");
            const unsigned og = xb_add(&bar[XB_TOP], 1u);
            const unsigned tg = og / nx;
            if (og + 1u == (tg + 1u) * nx) xb_add(&bar[XB_TOPGEN], 1u);
            else XB_SPIN(xb_ld(&bar[XB_TOPGEN]) == tg, bar);
            __builtin_amdgcn_fence(__ATOMIC_ACQUIRE, "agent");
            xb_add(&bar[XB_XGEN(b.x)], 1u);
            asm volatile("s_waitcnt vmcnt(0)" ::: "memory");
        } else {
            XB_SPIN(xb_ld(&bar[XB_XGEN(b.x)]) == gen, bar);
            __builtin_amdgcn_fence(__ATOMIC_ACQUIRE, "agent");
            asm volatile("s_waitcnt vmcnt(0)" ::: "memory");
        }
    }
    __syncthreads();
}


constexpr int NWAVES = 8;
constexpr int NTOK = 32768, D = 1024, NPROJ = 1792, NLAYER = 4, NEXP = 32, SEQ = 2048, NBATCH = 16, NMEM = 256;
constexpr float LN_EPS = 1e-5f, RMS_EPS = 1e-6f;
constexpr float DN_ALPHA = 1.6817928305074292f;
constexpr int XP_TILES = NTOK * 4 / 256 + NEXP;

constexpr size_t MiB = 1u << 20, TILE = 512 * 1024;
constexpr size_t WS_CTL = 0, CTL_ZERO_BYTES = 1 * MiB;
constexpr size_t WS_WMB = 1 * MiB;
constexpr size_t WS_POOLT = WS_WMB + 512 * 1024;
constexpr size_t WS_WRT = WS_POOLT + 128 * 1024;
constexpr int T_WIN = 4, T_WOUT = T_WIN + 28, T_WKV = T_WOUT + 16, T_MEMN = T_WKV + 8, T_HB = T_MEMN + 16, T_G = T_HB + 128, T_END = T_G + 128;
constexpr size_t QT = 256 * 1024;
constexpr size_t WS_W18 = (size_t)T_END * TILE;
constexpr size_t WS_W28 = WS_W18 + 256 * MiB;
constexpr size_t WS_H8 = WS_W28 + 128 * MiB;
constexpr size_t WS_XP8 = WS_H8 + 32 * MiB;
constexpr size_t WS_ACT8 = WS_XP8 + (size_t)XP_TILES * QT;
constexpr size_t WS_YS = WS_ACT8 + (size_t)XP_TILES * QT;
constexpr size_t WS_P = WS_YS + (size_t)XP_TILES * TILE;
#define Q8(off) ((int)((off) / QT))
constexpr size_t WS_PRE = WS_P + 112 * MiB;
constexpr size_t WS_KB = WS_PRE + 64 * MiB;
constexpr size_t WS_VT = WS_KB + 8 * MiB;
constexpr size_t WS_TOKES = WS_VT + 8 * MiB;
constexpr size_t WS_TOKG = WS_TOKES + 512 * 1024;
constexpr size_t WS_ROWIDX = WS_TOKG + 512 * 1024;
constexpr size_t WS_NV_VN = WS_ROWIDX + 512 * 1024;
constexpr size_t WS_NV_DP = WS_NV_VN + 32 * MiB;
constexpr size_t WS_NV_Y = WS_NV_DP + 32 * MiB;
constexpr size_t WS_END = WS_NV_Y + 128 * MiB;
constexpr int CW_TMO = 0, CW_CODE = 1;
constexpr int CW_BAR = 4096;
constexpr int CW_CNT = 16384;
static_assert((CW_CNT + NLAYER * NEXP * 16) * 4 <= (int)CTL_ZERO_BYTES, "CTL words inside the memset region");
constexpr int RING_OFF = 0, RING_BYTES = 131072;
constexpr int LDSCTL_OFF = 147456 - 1024, MISC_OFF = LDSCTL_OFF + 320, TOFF_OFF = MISC_OFF + 128;
constexpr int LDS_BYTES = 147456;
static_assert(TOFF_OFF + 160 <= LDS_BYTES, "LDS map");

__device__ __forceinline__ float bf2f(unsigned short b) { return __builtin_bit_cast(float, (unsigned)b << 16); }
__device__ __forceinline__ float wave_sum(float v) {
#pragma unroll
    for (int o = 1; o < 64; o <<= 1) v += __shfl_xor(v, o);
    return v;
}
__device__ __forceinline__ float gelu_tanh(float x) {
    const float u = 0.7978845608028654f * (x + 0.044715f * x * x * x);
    return x * __builtin_amdgcn_rcpf(1.0f + __builtin_amdgcn_exp2f(u * (-2.0f * 1.4426950408889634f)));
}

struct Frame {
    LAS unsigned char* lds;
    volatile LAS unsigned* MISC;
    gu32* ctl;
    unsigned char* ws;
    int tid, lane, wave, G;
    float* out;
};
struct Args { const float* in[27]; float* out; unsigned char* ws; int ph_lo, ph_hi; };
enum { I_X = 0, I_MEM, I_LN_IN_G, I_LN_IN_B, I_MEM_LN_G, I_MEM_LN_B, I_W_IN, I_CONV_W, I_POOL_W, I_POOL_SCALE, I_GMLP_LN_G, I_GMLP_LN_B, I_GMLP_W, I_GMLP_B, I_W_MEM_KV, I_GROUP_NORM_G, I_W_OUT,
       I_LN1_G, I_LN1_B, I_W_ROUTER, I_B_ROUTER, I_W1, I_B1, I_W2, I_B2, I_LN2_G, I_LN2_B };
#define RELANE(F) do { int t_ = threadIdx.x; asm volatile("" : "+v"(t_)); (F).tid = t_; (F).lane = t_ & 63; (F).wave = __builtin_amdgcn_readfirstlane(t_ >> 6); } while (0)
#define WSP(T, off) ((T*)(F.ws + (off)))
#define TILEP(t) ((bf16*)(F.ws + (size_t)(t) * TILE))

__device__ __forceinline__ void tr64(const float* W, int ldw, int k0, int n0, bf16* WT, int ldt, int drow0, LAS float* scr, int lane) {
    const int c4 = 4 * (lane & 15), kq = lane >> 4;
#pragma unroll
    for (int i = 0; i < 16; ++i) { const int kk = 4 * i + kq; const f32x4 v = *(const f32x4*)(W + (size_t)(k0 + kk) * ldw + n0 + c4);
        LAS float* s = scr + kk * 65 + c4; s[0] = v.x; s[1] = v.y; s[2] = v.z; s[3] = v.w; }
    LDS_WAIT(); asm volatile("" ::: "memory");
    const int ck = lane & 7;
#pragma unroll
    for (int j = 0; j < 8; ++j) { const int n = (lane >> 3) + 8 * j; const LAS float* s = scr + (8 * ck) * 65 + n;
        v4u o; o.x = pk2(s[0 * 65], s[1 * 65]); o.y = pk2(s[2 * 65], s[3 * 65]); o.z = pk2(s[4 * 65], s[5 * 65]); o.w = pk2(s[6 * 65], s[7 * 65]);
        *(v4u*)(WT + (size_t)(drow0 + n) * ldt + k0 + 8 * ck) = o; }
    LDS_WAIT(); asm volatile("" ::: "memory");
}
__device__ __forceinline__ void tr64_fp8(const float* W, int ldw, int k0, int n0, unsigned char* WT, int drow0, float scale, LAS float* scr, int lane) {
    const int c4 = 4 * (lane & 15), kq = lane >> 4;
#pragma unroll
    for (int i = 0; i < 16; ++i) { const int kk = 4 * i + kq; const f32x4 v = *(const f32x4*)(W + (size_t)(k0 + kk) * ldw + n0 + c4);
        LAS float* s = scr + kk * 65 + c4; s[0] = v.x; s[1] = v.y; s[2] = v.z; s[3] = v.w; }
    LDS_WAIT(); asm volatile("" ::: "memory");
    const int ck = lane & 7;
#pragma unroll
    for (int j = 0; j < 8; ++j) { const int n = (lane >> 3) + 8 * j; const LAS float* s = scr + (8 * ck) * 65 + n;
        v2u o; o.x = pg8::cvt4_fp8(s[0 * 65] * scale, s[1 * 65] * scale, s[2 * 65] * scale, s[3 * 65] * scale); o.y = pg8::cvt4_fp8(s[4 * 65] * scale, s[5 * 65] * scale, s[6 * 65] * scale, s[7 * 65] * scale);
        *(v2u*)(WT + (size_t)(drow0 + n) * 1024 + k0 + 8 * ck) = o; }
    LDS_WAIT(); asm volatile("" ::: "memory");
}
#define BAR_LDS() do { asm volatile("s_waitcnt lgkmcnt(0)" ::: "memory"); __builtin_amdgcn_s_barrier(); asm volatile("" ::: "memory"); } while (0)
__device__ __forceinline__ f32x4 bf2lo(const v4u r) { f32x4 o; o.x = __builtin_bit_cast(float, r.x << 16); o.y = __builtin_bit_cast(float, r.x & 0xffff0000u); o.z = __builtin_bit_cast(float, r.y << 16); o.w = __builtin_bit_cast(float, r.y & 0xffff0000u); return o; }
__device__ __forceinline__ f32x4 bf2hi(const v4u r) { f32x4 o; o.x = __builtin_bit_cast(float, r.z << 16); o.y = __builtin_bit_cast(float, r.z & 0xffff0000u); o.z = __builtin_bit_cast(float, r.w << 16); o.w = __builtin_bit_cast(float, r.w & 0xffff0000u); return o; }
__device__ __forceinline__ v4u pack8(const f32x4 a, const f32x4 b) { v4u o; o.x = pg8::cvt_pk_bf16(a.x, a.y); o.y = pg8::cvt_pk_bf16(a.z, a.w); o.z = pg8::cvt_pk_bf16(b.x, b.y); o.w = pg8::cvt_pk_bf16(b.z, b.w); return o; }
struct LnPar { f32x4 g[4], b[4]; };
__device__ __forceinline__ void ln_load(LnPar& p, const float* gam, const float* bet, int lane) {
#pragma unroll
    for (int j = 0; j < 4; ++j) { const int o = 8 * lane + 512 * (j >> 1) + 4 * (j & 1); p.g[j] = *(const f32x4*)(gam + o); p.b[j] = *(const f32x4*)(bet + o); }
}
__device__ __forceinline__ void ln_affine(f32x4 (&v)[4], const LnPar& p) {
    float s = 0.f;
#pragma unroll
    for (int j = 0; j < 4; ++j) s += (v[j].x + v[j].y) + (v[j].z + v[j].w);
    const float mean = wave_sum(s) * (1.f / 1024.f); float s2 = 0.f;
#pragma unroll
    for (int j = 0; j < 4; ++j) { v[j] = v[j] - mean; s2 += (v[j].x * v[j].x + v[j].y * v[j].y) + (v[j].z * v[j].z + v[j].w * v[j].w); }
    const float rstd = 1.f / sqrtf(wave_sum(s2) * (1.f / 1024.f) + LN_EPS);
#pragma unroll
    for (int j = 0; j < 4; ++j) v[j] = v[j] * rstd * p.g[j] + p.b[j];
}
__device__ __forceinline__ void p0_prologue(Frame& F, const Args& A) {
    RELANE(F);
    LAS float* scr = (LAS float*)(F.lds + RING_OFF + F.wave * 16640);
    const int gw = blockIdx.x * NWAVES + F.wave, NGW = F.G * NWAVES;
    constexpr int NI_W1 = NLAYER * NEXP * 16 * 32, NI_W2 = NLAYER * NEXP * 16 * 16, NI_WIN = NLAYER * 16 * 28, NI_WOUT = NLAYER * 16 * 16, NI_WKV = NLAYER * 16 * 8, NI_POOL = NLAYER * 4;
    constexpr int NITEMS = NI_W1 + NI_W2 + NI_WIN + NI_WOUT + NI_WKV + NI_POOL;
    for (int it = gw; it < NITEMS; it += NGW) {
        int r = it;
        if (r < NI_W1) { const int le = r >> 9, rr = r & 511, kb = rr >> 5, nb = rr & 31; const int n0 = 64 * nb, nn = n0 & 1023;
            const int drow = (nn >> 7) * 256 + (n0 >= 1024 ? 128 : 0) + (nn & 127);
            tr64_fp8(A.in[I_W1] + (size_t)le * 1024 * 2048, 2048, 64 * kb, n0, F.ws + WS_W18 + (size_t)le * 2048 * 1024, drow, 32.0f, scr, F.lane); continue; } r -= NI_W1;
        if (r < NI_W2) { const int le = r >> 8, rr = r & 255, kb = rr >> 4, nb = rr & 15;
            tr64_fp8(A.in[I_W2] + (size_t)le * 1024 * 1024, 1024, 64 * kb, 64 * nb, F.ws + WS_W28 + (size_t)le * 1024 * 1024, 64 * nb, 64.0f, scr, F.lane); continue; } r -= NI_W2;
        if (r < NI_WIN) { const int l = r / 448, rr = r % 448, kb = rr / 28, nb = rr % 28;
            tr64(A.in[I_W_IN] + (size_t)l * 1024 * NPROJ, NPROJ, 64 * kb, 64 * nb, TILEP(T_WIN) + (size_t)l * NPROJ * 1024, 1024, 64 * nb, scr, F.lane); continue; } r -= NI_WIN;
        if (r < NI_WOUT) { const int l = r >> 8, rr = r & 255, kb = rr >> 4, nb = rr & 15;
            tr64(A.in[I_W_OUT] + (size_t)l * 1024 * 1024, 1024, 64 * kb, 64 * nb, TILEP(T_WOUT) + (size_t)l * 1024 * 1024, 1024, 64 * nb, scr, F.lane); continue; } r -= NI_WOUT;
        if (r < NI_WKV) { const int l = r >> 7, rr = r & 127, kb = rr >> 3, nb = rr & 7;
            tr64(A.in[I_W_MEM_KV] + (size_t)l * 1024 * 512, 512, 64 * kb, 64 * nb, TILEP(T_WKV) + (size_t)l * 512 * 1024, 1024, 64 * nb, scr, F.lane); continue; } r -= NI_WKV;
        tr64(A.in[I_POOL_W] + (size_t)r * 64 * 64, 64, 0, 0, WSP(bf16, WS_POOLT) + (size_t)r * 64 * 64, 64, 0, scr, F.lane);
    }
    const int gt = blockIdx.x * (NWAVES * 64) + F.tid, NGT = F.G * NWAVES * 64;
    for (int i = gt; i < NLAYER * 4 * 128 * 128; i += NGT) { const int j = i & 127, ii = (i >> 7) & 127; WSP(bf16, WS_WMB)[i] = (bf16)(((j >> 6) <= (ii >> 6)) ? f2bf(A.in[I_GMLP_W][i]) : 0u); }
    for (int i = gt; i < NLAYER * 32 * 1024; i += NGT) { const int k = i & 1023, e = (i >> 10) & 31, l = i >> 15; WSP(bf16, WS_WRT)[i] = (bf16)f2bf(A.in[I_W_ROUTER][((size_t)l * 1024 + k) * 32 + e]); }
    LnPar px, pm; ln_load(px, A.in[I_LN_IN_G], A.in[I_LN_IN_B], F.lane); ln_load(pm, A.in[I_MEM_LN_G], A.in[I_MEM_LN_B], F.lane);
    for (int m = gw; m < NTOK + NBATCH * NMEM; m += NGW) {
        const bool ismem = m >= NTOK; const int row = ismem ? m - NTOK : m;
        const float* src = (ismem ? A.in[I_MEM] : A.in[I_X]) + (size_t)row * D + 8 * F.lane;
        f32x4 v[4]; v[0] = *(const f32x4*)(src); v[1] = *(const f32x4*)(src + 4); v[2] = *(const f32x4*)(src + 512); v[3] = *(const f32x4*)(src + 516);
        if (ismem) ln_affine(v, pm); else ln_affine(v, px);
        bf16* dst = (ismem ? TILEP(T_MEMN) : TILEP(T_HB)) + (size_t)row * D + 8 * F.lane;
        *(v4u*)dst = pack8(v[0], v[1]); *(v4u*)(dst + 512) = pack8(v[2], v[3]);
    }
}

struct DenseOrder {
    int nM, nN, G, c, a_t0, b_t0;
    __device__ __forceinline__ bool next(int i, pg8::Unit& u) const {
        const long L = (long)i * G + c; if (L >= (long)nM * nN) return false;
        int tm, tn; pg8::tile_of((int)L, nM, nN, tm, tn); u.pm = a_t0 + tm; u.pn = b_t0 + tn; u.lm = tm; u.ln = tn; u.a0 = 0; return true;
    }
    __device__ __forceinline__ void a_ready(const pg8::Unit&) const {}
    __device__ __forceinline__ void done(const pg8::Unit&) const {}
};
struct KvOrder {
    int G, c;
    __device__ __forceinline__ bool next(int i, pg8::Unit& u) const {
        const int L = i * G + c; if (L >= NLAYER * 32) return false;
        const int l = L >> 5, r = L & 31;
        if (r < 16) { u.pm = T_MEMN + r; u.pn = T_WKV + 2 * l; u.lm = l * 16 + r; u.ln = 0; u.a0 = 0; }
        else { u.pm = T_WKV + 2 * l + 1; u.pn = T_MEMN + (r - 16); u.lm = l; u.ln = r - 16; u.a0 = 1; }
        return true;
    }
    __device__ __forceinline__ void a_ready(const pg8::Unit&) const {}
    __device__ __forceinline__ void done(const pg8::Unit&) const {}
};
struct MoeOrder {
    int TM, NTN, G, c, a_t0, b_t0; const LAS int* toff;
    __device__ __forceinline__ bool next(int i, pg8::Unit& u) const {
        const long L = (long)i * G + c; if (L >= (long)TM * NTN) return false;
        int tm, tn; pg8::tile_of((int)L, TM, NTN, tm, tn);
        int e = 0;
#pragma unroll
        for (int j = 1; j < NEXP; ++j) e += (toff[j] <= tm) ? 1 : 0;
        e = __builtin_amdgcn_readfirstlane(e);
        u.pm = a_t0 + tm; u.pn = b_t0 + e * NTN + tn; u.lm = tm; u.ln = tn; u.a0 = e; return true;
    }
    __device__ __forceinline__ void a_ready(const pg8::Unit&) const {}
    __device__ __forceinline__ void done(const pg8::Unit&) const {}
};
__device__ __forceinline__ void compute_toff(Frame& F, int l) {
    RELANE(F);
    LAS int* toff = (LAS int*)(F.lds + TOFF_OFF);
    __syncthreads();
    if (F.wave == 0) {
        int t = 0;
        if (F.lane < NEXP) { const unsigned c = __hip_atomic_load(F.ctl + CW_CNT + (l * NEXP + F.lane) * 16, RLX_AGENT); t = (int)((c + 255u) >> 8); }
        int incl = t;
#pragma unroll
        for (int o = 1; o < 32; o <<= 1) { const int y = __shfl_up(incl, o); if ((F.lane & 31) >= o) incl += y; }
        if (F.lane < NEXP) toff[F.lane + 1] = incl;
        if (F.lane == 0) toff[0] = 0;
    }
    __syncthreads();
}

__device__ __forceinline__ void pd_phase(Frame& F, const Args& A, int l) {
    RELANE(F);
    LAS unsigned char* T = F.lds;
    LAS float* part = (LAS float*)(F.lds + 66048);
    LAS float* logit = (LAS float*)(F.lds + 82432);
    LAS int* cntl = (LAS int*)(F.lds + 86656);
    LAS int* basel = (LAS int*)(F.lds + 86784);
    LAS int* sel_e = (LAS int*)(F.lds + 86912);
    LAS int* sel_r = sel_e + 512; LAS float* sel_g = (LAS float*)(sel_r + 512);
    LnPar lp; ln_load(lp, A.in[I_LN1_G] + l * D, A.in[I_LN1_B] + l * D, F.lane);
    const bf16* wr = WSP(bf16, WS_WRT) + (size_t)l * NEXP * D; const float* br = A.in[I_B_ROUTER] + l * NEXP;
    const bf16* pre = WSP(bf16, WS_PRE); bf16* hb = TILEP(T_HB); unsigned char* h8 = F.ws + WS_H8;
    const int r16 = F.lane & 15, g4 = F.lane >> 4;
    for (int blk = blockIdx.x; blk < NTOK / 128; blk += F.G) {
        if (F.tid < NEXP) cntl[F.tid] = 0;
        v4u raw[4][2];
#pragma unroll
        for (int q = 0; q < 4; ++q) { const bf16* p = pre + (size_t)(blk * 128 + F.wave * 4 + q) * D + 8 * F.lane; raw[q][0] = *(const v4u*)p; raw[q][1] = *(const v4u*)(p + 512); }
        BAR_LDS();
#pragma nounroll
        for (int it = 0; it < 4; ++it) {
            const int r0 = blk * 128 + it * 32;
#pragma unroll
            for (int q = 0; q < 4; ++q) {
                const int lr = F.wave * 4 + q; const size_t row = (size_t)(r0 + lr);
                f32x4 v[4]; v[0] = bf2lo(raw[q][0]); v[1] = bf2hi(raw[q][0]); v[2] = bf2lo(raw[q][1]); v[3] = bf2hi(raw[q][1]);
                ln_affine(v, lp);
                const v4u o0 = pack8(v[0], v[1]), o1 = pack8(v[2], v[3]);
                *(v4u*)(hb + row * D + 8 * F.lane) = o0; *(v4u*)(hb + row * D + 512 + 8 * F.lane) = o1;
                *(LAS v4u*)(T + lr * 2064 + 16 * F.lane) = o0; *(LAS v4u*)(T + lr * 2064 + 1024 + 16 * F.lane) = o1;
                v2u q0, q1; q0.x = pg8::cvt4_fp8(v[0].x * 16.0f, v[0].y * 16.0f, v[0].z * 16.0f, v[0].w * 16.0f); q0.y = pg8::cvt4_fp8(v[1].x * 16.0f, v[1].y * 16.0f, v[1].z * 16.0f, v[1].w * 16.0f);
                q1.x = pg8::cvt4_fp8(v[2].x * 16.0f, v[2].y * 16.0f, v[2].z * 16.0f, v[2].w * 16.0f); q1.y = pg8::cvt4_fp8(v[3].x * 16.0f, v[3].y * 16.0f, v[3].z * 16.0f, v[3].w * 16.0f);
                *(v2u*)(h8 + row * D + 8 * F.lane) = q0; *(v2u*)(h8 + row * D + 512 + 8 * F.lane) = q1;
            }
            if (it < 3) {
#pragma unroll
                for (int q = 0; q < 4; ++q) { const bf16* p = pre + (size_t)(r0 + 32 + F.wave * 4 + q) * D + 8 * F.lane; raw[q][0] = *(const v4u*)p; raw[q][1] = *(const v4u*)(p + 512); }
            }
            BAR_LDS();
            {
                const int mt = F.wave & 1, kq = F.wave >> 1;
                f32x4 a0 = {0.f, 0.f, 0.f, 0.f}, a1 = {0.f, 0.f, 0.f, 0.f};
#pragma unroll
                for (int ks = 0; ks < 8; ++ks) { const int k0 = 256 * kq + 32 * ks + 8 * g4;
                    const bf16x8 a = *(const LAS bf16x8*)(T + (16 * mt + r16) * 2064 + k0 * 2);
                    const bf16x8 b0 = *(const bf16x8*)(wr + (size_t)r16 * D + k0), b1 = *(const bf16x8*)(wr + (size_t)(16 + r16) * D + k0);
                    a0 = __builtin_amdgcn_mfma_f32_16x16x32_bf16(a, b0, a0, 0, 0, 0); a1 = __builtin_amdgcn_mfma_f32_16x16x32_bf16(a, b1, a1, 0, 0, 0); }
#pragma unroll
                for (int i = 0; i < 4; ++i) { part[kq * 1024 + (16 * mt + 4 * g4 + i) * 32 + r16] = a0[i]; part[kq * 1024 + (16 * mt + 4 * g4 + i) * 32 + 16 + r16] = a1[i]; }
            }
            BAR_LDS();
            for (int idx = F.tid; idx < 1024; idx += NWAVES * 64) { const int rr = idx >> 5, e = idx & 31;
                logit[rr * 33 + e] = ((part[idx] + part[1024 + idx]) + (part[2048 + idx] + part[3072 + idx])) + br[e]; }
            BAR_LDS();
            if (F.tid < 32) {
                const LAS float* lg = logit + F.tid * 33; float tv[4]; int ti[4];
#pragma unroll
                for (int k = 0; k < 4; ++k) { float best = -3.0e38f; int bi = 0;
                    for (int e = 0; e < NEXP; ++e) { const float x = lg[e]; bool taken = false;
#pragma unroll
                        for (int kk = 0; kk < 4; ++kk) if (kk < k && ti[kk] == e) taken = true;
                        if (!taken && x > best) { best = x; bi = e; } }
                    tv[k] = best; ti[k] = bi; }
                float ex[4], sum = 0.f;
#pragma unroll
                for (int k = 0; k < 4; ++k) { ex[k] = __expf(tv[k] - tv[0]); sum += ex[k]; }
                const float inv = 1.0f / sum;
#pragma unroll
                for (int k = 0; k < 4; ++k) { const int p = (it * 32 + F.tid) * 4 + k; sel_e[p] = ti[k]; sel_r[p] = __hip_atomic_fetch_add(cntl + ti[k], 1, __ATOMIC_RELAXED, __HIP_MEMORY_SCOPE_WORKGROUP); sel_g[p] = ex[k] * inv; }
            }
        }
        BAR_LDS();
        if (F.tid < NEXP) basel[F.tid] = (int)__hip_atomic_fetch_add(F.ctl + CW_CNT + (l * NEXP + F.tid) * 16, (unsigned)cntl[F.tid], RLX_AGENT);
        BAR_LDS();
        { const int p = F.tid, e = sel_e[p], slot = basel[e] + sel_r[p];
          WSP(int, WS_TOKES)[(size_t)blk * 512 + p] = (e << 16) | slot; WSP(float, WS_TOKG)[(size_t)blk * 512 + p] = sel_g[p]; }
        BAR_LDS();
    }
}
__device__ __forceinline__ void pe_phase(Frame& F, int l) {
    RELANE(F);
    compute_toff(F, l);
    const LAS int* toff = (const LAS int*)(F.lds + TOFF_OFF);
    const unsigned char* h8 = F.ws + WS_H8; unsigned char* xp = F.ws + WS_XP8;
    for (int blk = blockIdx.x; blk < NTOK / 128; blk += F.G) {
        const int p0 = blk * 512 + F.wave * 64;
        const int es = WSP(int, WS_TOKES)[p0 + F.lane];
        const int rowl = toff[es >> 16] * 256 + (es & 0xffff);
        WSP(int, WS_ROWIDX)[p0 + F.lane] = rowl;
#pragma unroll 8
        for (int p = 0; p < 64; ++p) { const int row = __shfl(rowl, p); const int t = (p0 + p) >> 2;
            const v4u a = *(const v4u*)(h8 + (size_t)t * D + 16 * F.lane);
            *(v4u*)(xp + (size_t)row * D + 16 * F.lane) = a; }
    }
}
__device__ __forceinline__ void ph_phase(Frame& F, const Args& A, int l) {
    RELANE(F);
    const int gw = blockIdx.x * NWAVES + F.wave, NGW = F.G * NWAVES;
    LnPar lp; ln_load(lp, A.in[I_LN2_G] + l * D, A.in[I_LN2_B] + l * D, F.lane);
    bf16* hb = TILEP(T_HB); const bf16* ys = WSP(bf16, WS_YS);
    for (int t0 = gw * 16; t0 < NTOK; t0 += NGW * 16) {
        const int ri = WSP(int, WS_ROWIDX)[(size_t)t0 * 4 + F.lane]; const float gk = WSP(float, WS_TOKG)[(size_t)t0 * 4 + F.lane];
#pragma nounroll
        for (int i = 0; i < 16; i += 2) {
            v4u hr[2][2], yr[2][4][2];
#pragma unroll
            for (int rr = 0; rr < 2; ++rr) { const bf16* hp = hb + (size_t)(t0 + i + rr) * D + 8 * F.lane; hr[rr][0] = *(const v4u*)hp; hr[rr][1] = *(const v4u*)(hp + 512);
#pragma unroll
                for (int k = 0; k < 4; ++k) { const int row = __shfl(ri, 4 * (i + rr) + k); const bf16* yp = ys + (size_t)row * D + 8 * F.lane; yr[rr][k][0] = *(const v4u*)yp; yr[rr][k][1] = *(const v4u*)(yp + 512); } }
#pragma unroll
            for (int rr = 0; rr < 2; ++rr) { const int t = t0 + i + rr;
                f32x4 v[4]; v[0] = bf2lo(hr[rr][0]) * DN_ALPHA; v[1] = bf2hi(hr[rr][0]) * DN_ALPHA; v[2] = bf2lo(hr[rr][1]) * DN_ALPHA; v[3] = bf2hi(hr[rr][1]) * DN_ALPHA;
#pragma unroll
                for (int k = 0; k < 4; ++k) { const float g = __shfl(gk, 4 * (i + rr) + k);
                    v[0] += bf2lo(yr[rr][k][0]) * g; v[1] += bf2hi(yr[rr][k][0]) * g; v[2] += bf2lo(yr[rr][k][1]) * g; v[3] += bf2hi(yr[rr][k][1]) * g; }
                ln_affine(v, lp);
                if (l == NLAYER - 1) { float* op = F.out + (size_t)t * D + 8 * F.lane; *(f32x4*)op = v[0]; *(f32x4*)(op + 4) = v[1]; *(f32x4*)(op + 512) = v[2]; *(f32x4*)(op + 516) = v[3]; }
                else { bf16* op = hb + (size_t)t * D + 8 * F.lane; *(v4u*)op = pack8(v[0], v[1]); *(v4u*)(op + 512) = pack8(v[2], v[3]); } }
        }
    }
}

constexpr int MX_VT = 0, MX_K = 65536, MX_V = 65536 + 32768;
__device__ __forceinline__ void unpack8(const v4u raw, float (&f)[8]) {
    f[0] = __builtin_bit_cast(float, raw.x << 16); f[1] = __builtin_bit_cast(float, raw.x & 0xffff0000u); f[2] = __builtin_bit_cast(float, raw.y << 16); f[3] = __builtin_bit_cast(float, raw.y & 0xffff0000u);
    f[4] = __builtin_bit_cast(float, raw.z << 16); f[5] = __builtin_bit_cast(float, raw.z & 0xffff0000u); f[6] = __builtin_bit_cast(float, raw.w << 16); f[7] = __builtin_bit_cast(float, raw.w & 0xffff0000u);
}
__device__ __forceinline__ void mix_finish(float (&val)[8][8], const float* gain, bf16* grow, int q) {
    float ss = 0.f;
#pragma unroll
    for (int cb = 0; cb < 8; ++cb)
#pragma unroll
        for (int i = 0; i < 8; ++i) ss += val[cb][i] * val[cb][i];
    ss += __shfl_xor(ss, 16); ss += __shfl_xor(ss, 32);
    const float rs = 1.0f / sqrtf(ss * (1.0f / 256.0f) + RMS_EPS);
#pragma unroll
    for (int cb = 0; cb < 8; ++cb) { const f32x4 g0 = *(const f32x4*)(gain + 32 * cb + 8 * q), g1 = *(const f32x4*)(gain + 32 * cb + 8 * q + 4);
        v4u o; o.x = pk2(val[cb][0] * rs * g0.x, val[cb][1] * rs * g0.y); o.y = pk2(val[cb][2] * rs * g0.z, val[cb][3] * rs * g0.w);
        o.z = pk2(val[cb][4] * rs * g1.x, val[cb][5] * rs * g1.y); o.w = pk2(val[cb][6] * rs * g1.z, val[cb][7] * rs * g1.w);
        *(v4u*)(grow + 32 * cb + 8 * q) = o; }
}
__device__ __forceinline__ void pb_phase(Frame& F, const Args& A, int l) {
    for (int u = blockIdx.x; u < NTOK / 128; u += F.G) {
    RELANE(F);
    const int r = F.lane & 15, q = F.lane >> 4, w = F.wave;
    const bf16* P = WSP(bf16, WS_P); bf16* G = TILEP(T_G);
    const float* gng = A.in[I_GROUP_NORM_G] + l * 1024;
        const int row = u * 128 + 16 * w + r, tseq = (u & 15) * 128 + 16 * w + r, b = u >> 4;
        const bf16* prow = P + (size_t)row * NPROJ; bf16* grow = G + (size_t)row * 1024;
        float val[8][8];
#if MXMASK & 1
        {
            const float* cw = A.in[I_CONV_W] + l * 768;
#pragma unroll
            for (int cb = 0; cb < 8; ++cb) { const int col = 32 * cb + 8 * q;
                float gb[8], zc[8], zh[8], z[8], acc[8];
                unpack8(*(const v4u*)(prow + col), gb);
#pragma unroll
                for (int i = 0; i < 8; ++i) acc[i] = 0.f;
#pragma unroll
                for (int d = 0; d < 3; ++d) {
                    if (tseq - 2 + d >= 0) { const bf16* pr = prow - (size_t)(2 - d) * NPROJ;
                        unpack8(*(const v4u*)(pr + 256 + col), zc); unpack8(*(const v4u*)(pr + 512 + col), zh);
                        const f32x4 w0 = *(const f32x4*)(cw + d * 256 + col), w1 = *(const f32x4*)(cw + d * 256 + col + 4);
#pragma unroll
                        for (int i = 0; i < 8; ++i) z[i] = zc[i] * zh[i];
                        acc[0] += w0.x * z[0]; acc[1] += w0.y * z[1]; acc[2] += w0.z * z[2]; acc[3] += w0.w * z[3]; acc[4] += w1.x * z[4]; acc[5] += w1.y * z[5]; acc[6] += w1.z * z[6]; acc[7] += w1.w * z[7]; } }
#pragma unroll
                for (int i = 0; i < 8; ++i) val[cb][i] = gb[i] * acc[i];
                asm volatile("" ::: "memory"); }
            mix_finish(val, gng, grow, q);
        }
#endif
        asm volatile("" ::: "memory"); __builtin_amdgcn_sched_barrier(0);
#if MXMASK & 2
        {
            const bf16* pt = WSP(bf16, WS_POOLT) + (size_t)l * 4 * 4096;
            bf16x8 dfr[4][2];
#pragma unroll
            for (int g = 0; g < 4; ++g)
#pragma unroll
                for (int ks = 0; ks < 2; ++ks) { const int col = 768 + g * 64 + 32 * ks + 8 * q, wlen = 2 << g;
                    float acc[8], x[8], t8[8];
                    unpack8(*(const v4u*)(prow + col), x);
#pragma unroll
                    for (int i = 0; i < 8; ++i) acc[i] = x[i];
                    for (int d = 1; d < wlen; ++d) if (tseq - d >= 0) { unpack8(*(const v4u*)(prow - (size_t)d * NPROJ + col), t8);
#pragma unroll
                        for (int i = 0; i < 8; ++i) acc[i] += t8[i]; }
                    const float inv = 1.0f / (float)((tseq + 1 < wlen) ? tseq + 1 : wlen);
                    v4u o; o.x = pk2(acc[0] * inv - x[0], acc[1] * inv - x[1]); o.y = pk2(acc[2] * inv - x[2], acc[3] * inv - x[3]);
                    o.z = pk2(acc[4] * inv - x[4], acc[5] * inv - x[5]); o.w = pk2(acc[6] * inv - x[6], acc[7] * inv - x[7]);
                    dfr[g][ks] = __builtin_bit_cast(bf16x8, o);
                    asm volatile("" ::: "memory"); }
            const float* psc = A.in[I_POOL_SCALE] + l * 256;
#pragma unroll
            for (int g = 0; g < 4; ++g)
#pragma unroll
                for (int mt2 = 0; mt2 < 2; ++mt2) { const f32x4 s0 = *(const f32x4*)(psc + g * 64 + 32 * mt2 + 8 * q), s1 = *(const f32x4*)(psc + g * 64 + 32 * mt2 + 8 * q + 4);
#pragma unroll
                    for (int e = 0; e < 2; ++e) { const int dd = 32 * mt2 + 8 * (r >> 2) + 4 * e + (r & 3);
                        f32x4 o = {0.f, 0.f, 0.f, 0.f};
#pragma unroll
                        for (int ks = 0; ks < 2; ++ks) { const bf16x8 a = *(const bf16x8*)(pt + (size_t)(g * 64 + dd) * 64 + 32 * ks + 8 * q);
                            o = __builtin_amdgcn_mfma_f32_16x16x32_bf16(a, dfr[g][ks], o, 0, 0, 0); }
                        const f32x4 sc = e ? s1 : s0;
                        val[2 * g + mt2][4 * e + 0] = o[0] * sc.x; val[2 * g + mt2][4 * e + 1] = o[1] * sc.y; val[2 * g + mt2][4 * e + 2] = o[2] * sc.z; val[2 * g + mt2][4 * e + 3] = o[3] * sc.w; } }
            mix_finish(val, gng + 256, grow + 256, q);
        }
#endif
        asm volatile("" ::: "memory"); __builtin_amdgcn_sched_barrier(0);
#if MXMASK & 4
        {
            const float* lg = A.in[I_GMLP_LN_G] + l * 256; const float* lb = A.in[I_GMLP_LN_B] + l * 256;
            const f32x4 g4 = *(const f32x4*)(lg + 4 * F.lane), b4 = *(const f32x4*)(lb + 4 * F.lane);
            const int hh_l = F.lane >> 4, mt2_l = (F.lane & 15) >> 3, q_l = (F.lane & 7) >> 1, e_l = F.lane & 1;
#pragma unroll 2
            for (int jp = 0; jp < 8; ++jp) { const int j = 16 * w + 2 * jp;
                const bf16* p0 = P + (size_t)(u * 128 + j) * NPROJ + 1280 + 4 * F.lane;
                const v2u ra = *(const v2u*)p0, rb = *(const v2u*)(p0 + NPROJ);
                float va[4], vb[4];
                va[0] = gelu_tanh(__builtin_bit_cast(float, ra.x << 16)); va[1] = gelu_tanh(__builtin_bit_cast(float, ra.x & 0xffff0000u)); va[2] = gelu_tanh(__builtin_bit_cast(float, ra.y << 16)); va[3] = gelu_tanh(__builtin_bit_cast(float, ra.y & 0xffff0000u));
                vb[0] = gelu_tanh(__builtin_bit_cast(float, rb.x << 16)); vb[1] = gelu_tanh(__builtin_bit_cast(float, rb.x & 0xffff0000u)); vb[2] = gelu_tanh(__builtin_bit_cast(float, rb.y << 16)); vb[3] = gelu_tanh(__builtin_bit_cast(float, rb.y & 0xffff0000u));
                const float ma = wave_sum((va[0] + va[1]) + (va[2] + va[3])) * (1.f / 256.f), mb = wave_sum((vb[0] + vb[1]) + (vb[2] + vb[3])) * (1.f / 256.f);
                float sa = 0.f, sb = 0.f;
#pragma unroll
                for (int c = 0; c < 4; ++c) { va[c] -= ma; vb[c] -= mb; sa += va[c] * va[c]; sb += vb[c] * vb[c]; }
                const float ra_ = 1.f / sqrtf(wave_sum(sa) * (1.f / 256.f) + LN_EPS), rb_ = 1.f / sqrtf(wave_sum(sb) * (1.f / 256.f) + LN_EPS);
                const int ks = j >> 5, gg = (j & 31) >> 3, jj = j & 7;
                LAS unsigned char* dst = F.lds + MX_VT + ((((hh_l * 2 + mt2_l) * 2 + e_l) * 4 + ks) * 64 + 16 * gg + 4 * q_l) * 16 + jj * 2;
                const float ga[4] = {g4.x, g4.y, g4.z, g4.w}, ba[4] = {b4.x, b4.y, b4.z, b4.w};
#pragma unroll
                for (int c = 0; c < 4; ++c) *(LAS unsigned*)(dst + c * 16) = pk2(va[c] * ra_ * ga[c] + ba[c], vb[c] * rb_ * ga[c] + ba[c]);
            }
            __syncthreads();
            const bf16* wm = WSP(bf16, WS_WMB) + (size_t)l * 4 * 128 * 128; const float* gbias = A.in[I_GMLP_B] + l * 512;
            const int nks = (w < 4) ? 2 : 4;
#pragma unroll
            for (int hh = 0; hh < 4; ++hh) {
                bf16x8 wf[4];
#pragma unroll
                for (int ks = 0; ks < 4; ++ks) wf[ks] = *(const bf16x8*)(wm + (size_t)(hh * 128 + 16 * w + r) * 128 + 32 * ks + 8 * q);
                const float bias = gbias[hh * 128 + 16 * w + r];
#pragma unroll
                for (int mt2 = 0; mt2 < 2; ++mt2) {
                    float uu[8]; unpack8(*(const v4u*)(prow + 1024 + hh * 64 + 32 * mt2 + 8 * q), uu);
#pragma unroll
                    for (int e = 0; e < 2; ++e) { f32x4 o = {0.f, 0.f, 0.f, 0.f};
#pragma unroll
                        for (int ks = 0; ks < 4; ++ks) if (ks < nks) { const bf16x8 a = *(const LAS bf16x8*)(F.lds + MX_VT + ((((hh * 2 + mt2) * 2 + e) * 4 + ks) * 64 + F.lane) * 16);
                            o = __builtin_amdgcn_mfma_f32_16x16x32_bf16(a, wf[ks], o, 0, 0, 0); }
#pragma unroll
                        for (int i = 0; i < 4; ++i) val[2 * hh + mt2][4 * e + i] = gelu_tanh(uu[4 * e + i]) * (o[i] + bias); } }
            }
            mix_finish(val, gng + 512, grow + 512, q);
        }
#endif
        asm volatile("" ::: "memory"); __builtin_amdgcn_sched_barrier(0);
#if MXMASK & 8
        {
            const bf16* kb = WSP(bf16, WS_KB) + ((size_t)l * 4096 + (size_t)b * 256) * 256;
            const bf16* vt = WSP(bf16, WS_VT) + (size_t)l * 256 * 4096 + (size_t)b * 256;
            float rsum[4];
#pragma unroll
            for (int hh = 0; hh < 4; ++hh) {
                __syncthreads();
#pragma unroll
                for (int i = 0; i < 4; ++i) { const int idx = F.tid + 512 * i;
                    { const int key = idx >> 3, cidx = idx & 7; const v4u x = *(const v4u*)(kb + (size_t)key * 256 + hh * 64 + 8 * cidx);
                      *(LAS v4u*)(F.lds + MX_K + ((((key >> 4) * 2 + (cidx >> 2)) * 64) + 16 * (cidx & 3) + (key & 15)) * 16) = x; }
                    { const int d = idx >> 5, c16 = idx & 31; const v4u x = *(const v4u*)(vt + (size_t)(hh * 64 + d) * 4096 + 8 * c16);
                      const int key0 = 8 * c16, s = key0 >> 5, kk = key0 & 31, half = kk >> 4, gA = (kk & 15) >> 2, mt2 = d >> 5, rem = d & 31, m = 4 * (rem >> 3) + (rem & 3), e = (rem >> 2) & 1;
                      LAS unsigned char* dst = F.lds + MX_V + ((((mt2 * 2 + e) * 8 + s) * 64) + 16 * gA + m) * 16 + half * 8;
                      v2u lo; lo.x = x.x; lo.y = x.y; v2u hi; hi.x = x.z; hi.y = x.w; *(LAS v2u*)dst = lo; *(LAS v2u*)(dst + 256) = hi; } }
                const bf16x8 q0 = *(const bf16x8*)(prow + 1536 + hh * 64 + 8 * q), q1 = *(const bf16x8*)(prow + 1536 + hh * 64 + 32 + 8 * q);
                __syncthreads();
                f32x4 st[16];
#pragma unroll
                for (int t = 0; t < 16; ++t) { const bf16x8 k0 = *(const LAS bf16x8*)(F.lds + MX_K + ((t * 2 + 0) * 64 + F.lane) * 16), k1 = *(const LAS bf16x8*)(F.lds + MX_K + ((t * 2 + 1) * 64 + F.lane) * 16);
                    f32x4 z = {0.f, 0.f, 0.f, 0.f}; z = __builtin_amdgcn_mfma_f32_16x16x32_bf16(k0, q0, z, 0, 0, 0); st[t] = __builtin_amdgcn_mfma_f32_16x16x32_bf16(k1, q1, z, 0, 0, 0); }
                float mx = -3.0e38f;
#pragma unroll
                for (int t = 0; t < 16; ++t) mx = fmaxf(fmaxf(mx, fmaxf(st[t][0], st[t][1])), fmaxf(st[t][2], st[t][3]));
                mx = fmaxf(mx, __shfl_xor(mx, 16)); mx = fmaxf(mx, __shfl_xor(mx, 32));
                float sum = 0.f; const float c2 = 0.125f * 1.4426950408889634f, mo = mx * c2;
#pragma unroll
                for (int t = 0; t < 16; ++t)
#pragma unroll
                    for (int i = 0; i < 4; ++i) { const float p = __builtin_amdgcn_exp2f(st[t][i] * c2 - mo); st[t][i] = p; sum += p; }
                sum += __shfl_xor(sum, 16); sum += __shfl_xor(sum, 32); rsum[hh] = 1.0f / sum;
                bf16x8 pb[8];
#pragma unroll
                for (int s = 0; s < 8; ++s) { v4u o; o.x = pk2(st[2 * s][0], st[2 * s][1]); o.y = pk2(st[2 * s][2], st[2 * s][3]); o.z = pk2(st[2 * s + 1][0], st[2 * s + 1][1]); o.w = pk2(st[2 * s + 1][2], st[2 * s + 1][3]);
                    pb[s] = __builtin_bit_cast(bf16x8, o); }
#pragma unroll
                for (int mt2 = 0; mt2 < 2; ++mt2)
#pragma unroll
                    for (int e = 0; e < 2; ++e) { f32x4 o = {0.f, 0.f, 0.f, 0.f};
#pragma unroll
                        for (int s = 0; s < 8; ++s) { const bf16x8 a = *(const LAS bf16x8*)(F.lds + MX_V + (((mt2 * 2 + e) * 8 + s) * 64 + F.lane) * 16);
                            o = __builtin_amdgcn_mfma_f32_16x16x32_bf16(a, pb[s], o, 0, 0, 0); }
#pragma unroll
                        for (int i = 0; i < 4; ++i) val[2 * hh + mt2][4 * e + i] = o[i] * rsum[hh]; }
            }
            mix_finish(val, gng + 768, grow + 768, q);
        }
#endif
        __syncthreads();
    }
}

#if NAIVE_MIX
__global__ void __launch_bounds__(256) nv_mix_pre(const bf16* P, const float* lng, const float* lnb, float* Vn, float* Dp) {
    const int row = blockIdx.x * 4 + (threadIdx.x >> 6), lane = threadIdx.x & 63;
    const bf16* p = P + (size_t)row * NPROJ;
    float v[4]; float s = 0.f;
    for (int i = 0; i < 4; ++i) { v[i] = gelu_tanh(bf2f(p[1280 + 4 * lane + i])); s += v[i]; }
    const float mean = wave_sum(s) * (1.f / 256.f); float s2 = 0.f;
    for (int i = 0; i < 4; ++i) { v[i] -= mean; s2 += v[i] * v[i]; }
    const float rstd = 1.f / sqrtf(wave_sum(s2) * (1.f / 256.f) + LN_EPS);
    for (int i = 0; i < 4; ++i) Vn[(size_t)row * 256 + 4 * lane + i] = v[i] * rstd * lng[4 * lane + i] + lnb[4 * lane + i];
    const int t = row % SEQ, w = 2 << (lane >> 4), cnt = (t + 1 < w) ? t + 1 : w;
    for (int i = 0; i < 4; ++i) { const int c = 4 * lane + i; float acc = 0.f;
        for (int d = 0; d < cnt; ++d) acc += bf2f(P[(size_t)(row - d) * NPROJ + 768 + c]);
        Dp[(size_t)row * 256 + c] = acc / (float)cnt - bf2f(p[768 + c]); }
}
__global__ void __launch_bounds__(256) nv_mix_main(const bf16* P, const float* Vn, const float* Dp, const bf16* Kb, const bf16* VT, const float* conv_w, const float* pool_w, const float* pool_scale,
                                                   const float* gmlp_w, const float* gmlp_b, float* Y) {
    const int row = blockIdx.x >> 2, grp = blockIdx.x & 3, c = threadIdx.x, t = row % SEQ;
    const bf16* p = P + (size_t)row * NPROJ; float y = 0.f;
    if (grp == 0) {
        float z[3];
        for (int d = 0; d < 3; ++d) { const int tt = t - 2 + d; z[d] = (tt >= 0) ? bf2f(P[(size_t)(row - 2 + d) * NPROJ + 256 + c]) * bf2f(P[(size_t)(row - 2 + d) * NPROJ + 512 + c]) : 0.f; }
        y = bf2f(p[c]) * (conv_w[c] * z[0] + conv_w[256 + c] * z[1] + conv_w[512 + c] * z[2]);
    } else if (grp == 1) {
        const int gi = c >> 6, dd = c & 63; float acc = 0.f;
        for (int cc = 0; cc < 64; ++cc) acc += Dp[(size_t)row * 256 + gi * 64 + cc] * pool_w[(gi * 64 + cc) * 64 + dd];
        y = acc * pool_scale[c];
    } else if (grp == 2) {
        const int hh = c >> 6, i = t & 127, jmax = ((i >> 6) + 1) * 64; const size_t blk0 = (size_t)(row - i); float acc = 0.f;
        for (int j = 0; j < jmax; ++j) acc += gmlp_w[(hh * 128 + i) * 128 + j] * Vn[(blk0 + j) * 256 + c];
        y = gelu_tanh(bf2f(p[1024 + c])) * (acc + gmlp_b[hh * 128 + i]);
    } else {
        const int hh = c >> 6, lane = c & 63, b = row / SEQ;
        const float q = bf2f(p[1536 + hh * 64 + lane]);
        float sc[4] = {0.f, 0.f, 0.f, 0.f};
        for (int d = 0; d < 64; ++d) { const float qd = __shfl(q, d);
            for (int m = 0; m < 4; ++m) sc[m] += qd * bf2f(Kb[(size_t)(b * 256 + lane + 64 * m) * 256 + hh * 64 + d]); }
        float mx = -3.0e38f;
        for (int m = 0; m < 4; ++m) { sc[m] *= 0.125f; mx = fmaxf(mx, sc[m]); }
        for (int o = 1; o < 64; o <<= 1) mx = fmaxf(mx, __shfl_xor(mx, o));
        float sum = 0.f;
        for (int m = 0; m < 4; ++m) { sc[m] = __expf(sc[m] - mx); sum += sc[m]; }
        sum = wave_sum(sum);
        float o = 0.f;
        for (int m = 0; m < 4; ++m) for (int j = 0; j < 64; ++j) { const float pj = __shfl(sc[m], j); o += pj * bf2f(VT[(size_t)(hh * 64 + lane) * 4096 + b * 256 + j + 64 * m]); }
        y = o / sum;
    }
    Y[(size_t)row * 1024 + grp * 256 + c] = y;
}
__global__ void __launch_bounds__(256) nv_mix_norm(const float* Y, const float* gng, bf16* G) {
    const int wv = blockIdx.x * 4 + (threadIdx.x >> 6), lane = threadIdx.x & 63, row = wv >> 2, grp = wv & 3;
    const float* y = Y + (size_t)row * 1024 + grp * 256; float v[4], s2 = 0.f;
    for (int i = 0; i < 4; ++i) { v[i] = y[4 * lane + i]; s2 += v[i] * v[i]; }
    const float r = 1.f / sqrtf(wave_sum(s2) * (1.f / 256.f) + RMS_EPS);
    for (int i = 0; i < 4; ++i) G[(size_t)row * 1024 + grp * 256 + 4 * lane + i] = (bf16)f2bf(v[i] * r * gng[grp * 256 + 4 * lane + i]);
}
#endif

constexpr int PH_PRO = 0, PH_KV = 1, PH_L0 = 2, PH_PER_LAYER = 8, N_PHASES = PH_L0 + NLAYER * PH_PER_LAYER;
__global__ void __launch_bounds__(NWAVES * 64, 2) fwd(Args args) {
    const Args& A = args;
    extern __shared__ __attribute__((aligned(16))) unsigned char lds[];
    Frame F;
    F.lds = (LAS unsigned char*)lds;
    F.MISC = (volatile LAS unsigned*)(F.lds + MISC_OFF);
    F.tid = threadIdx.x; F.lane = F.tid & 63; F.wave = __builtin_amdgcn_readfirstlane(F.tid >> 6);
    F.G = gridDim.x; F.ws = args.ws; F.ctl = (gu32*)(args.ws + WS_CTL); F.out = args.out;
    for (int u = F.tid; u < (LDS_BYTES - LDSCTL_OFF) / 4; u += NWAVES * 64) ((LAS unsigned*)(F.lds + LDSCTL_OFF))[u] = 0u;
    __syncthreads();
#if MK_ONE_LAUNCH
    XcdBarrier bar = xcd_barrier_post((unsigned*)(F.ctl + CW_BAR), F.MISC + 8);
#define GRID_BAR() xcd_barrier(bar)
#else
#define GRID_BAR() do { } while (0)
#endif
    const int lo = args.ph_lo, hi = args.ph_hi;
#define IN(k) (lo <= (k) && (k) < hi)
#define REP(q) for (int rep_ = 0; rep_ < ((DUP_PHASE == (q)) ? 2 : 1); ++rep_)
#define BOTH(k) (IN(k) && IN((k) + 1))
    const pg8::Gemm gm{(const pg8::bf16_t*)F.ws, (const pg8::bf16_t*)F.ws, D};
    const int c = (int)blockIdx.x;

    REP(100) if (IN(PH_PRO) && (PHMASK & 1)) { p0_prologue(F, args); if (BOTH(PH_PRO)) GRID_BAR(); }
    REP(101) if (IN(PH_KV) && (PHMASK & 2)) {
        KvOrder S{F.G, c};
        pg8::EpiBf16Sel E{WSP(bf16, WS_KB), WSP(bf16, WS_VT), 256, 4096};
        pg8::gemm_phase<pg8::EpiBf16Sel, KvOrder, true, true>(F.lds + RING_OFF, gm, S, E);
        if (BOTH(PH_KV)) GRID_BAR();
    }
    for (int l = 0; l < NLAYER; ++l) {
        const int pb = PH_L0 + l * PH_PER_LAYER;
        REP(0) if (IN(pb + 0) && (PHMASK & 4)) {
            DenseOrder S{NTOK / 256, NPROJ / 256, F.G, c, T_HB, T_WIN + l * (NPROJ / 256)};
            pg8::EpiBf16Sel E{WSP(bf16, WS_P), WSP(bf16, WS_P), NPROJ, NPROJ};
            pg8::gemm_phase<pg8::EpiBf16Sel, DenseOrder, true, true>(F.lds + RING_OFF, gm, S, E);
            if (BOTH(pb + 0)) GRID_BAR();
        }
        REP(1) if (IN(pb + 1) && (PHMASK & 512)) {
            pb_phase(F, args, l);
            if (BOTH(pb + 1)) GRID_BAR();
        }
        REP(2) if (IN(pb + 2) && (PHMASK & 8)) {
            DenseOrder S{NTOK / 256, D / 256, F.G, c, T_G, T_WOUT + l * (D / 256)};
            pg8::EpiResBf16 E{TILEP(T_HB), WSP(bf16, WS_PRE), DN_ALPHA};
            pg8::gemm_phase<pg8::EpiResBf16, DenseOrder, true, true>(F.lds + RING_OFF, gm, S, E);
            if (BOTH(pb + 2)) GRID_BAR();
        }
        if (IN(pb + 3) && (PHMASK & 16)) { pd_phase(F, args, l); if (BOTH(pb + 3)) GRID_BAR(); }
        REP(4) if (IN(pb + 4) && (PHMASK & 32)) { pe_phase(F, l); if (BOTH(pb + 4)) GRID_BAR(); }
        REP(5) if (IN(pb + 5) && (PHMASK & 64)) {
            compute_toff(F, l);
            const LAS int* toff = (const LAS int*)(F.lds + TOFF_OFF);
            MoeOrder S{__builtin_amdgcn_readfirstlane(toff[NEXP]), 8, F.G, c, Q8(WS_XP8), Q8(WS_W18) + l * NEXP * 8, toff};
            pg8::EpiSwiglu E{F.ws + WS_ACT8, A.in[I_B1] + (size_t)l * NEXP * 2048};
            pg8::gemm_phase<pg8::EpiSwiglu, MoeOrder, true, true, true>(F.lds + RING_OFF, gm, S, E);
            if (BOTH(pb + 5)) GRID_BAR();
        }
        REP(6) if (IN(pb + 6) && (PHMASK & 128)) {
            compute_toff(F, l);
            const LAS int* toff = (const LAS int*)(F.lds + TOFF_OFF);
            MoeOrder S{__builtin_amdgcn_readfirstlane(toff[NEXP]), 4, F.G, c, Q8(WS_ACT8), Q8(WS_W28) + l * NEXP * 4, toff};
            pg8::EpiDown E{WSP(bf16, WS_YS), A.in[I_B2] + (size_t)l * NEXP * 1024};
            pg8::gemm_phase<pg8::EpiDown, MoeOrder, true, true, true>(F.lds + RING_OFF, gm, S, E);
            if (BOTH(pb + 6)) GRID_BAR();
        }
        if (IN(pb + 7) && (PHMASK & 256)) { ph_phase(F, args, l); if (BOTH(pb + 7)) GRID_BAR(); }
    }
#undef IN
#undef BOTH
}

extern "C" void kernel_launch(void* const* d_in, const int* in_sizes, int n_in, void* d_out, int out_size, void* d_ws, size_t ws_size, hipStream_t stream) {
    static int grid = 0;
    if (grid == 0) {
        if (n_in != 27 || out_size != NTOK * D || ws_size < WS_END) { fprintf(stderr, "kernel_launch: unexpected problem (n_in %d, out %d, ws %zu < %zu)\n", n_in, out_size, ws_size, (size_t)WS_END); grid = -1; return; }
        int dev = 0, cus = 0, per_cu = 0;
        if (hipGetDevice(&dev) != hipSuccess || hipDeviceGetAttribute(&cus, hipDeviceAttributeMultiprocessorCount, dev) != hipSuccess) { grid = -1; return; }
        if (hipFuncSetAttribute((const void*)fwd, hipFuncAttributeMaxDynamicSharedMemorySize, LDS_BYTES) != hipSuccess) { fprintf(stderr, "kernel_launch: hipFuncSetAttribute failed\n"); grid = -1; return; }
        if (hipOccupancyMaxActiveBlocksPerMultiprocessor(&per_cu, (const void*)fwd, NWAVES * 64, LDS_BYTES) != hipSuccess || per_cu < 1) fprintf(stderr, "kernel_launch: occupancy query says %d\n", per_cu);
        (void)hipGetLastError();
        grid = cus;
    }
    if (grid < 0) return;
    if (hipMemsetAsync((char*)d_ws + WS_CTL, 0, CTL_ZERO_BYTES, stream) != hipSuccess) return;
    Args a{};
    for (int i = 0; i < 27; ++i) a.in[i] = (const float*)d_in[i];
    a.out = (float*)d_out; a.ws = (unsigned char*)d_ws;
#if MK_ONE_LAUNCH
    a.ph_lo = 0; a.ph_hi = N_PHASES;
    hipLaunchKernelGGL(fwd, dim3(grid), dim3(NWAVES * 64), LDS_BYTES, stream, a);
#else
    unsigned char* ws = (unsigned char*)d_ws;
    for (int p = 0; p < N_PHASES; ++p) {
        const int l = (p - PH_L0) / PH_PER_LAYER, q = (p - PH_L0) % PH_PER_LAYER;
        if (p >= PH_L0 && q == 1) {
#if NAIVE_MIX
            const float* const* in = (const float* const*)d_in;
            hipLaunchKernelGGL(nv_mix_pre, dim3(NTOK / 4), dim3(256), 0, stream, (const bf16*)(ws + WS_P), in[10] + l * 256, in[11] + l * 256, (float*)(ws + WS_NV_VN), (float*)(ws + WS_NV_DP));
            hipLaunchKernelGGL(nv_mix_main, dim3(NTOK * 4), dim3(256), 0, stream, (const bf16*)(ws + WS_P), (const float*)(ws + WS_NV_VN), (const float*)(ws + WS_NV_DP),
                               (const bf16*)(ws + WS_KB) + (size_t)l * 4096 * 256, (const bf16*)(ws + WS_VT) + (size_t)l * 256 * 4096, in[7] + l * 768, in[8] + l * 4 * 64 * 64, in[9] + l * 256,
                               in[12] + l * 4 * 128 * 128, in[13] + l * 4 * 128, (float*)(ws + WS_NV_Y));
            hipLaunchKernelGGL(nv_mix_norm, dim3(NTOK), dim3(256), 0, stream, (const float*)(ws + WS_NV_Y), in[15] + l * 1024, (bf16*)(ws + (size_t)T_G * TILE));
            continue;
#endif
        }
        a.ph_lo = p; a.ph_hi = p + 1;
        hipLaunchKernelGGL(fwd, dim3(grid), dim3(NWAVES * 64), LDS_BYTES, stream, a);
    }
#endif
}
```

```cpp
#include <hip/hip_runtime.h>
#include <cstdio>
#include <cstdint>

#ifndef MK_ONE_LAUNCH
#define MK_ONE_LAUNCH 1
#endif
#ifndef PHMASK
#define PHMASK 0xffff
#endif
#ifndef MXMASK
#define MXMASK 15
#endif
#ifndef DUP_PHASE
#define DUP_PHASE -1
#endif
#ifndef DUP_EPI
#define DUP_EPI 0
#endif
#ifndef NAIVE_MIX
#define NAIVE_MIX 0
#endif

namespace pg8 {
#define PG8_LAS __attribute__((address_space(3)))
typedef unsigned short bf16_t;
typedef short bf16x8 __attribute__((ext_vector_type(8)));
typedef float f32x4 __attribute__((ext_vector_type(4)));
typedef float f32x2 __attribute__((ext_vector_type(2)));
typedef unsigned u32x4 __attribute__((ext_vector_type(4)));
typedef unsigned u32x2 __attribute__((ext_vector_type(2)));
constexpr int BM = 256, BK = 64, HALF = 128, HTB = HALF * BK * 2  , STAGE_BYTES = 8 * HTB, NXCD = 8, WGM = 8;

__host__ __device__ __forceinline__ int lds_byte(int r, int c) { const int st = (r >> 4) * 2 + (c >> 5), rr = r & 15, cc = c & 31, ob = rr * 64 + cc * 2; return st * 1024 + (ob ^ (((ob >> 9) & 1) << 5)); }
__host__ __device__ __forceinline__ void stage_rc(int b, int& R, int& C) { const int st = b / 1024, sb = b % 1024, swz = sb ^ (((sb >> 9) & 1) << 5); R = (st >> 1) * 16 + swz / 64; C = (st & 1) * 32 + (swz % 64) / 2; }
__host__ __device__ __forceinline__ int perm32(int rho) { const int n = rho >> 4, i = rho & 15; return 8 * (i >> 2) + 4 * n + (i & 3); }

struct Unit { int pm, pn, lm, ln, a0; };
struct Gemm { const bf16_t* A; const bf16_t* Bt; int K; };

__device__ __forceinline__ void tile_of(int L, int nM, int nN, int& tm, int& tn) {
    const int nwg = nM * nN; int wgid = L; { const int q = nwg / NXCD, r = nwg % NXCD, xcd = wgid % NXCD, off = wgid / NXCD; wgid = (xcd < r ? xcd * (q + 1) : r * (q + 1) + (xcd - r) * q) + off; }
    const int nig = WGM * nN, gid = wgid / nig, fm = gid * WGM, gsz = (nM - fm) < WGM ? (nM - fm) : WGM;
    tm = fm + ((wgid % nig) % gsz); tn = (wgid % nig) / gsz;
}

typedef int v8i __attribute__((ext_vector_type(8)));
__device__ __forceinline__ v8i cat8(bf16x8 a, bf16x8 b) { typedef short s16x16 __attribute__((ext_vector_type(16))); return __builtin_bit_cast(v8i, __builtin_shufflevector(a, b, 0, 1, 2, 3, 4, 5, 6, 7, 8, 9, 10, 11, 12, 13, 14, 15)); }
__device__ __forceinline__ bf16x8 half8(v8i x, int k) { typedef int v4i __attribute__((ext_vector_type(4))); return __builtin_bit_cast(bf16x8, k ? __builtin_shufflevector(x, x, 4, 5, 6, 7) : __builtin_shufflevector(x, x, 0, 1, 2, 3)); }
__device__ __forceinline__ void mfma_fp8_acc(f32x4& acc, const v8i& a, const v8i& b) { asm volatile("v_mfma_f32_16x16x128_f8f6f4 %0, %1, %2, %0" : "+v"(acc) : "v"(a), "v"(b)); }
__device__ __forceinline__ unsigned cvt4_fp8(float a, float b, float c, float d) {
    a = __builtin_amdgcn_fmed3f(a, -448.f, 448.f); b = __builtin_amdgcn_fmed3f(b, -448.f, 448.f); c = __builtin_amdgcn_fmed3f(c, -448.f, 448.f); d = __builtin_amdgcn_fmed3f(d, -448.f, 448.f);
    int r = __builtin_amdgcn_cvt_pk_fp8_f32(a, b, 0, false); r = __builtin_amdgcn_cvt_pk_fp8_f32(c, d, r, true); return (unsigned)r; }
__device__ __forceinline__ unsigned cvt_pk_bf16(float lo, float hi) { unsigned r; asm volatile("v_cvt_pk_bf16_f32 %0, %1, %2" : "=v"(r) : "v"(lo), "v"(hi)); return r; }


struct EpiBf16Sel {
    static constexpr bool PERM = true, AFTER_DRAIN = false, DUP = (DUP_EPI & 4) != 0;
    bf16_t* o0; bf16_t* o1; int ld0, ld1;
    __device__ __forceinline__ void operator()(const f32x4 (&acc)[2][2][4][2], const Unit& u, int wr, int wc, int fr, int fq) const {
        bf16_t* base = u.a0 == 0 ? o0 : o1; const int ldc = u.a0 == 0 ? ld0 : ld1;
        const int row0 = u.lm * BM + wr * 64 + fr, col0 = u.ln * BM + wc * 32 + 8 * fq;
#pragma unroll
        for (int ai = 0; ai < 2; ++ai)
#pragma unroll
            for (int m = 0; m < 4; ++m) { bf16_t* rowp = base + (size_t)(row0 + ai * HALF + m * 16) * ldc + col0;
#pragma unroll
                for (int bj = 0; bj < 2; ++bj) { const f32x4 v0 = acc[ai][bj][m][0], v1 = acc[ai][bj][m][1];
                    u32x4 w; w.x = cvt_pk_bf16(v0[0], v0[1]); w.y = cvt_pk_bf16(v0[2], v0[3]); w.z = cvt_pk_bf16(v1[0], v1[1]); w.w = cvt_pk_bf16(v1[2], v1[3]);
                    *(u32x4*)(rowp + bj * HALF) = w; } }
    }
};
struct EpiResBf16 {
    static constexpr bool PERM = true, AFTER_DRAIN = false, DUP = (DUP_EPI & 8) != 0;
    const bf16_t* h; bf16_t* pre; float alpha;
    __device__ __forceinline__ void operator()(const f32x4 (&acc)[2][2][4][2], const Unit& u, int wr, int wc, int fr, int fq) const {
        const int row0 = u.lm * BM + wr * 64 + fr, col0 = u.ln * BM + wc * 32 + 8 * fq;
#pragma unroll
        for (int ai = 0; ai < 2; ++ai)
#pragma unroll
            for (int m = 0; m < 4; ++m) { const size_t off = (size_t)(row0 + ai * HALF + m * 16) * 1024 + col0;
#pragma unroll
                for (int bj = 0; bj < 2; ++bj) { const u32x4 hv = *(const u32x4*)(h + off + bj * HALF); const f32x4 a0 = acc[ai][bj][m][0], a1 = acc[ai][bj][m][1];
                    u32x4 w;
                    w.x = cvt_pk_bf16(__builtin_bit_cast(float, hv.x << 16) * alpha + a0[0], __builtin_bit_cast(float, hv.x & 0xffff0000u) * alpha + a0[1]);
                    w.y = cvt_pk_bf16(__builtin_bit_cast(float, hv.y << 16) * alpha + a0[2], __builtin_bit_cast(float, hv.y & 0xffff0000u) * alpha + a0[3]);
                    w.z = cvt_pk_bf16(__builtin_bit_cast(float, hv.z << 16) * alpha + a1[0], __builtin_bit_cast(float, hv.z & 0xffff0000u) * alpha + a1[1]);
                    w.w = cvt_pk_bf16(__builtin_bit_cast(float, hv.w << 16) * alpha + a1[2], __builtin_bit_cast(float, hv.w & 0xffff0000u) * alpha + a1[3]);
                    *(u32x4*)(pre + off + bj * HALF) = w; }
                asm volatile("" ::: "memory"); }
    }
};
struct EpiSwiglu {
    static constexpr bool PERM = true, AFTER_DRAIN = false, DUP = (DUP_EPI & 1) != 0;
    unsigned char* act; const float* b1;
    __device__ __forceinline__ void operator()(const f32x4 (&acc)[2][2][4][2], const Unit& u, int wr, int wc, int fr, int fq) const {
        const int row0 = u.lm * BM + wr * 64 + fr, lc0 = u.ln * HALF + wc * 32 + 8 * fq;
        const float* bb = b1 + (size_t)u.a0 * 2048 + lc0;
        const f32x4 bg0 = *(const f32x4*)(bb), bg1 = *(const f32x4*)(bb + 4), bl0 = *(const f32x4*)(bb + 1024), bl1 = *(const f32x4*)(bb + 1028);
        constexpr float DS = 1.0f / 512.0f;
#pragma unroll
        for (int ai = 0; ai < 2; ++ai)
#pragma unroll
            for (int m = 0; m < 4; ++m) {
                u32x2 w; unsigned* wp = (unsigned*)&w;
#pragma unroll
                for (int n = 0; n < 2; ++n) { const f32x4 g4 = acc[ai][0][m][n] * DS + (n ? bg1 : bg0), l4 = acc[ai][1][m][n] * DS + (n ? bl1 : bl0); float r4[4];
#pragma unroll
                    for (int j = 0; j < 4; ++j) { const float g = fminf(g4[j], 7.0f), li = fminf(fmaxf(l4[j], -7.0f), 7.0f);
                        const float sg = __builtin_amdgcn_rcpf(1.0f + __builtin_amdgcn_exp2f(g * (-1.702f * 1.4426950408889634f))); r4[j] = g * sg * (li + 1.0f) * 4.0f; }
                    wp[n] = cvt4_fp8(r4[0], r4[1], r4[2], r4[3]); }
                *(u32x2*)(act + (size_t)(row0 + ai * HALF + m * 16) * 1024 + lc0) = w; }
    }
};
struct EpiDown {
    static constexpr bool PERM = true, AFTER_DRAIN = false, DUP = (DUP_EPI & 2) != 0;
    unsigned char* ys; const float* b2;
    __device__ __forceinline__ void operator()(const f32x4 (&acc)[2][2][4][2], const Unit& u, int wr, int wc, int fr, int fq) const {
        const int row0 = u.lm * BM + wr * 64 + fr, col0 = u.ln * BM + wc * 32 + 8 * fq;
        f32x4 bv[2][2];
#pragma unroll
        for (int bj = 0; bj < 2; ++bj)
#pragma unroll
            for (int n = 0; n < 2; ++n) bv[bj][n] = *(const f32x4*)(b2 + (size_t)u.a0 * 1024 + col0 + bj * HALF + 4 * n) * 64.0f;
#pragma unroll
        for (int ai = 0; ai < 2; ++ai)
#pragma unroll
            for (int m = 0; m < 4; ++m) { unsigned char* rowp = ys + (size_t)(row0 + ai * HALF + m * 16) * 1024 + col0;
#pragma unroll
                for (int bj = 0; bj < 2; ++bj) { const f32x4 v0 = acc[ai][bj][m][0] * 0.25f + bv[bj][0], v1 = acc[ai][bj][m][1] * 0.25f + bv[bj][1];
                    u32x2 w; w.x = cvt4_fp8(v0[0], v0[1], v0[2], v0[3]); w.y = cvt4_fp8(v1[0], v1[1], v1[2], v1[3]);
                    *(u32x2*)(rowp + bj * HALF) = w; } }
    }
};

template <class Epi, class Sched, bool ALIGN_EPI = false, bool SP2 = false, bool FP8 = false>
__device__ __forceinline__ void gemm_phase(PG8_LAS unsigned char* lds, const Gemm g, const Sched& S, const Epi& E) {
    int tid_l = threadIdx.x; asm volatile("" : "+v"(tid_l));
    const int tid = tid_l, wid = __builtin_amdgcn_readfirstlane(tid >> 6), lane = tid & 63, wr = wid >> 2, wc = wid & 3, fr = lane & 15, fq = lane >> 4;
    const int RB = g.K * (FP8 ? 1 : 2), nt = RB / 128;
    unsigned voffA[2], voffB[2];
#pragma unroll
    for (int i = 0; i < 2; ++i) { int R, C; stage_rc(tid * 16 + i * 8192, R, C); const int Rb = Epi::PERM ? ((R & ~31) + perm32(R & 31)) : R;
        voffA[i] = (unsigned)(R * RB + C * 2); voffB[i] = (unsigned)(Rb * RB + C * 2); }
    const size_t kstep = (size_t)(BK * 2);
    const size_t hstep = (size_t)HALF * RB;
    const size_t tstep = 2 * hstep;
    const unsigned ldsw = (unsigned)wid * 1024u;
    const int aoff = lds_byte(wr * 64 + fr, fq * 8), boff = lds_byte(wc * 32 + fr, fq * 8);
#define PG8_SA(b, h) (((b) * 2 + (h)) * HTB)
#define PG8_SB(b, h) ((4 + (b) * 2 + (h)) * HTB)
#define PG8_STAGE(bufoff, gbase, voff) do { _Pragma("unroll") for (int _i = 0; _i < 2; ++_i) \
        __builtin_amdgcn_global_load_lds((const unsigned*)((const char*)(gbase) + (voff)[_i]), (PG8_LAS unsigned*)(lds + (bufoff) + ldsw + _i * 8192), 16, 0, 0); } while (0)
#define PG8_LDA(dst, b, h) do { _Pragma("unroll") for (int m = 0; m < 4; ++m) dst[m] = cat8(*(const PG8_LAS bf16x8*)(lds + PG8_SA(b, h) + aoff + m * 2048), *(const PG8_LAS bf16x8*)(lds + PG8_SA(b, h) + aoff + m * 2048 + 1024)); } while (0)
#define PG8_LDB(dst, b, h) do { _Pragma("unroll") for (int n = 0; n < 2; ++n) dst[n] = cat8(*(const PG8_LAS bf16x8*)(lds + PG8_SB(b, h) + boff + n * 2048), *(const PG8_LAS bf16x8*)(lds + PG8_SB(b, h) + boff + n * 2048 + 1024)); } while (0)
#define PG8_MMA(ai, bj, At, Bt) do { __builtin_amdgcn_s_setprio(1); _Pragma("unroll") for (int m = 0; m < 4; ++m) _Pragma("unroll") for (int n = 0; n < 2; ++n) { \
        if constexpr (FP8) mfma_fp8_acc(acc[ai][bj][m][n], Bt[n], At[m]); \
        else { _Pragma("unroll") for (int k = 0; k < 2; ++k) acc[ai][bj][m][n] = __builtin_amdgcn_mfma_f32_16x16x32_bf16(half8(Bt[n], k), half8(At[m], k), acc[ai][bj][m][n], 0, 0, 0); } } \
        __builtin_amdgcn_s_setprio(0); } while (0)
#define PG8_WAIT_V(n) asm volatile("s_waitcnt vmcnt(" #n ")" ::: "memory")
#define PG8_WAIT_L(n) asm volatile("s_waitcnt lgkmcnt(" #n ")" ::: "memory")
#define PG8_BAR __builtin_amdgcn_s_barrier()
#define PG8_SCHED __builtin_amdgcn_sched_barrier(0)
    Unit cur, nxt; int ui = 0;
    if (!S.next(0, cur)) return;
    f32x4 acc[2][2][4][2];
#pragma unroll
    for (int a = 0; a < 2; ++a)
#pragma unroll
        for (int b = 0; b < 2; ++b)
#pragma unroll
            for (int m = 0; m < 4; ++m)
#pragma unroll
                for (int n = 0; n < 2; ++n) acc[a][b][m][n] = (f32x4){0.f, 0.f, 0.f, 0.f};
    v8i At[4], B0[2], B1[2];
    const char* cA = (const char*)g.A + (size_t)cur.pm * tstep; const char* cB = (const char*)g.Bt + (size_t)cur.pn * tstep;
    S.a_ready(cur);
    if constexpr (SP2) {
        PG8_STAGE(PG8_SB(0, 0), cB, voffB); PG8_STAGE(PG8_SB(0, 1), cB + hstep, voffB); PG8_STAGE(PG8_SA(0, 0), cA, voffA); PG8_STAGE(PG8_SA(0, 1), cA + hstep, voffA);
        if (wr == 1) PG8_BAR;
        PG8_WAIT_V(2); PG8_BAR;
        PG8_STAGE(PG8_SB(1, 0), cB + kstep, voffB); PG8_STAGE(PG8_SA(1, 0), cA + kstep, voffA); PG8_STAGE(PG8_SB(1, 1), cB + hstep + kstep, voffB);
        PG8_WAIT_V(6); PG8_BAR;
    } else {
        PG8_STAGE(PG8_SB(0, 0), cB, voffB); PG8_STAGE(PG8_SA(0, 0), cA, voffA); PG8_STAGE(PG8_SB(0, 1), cB + hstep, voffB); PG8_STAGE(PG8_SA(0, 1), cA + hstep, voffA);
        if (wr == 1) PG8_BAR;
        PG8_WAIT_V(4); PG8_BAR;
        PG8_STAGE(PG8_SB(1, 0), cB + kstep, voffB); PG8_STAGE(PG8_SA(1, 0), cA + kstep, voffA); PG8_STAGE(PG8_SB(1, 1), cB + hstep + kstep, voffB);
        PG8_WAIT_V(6); PG8_BAR;
    }
    for (;;) {
        const bool has_next = S.next(ui + 1, nxt);
        const char* nA = has_next ? (const char*)g.A + (size_t)nxt.pm * tstep : cA; const char* nB = has_next ? (const char*)g.Bt + (size_t)nxt.pn * tstep : cB;
#pragma nounroll
        for (int t = 0; t < nt; t += 2) {
            const bool last = (t == nt - 2);
            const char* a1 = cA + (size_t)(t + 1) * kstep;
            const char* a2 = last ? nA : cA + (size_t)(t + 2) * kstep; const char* b2 = last ? nB : cB + (size_t)(t + 2) * kstep;
            const char* a3 = a2 + kstep; const char* b3 = b2 + kstep;
            if (last && has_next) S.a_ready(nxt);
            if constexpr (SP2) {
            PG8_LDB(B0, 0, 0); PG8_LDB(B1, 0, 1); PG8_SCHED; PG8_LDA(At, 0, 0); PG8_STAGE(PG8_SA(1, 1), a1 + hstep, voffA);
            PG8_WAIT_V(8); PG8_WAIT_L(0); PG8_BAR; PG8_MMA(0, 0, At, B0); PG8_MMA(0, 1, At, B1); PG8_BAR; PG8_SCHED;
            PG8_LDA(At, 0, 1); PG8_STAGE(PG8_SB(0, 0), b2, voffB); PG8_STAGE(PG8_SB(0, 1), b2 + hstep, voffB); PG8_STAGE(PG8_SA(0, 0), a2, voffA);
            PG8_WAIT_V(8); PG8_WAIT_L(0); PG8_BAR; PG8_MMA(1, 0, At, B0); PG8_MMA(1, 1, At, B1); PG8_BAR; PG8_SCHED;
            PG8_LDB(B0, 1, 0); PG8_LDB(B1, 1, 1); PG8_SCHED; PG8_LDA(At, 1, 0); PG8_STAGE(PG8_SA(0, 1), a2 + hstep, voffA);
            PG8_WAIT_V(8); PG8_WAIT_L(0); PG8_BAR; PG8_MMA(0, 0, At, B0); PG8_MMA(0, 1, At, B1); PG8_BAR; PG8_SCHED;
            PG8_LDA(At, 1, 1); PG8_STAGE(PG8_SB(1, 0), b3, voffB); PG8_STAGE(PG8_SB(1, 1), b3 + hstep, voffB); PG8_STAGE(PG8_SA(1, 0), a3, voffA);
            PG8_WAIT_V(8); PG8_WAIT_L(0); PG8_BAR; PG8_MMA(1, 0, At, B0); PG8_MMA(1, 1, At, B1); PG8_BAR; PG8_SCHED;
            } else {
            PG8_LDB(B0, 0, 0); PG8_SCHED; PG8_LDA(At, 0, 0); PG8_STAGE(PG8_SA(1, 1), a1 + hstep, voffA);
            PG8_WAIT_L(8); PG8_BAR; PG8_WAIT_L(0); PG8_MMA(0, 0, At, B0); PG8_BAR; PG8_SCHED;
            PG8_LDB(B1, 0, 1); PG8_STAGE(PG8_SB(0, 0), b2, voffB);
            PG8_BAR; PG8_WAIT_L(0); PG8_MMA(0, 1, At, B1); PG8_BAR;
            PG8_LDA(At, 0, 1); PG8_STAGE(PG8_SA(0, 0), a2, voffA);
            PG8_BAR; PG8_WAIT_L(0); PG8_MMA(1, 0, At, B0); PG8_BAR; PG8_SCHED;
            PG8_STAGE(PG8_SB(0, 1), b2 + hstep, voffB);
            PG8_WAIT_V(6); PG8_BAR; PG8_MMA(1, 1, At, B1); PG8_BAR;
            PG8_LDB(B0, 1, 0); PG8_SCHED; PG8_LDA(At, 1, 0); PG8_STAGE(PG8_SA(0, 1), a2 + hstep, voffA);
            PG8_WAIT_L(8); PG8_BAR; PG8_WAIT_L(0); PG8_MMA(0, 0, At, B0); PG8_BAR; PG8_SCHED;
            PG8_LDB(B1, 1, 1); PG8_STAGE(PG8_SB(1, 0), b3, voffB);
            PG8_BAR; PG8_WAIT_L(0); PG8_MMA(0, 1, At, B1); PG8_BAR;
            PG8_LDA(At, 1, 1); PG8_STAGE(PG8_SA(1, 0), a3, voffA);
            PG8_BAR; PG8_WAIT_L(0); PG8_MMA(1, 0, At, B0); PG8_BAR; PG8_SCHED;
            PG8_STAGE(PG8_SB(1, 1), b3 + hstep, voffB);
            PG8_WAIT_V(6); PG8_BAR; PG8_MMA(1, 1, At, B1); PG8_BAR;
            }
        }
        if constexpr (ALIGN_EPI) { if (wr == 0) PG8_BAR; }
        if constexpr (FP8) asm volatile("s_nop 15\n\ts_nop 15" ::: "memory");
        if constexpr (!Epi::AFTER_DRAIN) { E(acc, cur, wr, wc, fr, fq); if constexpr (Epi::DUP) { asm volatile("" ::: "memory"); E(acc, cur, wr, wc, fr, fq); } S.done(cur); }
        if (!has_next) break;
#pragma unroll
        for (int a = 0; a < 2; ++a)
#pragma unroll
            for (int b = 0; b < 2; ++b)
#pragma unroll
                for (int m = 0; m < 4; ++m)
#pragma unroll
                    for (int n = 0; n < 2; ++n) acc[a][b][m][n] = (f32x4){0.f, 0.f, 0.f, 0.f};
        cur = nxt; cA = nA; cB = nB; ++ui;
        if constexpr (ALIGN_EPI) { if (wr == 1) PG8_BAR; }
    }
    PG8_WAIT_V(0);
    if constexpr (!ALIGN_EPI) { if (wr == 0) PG8_BAR; }
    PG8_BAR;
    if constexpr (Epi::AFTER_DRAIN) { E.fused(acc, cur, wr, wc, fr, fq, lds, wid, lane); S.done(cur); }
#undef PG8_SA
#undef PG8_SB
#undef PG8_STAGE
#undef PG8_LDA
#undef PG8_LDB
#undef PG8_MMA
#undef PG8_WAIT_V
#undef PG8_WAIT_L
#undef PG8_BAR
#undef PG8_SCHED
}
}

#define GAS __attribute__((address_space(1)))
#define LAS __attribute__((address_space(3)))
typedef unsigned short bf16;
typedef unsigned v4u __attribute__((ext_vector_type(4)));
typedef unsigned v2u __attribute__((ext_vector_type(2)));
typedef float f32x4 __attribute__((ext_vector_type(4)));
typedef short bf16x8 __attribute__((ext_vector_type(8)));
typedef GAS unsigned gu32;
typedef GAS unsigned long long gu64;
#define RLX_AGENT __ATOMIC_RELAXED, __HIP_MEMORY_SCOPE_AGENT
#define LDS_WAIT() asm volatile("s_waitcnt lgkmcnt(0)" ::: "memory")
#define VM_WAIT() asm volatile("s_waitcnt vmcnt(0)" ::: "memory")
__device__ __forceinline__ unsigned long long rt() { return __builtin_amdgcn_s_memrealtime(); }
__device__ __forceinline__ unsigned f2bf(float f) { unsigned u = __builtin_bit_cast(unsigned, f); return (u + 0x7fffu + ((u >> 16) & 1u)) >> 16; }
__device__ __forceinline__ unsigned pk2(float lo, float hi) { return f2bf(lo) | (f2bf(hi) << 16); }

#define XB_TMO      128
#define XB_XCNT(j)  (256  + 64 * (j))
#define XB_XSUB(j)  (1280 + 64 * (j))
#define XB_XGEN(j)  (2304 + 64 * (j))
#define XB_TOP      3328
#define XB_TOPGEN   3392
#define XCD_BAR_WORDS 3456
#define XB_SPIN_CAP (1u << 18)

__device__ __forceinline__ unsigned xb_ld(unsigned* p)              { return __hip_atomic_load(p, __ATOMIC_RELAXED, __HIP_MEMORY_SCOPE_AGENT); }
__device__ __forceinline__ unsigned xb_add(unsigned* p, unsigned v) { return __hip_atomic_fetch_add(p, v, __ATOMIC_RELAXED, __HIP_MEMORY_SCOPE_AGENT); }
__device__ __forceinline__ unsigned xb_xcc_id() { return (unsigned)__builtin_amdgcn_s_getreg((3 << 11) | 20) & 0xFu; }
#define XB_SPIN(cond, bar) do { unsigned _sp = 0; while (cond) { __builtin_amdgcn_s_sleep(1); \
    if ((++_sp & 255u) == 0u) { if (xb_ld(&(bar)[XB_TMO])) break; if (_sp > XB_SPIN_CAP) { atomicAdd(&(bar)[XB_TMO], 1u); break; } } } } while (0)

struct XcdBarrier {
    unsigned* bar; unsigned x;
    volatile LAS unsigned* st;
};

__device__ __forceinline__ XcdBarrier xcd_barrier_post(unsigned* bar, volatile LAS unsigned* st) {
    XcdBarrier b; b.bar = bar; b.x = xb_xcc_id(); b.st = st;
    if (threadIdx.x == 0) (void)xb_add(&bar[XB_XCNT(b.x)], 1u);
    return b;
}
__device__ __forceinline__ void xcd_barrier_complete(unsigned* bar, unsigned x, unsigned& nloc, unsigned& nx) {
    const unsigned G = gridDim.x * gridDim.y * gridDim.z;
    unsigned sum, cnt, mine, sp = 0u;
    for (;;) {
        sum = 0u; cnt = 0u; mine = 0u;
#pragma unroll
        for (unsigned j = 0; j < 16; ++j) { const unsigned c = xb_ld(&bar[XB_XCNT(j)]); sum += c; cnt += (c > 0u) ? 1u : 0u; mine = (j == x) ? c : mine; }
        if (sum == G) break;
        __builtin_amdgcn_s_sleep(1);
        if ((++sp & 255u) == 0u) { if (xb_ld(&bar[XB_TMO])) break; if (sp > XB_SPIN_CAP) { atomicAdd(&bar[XB_TMO], 1u); break; } }
    }
    nloc = mine > 0u ? mine : 1u; nx = cnt > 0u ? cnt : 1u;
}

__device__ __forceinline__ void xcd_barrier(const XcdBarrier& b) {
    asm volatile("s_waitcnt vmcnt(0)" ::: "memory");
    __syncthreads();
    if (threadIdx.x == 0) {
        unsigned* bar = b.bar;
        __builtin_amdgcn_s_waitcnt(0);
        unsigned nloc = b.st[0], nx = b.st[1];
        if (nloc == 0u) { xcd_barrier_complete(bar, b.x, nloc, nx); b.st[0] = nloc; b.st[1] = nx; }
        const unsigned old = xb_add(&bar[XB_XSUB(b.x)], 1u);
        const unsigned gen = old / nloc;
        if (old + 1u == (gen + 1u) * nloc) {
            __builtin_amdgcn_fence(__ATOMIC_RELEASE, "agent");
            asm volatile("s_waitcnt vmcnt(0)" ::: "memory");
            const unsigned og = xb_add(&bar[XB_TOP], 1u);
            const unsigned tg = og / nx;
            if (og + 1u == (tg + 1u) * nx) xb_add(&bar[XB_TOPGEN], 1u);
            else XB_SPIN(xb_ld(&bar[XB_TOPGEN]) == tg, bar);
            __builtin_amdgcn_fence(__ATOMIC_ACQUIRE, "agent");
            xb_add(&bar[XB_XGEN(b.x)], 1u);
            asm volatile("s_waitcnt vmcnt(0)" ::: "memory");
        } else {
            XB_SPIN(xb_ld(&bar[XB_XGEN(b.x)]) == gen, bar);
            __builtin_amdgcn_fence(__ATOMIC_ACQUIRE, "agent");
            asm volatile("s_waitcnt vmcnt(0)" ::: "memory");
        }
    }
    __syncthreads();
}


constexpr int NWAVES = 8;
constexpr int NTOK = 32768, D = 1024, NPROJ = 1792, NLAYER = 4, NEXP = 32, SEQ = 2048, NBATCH = 16, NMEM = 256;
constexpr float LN_EPS = 1e-5f, RMS_EPS = 1e-6f;
constexpr float DN_ALPHA = 1.6817928305074292f;
constexpr int XP_TILES = NTOK * 4 / 256 + NEXP;

constexpr size_t MiB = 1u << 20, TILE = 512 * 1024;
constexpr size_t WS_CTL = 0, CTL_ZERO_BYTES = 1 * MiB;
constexpr size_t WS_WMB = 1 * MiB;
constexpr size_t WS_POOLT = WS_WMB + 512 * 1024;
constexpr size_t WS_WRT = WS_POOLT + 128 * 1024;
constexpr int T_WIN = 4, T_WOUT = T_WIN + 28, T_WKV = T_WOUT + 16, T_MEMN = T_WKV + 8, T_HB = T_MEMN + 16, T_G = T_HB + 128, T_END = T_G + 128;
constexpr size_t QT = 256 * 1024;
constexpr size_t WS_W18 = (size_t)T_END * TILE;
constexpr size_t WS_W28 = WS_W18 + 256 * MiB;
constexpr size_t WS_H8 = WS_W28 + 128 * MiB;
constexpr size_t WS_XP8 = WS_H8 + 32 * MiB;
constexpr size_t WS_ACT8 = WS_XP8 + (size_t)XP_TILES * QT;
constexpr size_t WS_YS8 = WS_ACT8 + (size_t)XP_TILES * QT;
constexpr size_t WS_P = WS_YS8 + (size_t)XP_TILES * QT;
#define Q8(off) ((int)((off) / QT))
constexpr size_t WS_PRE = WS_P + 112 * MiB;
constexpr size_t WS_KB = WS_PRE + 64 * MiB;
constexpr size_t WS_VT = WS_KB + 8 * MiB;
constexpr size_t WS_TOKES = WS_VT + 8 * MiB;
constexpr size_t WS_TOKG = WS_TOKES + 512 * 1024;
constexpr size_t WS_ROWIDX = WS_TOKG + 512 * 1024;
constexpr size_t WS_NV_VN = WS_ROWIDX + 512 * 1024;
constexpr size_t WS_NV_DP = WS_NV_VN + 32 * MiB;
constexpr size_t WS_NV_Y = WS_NV_DP + 32 * MiB;
constexpr size_t WS_END = WS_NV_Y + 128 * MiB;
constexpr int CW_TMO = 0, CW_CODE = 1;
constexpr int CW_BAR = 4096;
constexpr int CW_CNT = 16384;
static_assert((CW_CNT + NLAYER * NEXP * 16) * 4 <= (int)CTL_ZERO_BYTES, "CTL words inside the memset region");
constexpr int RING_OFF = 0, RING_BYTES = 131072;
constexpr int LDSCTL_OFF = 147456 - 1024, MISC_OFF = LDSCTL_OFF + 320, TOFF_OFF = MISC_OFF + 128;
constexpr int LDS_BYTES = 147456;
static_assert(TOFF_OFF + 160 <= LDS_BYTES, "LDS map");

__device__ __forceinline__ float bf2f(unsigned short b) { return __builtin_bit_cast(float, (unsigned)b << 16); }
__device__ __forceinline__ float wave_sum(float v) {
#pragma unroll
    for (int o = 1; o < 64; o <<= 1) v += __shfl_xor(v, o);
    return v;
}
__device__ __forceinline__ float gelu_tanh(float x) {
    const float u = 0.7978845608028654f * (x + 0.044715f * x * x * x);
    return x * __builtin_amdgcn_rcpf(1.0f + __builtin_amdgcn_exp2f(u * (-2.0f * 1.4426950408889634f)));
}

struct Frame {
    LAS unsigned char* lds;
    volatile LAS unsigned* MISC;
    gu32* ctl;
    unsigned char* ws;
    int tid, lane, wave, G;
    float* out;
};
struct Args { const float* in[27]; float* out; unsigned char* ws; int ph_lo, ph_hi; };
enum { I_X = 0, I_MEM, I_LN_IN_G, I_LN_IN_B, I_MEM_LN_G, I_MEM_LN_B, I_W_IN, I_CONV_W, I_POOL_W, I_POOL_SCALE, I_GMLP_LN_G, I_GMLP_LN_B, I_GMLP_W, I_GMLP_B, I_W_MEM_KV, I_GROUP_NORM_G, I_W_OUT,
       I_LN1_G, I_LN1_B, I_W_ROUTER, I_B_ROUTER, I_W1, I_B1, I_W2, I_B2, I_LN2_G, I_LN2_B };
#define RELANE(F) do { int t_ = threadIdx.x; asm volatile("" : "+v"(t_)); (F).tid = t_; (F).lane = t_ & 63; (F).wave = __builtin_amdgcn_readfirstlane(t_ >> 6); } while (0)
#define WSP(T, off) ((T*)(F.ws + (off)))
#define TILEP(t) ((bf16*)(F.ws + (size_t)(t) * TILE))

__device__ __forceinline__ void tr64(const float* W, int ldw, int k0, int n0, bf16* WT, int ldt, int drow0, LAS float* scr, int lane) {
    const int c4 = 4 * (lane & 15), kq = lane >> 4;
#pragma unroll
    for (int i = 0; i < 16; ++i) { const int kk = 4 * i + kq; const f32x4 v = *(const f32x4*)(W + (size_t)(k0 + kk) * ldw + n0 + c4);
        LAS float* s = scr + kk * 65 + c4; s[0] = v.x; s[1] = v.y; s[2] = v.z; s[3] = v.w; }
    LDS_WAIT(); asm volatile("" ::: "memory");
    const int ck = lane & 7;
#pragma unroll
    for (int j = 0; j < 8; ++j) { const int n = (lane >> 3) + 8 * j; const LAS float* s = scr + (8 * ck) * 65 + n;
        v4u o; o.x = pk2(s[0 * 65], s[1 * 65]); o.y = pk2(s[2 * 65], s[3 * 65]); o.z = pk2(s[4 * 65], s[5 * 65]); o.w = pk2(s[6 * 65], s[7 * 65]);
        *(v4u*)(WT + (size_t)(drow0 + n) * ldt + k0 + 8 * ck) = o; }
    LDS_WAIT(); asm volatile("" ::: "memory");
}
__device__ __forceinline__ void tr64_fp8(const float* W, int ldw, int k0, int n0, unsigned char* WT, int drow0, float scale, LAS float* scr, int lane) {
    const int c4 = 4 * (lane & 15), kq = lane >> 4;
#pragma unroll
    for (int i = 0; i < 16; ++i) { const int kk = 4 * i + kq; const f32x4 v = *(const f32x4*)(W + (size_t)(k0 + kk) * ldw + n0 + c4);
        LAS float* s = scr + kk * 65 + c4; s[0] = v.x; s[1] = v.y; s[2] = v.z; s[3] = v.w; }
    LDS_WAIT(); asm volatile("" ::: "memory");
    const int ck = lane & 7;
#pragma unroll
    for (int j = 0; j < 8; ++j) { const int n = (lane >> 3) + 8 * j; const LAS float* s = scr + (8 * ck) * 65 + n;
        v2u o; o.x = pg8::cvt4_fp8(s[0 * 65] * scale, s[1 * 65] * scale, s[2 * 65] * scale, s[3 * 65] * scale); o.y = pg8::cvt4_fp8(s[4 * 65] * scale, s[5 * 65] * scale, s[6 * 65] * scale, s[7 * 65] * scale);
        *(v2u*)(WT + (size_t)(drow0 + n) * 1024 + k0 + 8 * ck) = o; }
    LDS_WAIT(); asm volatile("" ::: "memory");
}
#define BAR_LDS() do { asm volatile("s_waitcnt lgkmcnt(0)" ::: "memory"); __builtin_amdgcn_s_barrier(); asm volatile("" ::: "memory"); } while (0)
__device__ __forceinline__ f32x4 bf2lo(const v4u r) { f32x4 o; o.x = __builtin_bit_cast(float, r.x << 16); o.y = __builtin_bit_cast(float, r.x & 0xffff0000u); o.z = __builtin_bit_cast(float, r.y << 16); o.w = __builtin_bit_cast(float, r.y & 0xffff0000u); return o; }
__device__ __forceinline__ f32x4 bf2hi(const v4u r) { f32x4 o; o.x = __builtin_bit_cast(float, r.z << 16); o.y = __builtin_bit_cast(float, r.z & 0xffff0000u); o.z = __builtin_bit_cast(float, r.w << 16); o.w = __builtin_bit_cast(float, r.w & 0xffff0000u); return o; }
__device__ __forceinline__ v4u pack8(const f32x4 a, const f32x4 b) { v4u o; o.x = pg8::cvt_pk_bf16(a.x, a.y); o.y = pg8::cvt_pk_bf16(a.z, a.w); o.z = pg8::cvt_pk_bf16(b.x, b.y); o.w = pg8::cvt_pk_bf16(b.z, b.w); return o; }
struct LnPar { f32x4 g[4], b[4]; };
__device__ __forceinline__ void ln_load(LnPar& p, const float* gam, const float* bet, int lane) {
#pragma unroll
    for (int j = 0; j < 4; ++j) { const int o = 8 * lane + 512 * (j >> 1) + 4 * (j & 1); p.g[j] = *(const f32x4*)(gam + o); p.b[j] = *(const f32x4*)(bet + o); }
}
__device__ __forceinline__ void ln_affine(f32x4 (&v)[4], const LnPar& p) {
    float s = 0.f;
#pragma unroll
    for (int j = 0; j < 4; ++j) s += (v[j].x + v[j].y) + (v[j].z + v[j].w);
    const float mean = wave_sum(s) * (1.f / 1024.f); float s2 = 0.f;
#pragma unroll
    for (int j = 0; j < 4; ++j) { v[j] = v[j] - mean; s2 += (v[j].x * v[j].x + v[j].y * v[j].y) + (v[j].z * v[j].z + v[j].w * v[j].w); }
    const float rstd = 1.f / sqrtf(wave_sum(s2) * (1.f / 1024.f) + LN_EPS);
#pragma unroll
    for (int j = 0; j < 4; ++j) v[j] = v[j] * rstd * p.g[j] + p.b[j];
}
__device__ __forceinline__ void p0_prologue(Frame& F, const Args& A) {
    RELANE(F);
    LAS float* scr = (LAS float*)(F.lds + RING_OFF + F.wave * 16640);
    const int gw = blockIdx.x * NWAVES + F.wave, NGW = F.G * NWAVES;
    constexpr int NI_W1 = NLAYER * NEXP * 16 * 32, NI_W2 = NLAYER * NEXP * 16 * 16, NI_WIN = NLAYER * 16 * 28, NI_WOUT = NLAYER * 16 * 16, NI_WKV = NLAYER * 16 * 8, NI_POOL = NLAYER * 4;
    constexpr int NITEMS = NI_W1 + NI_W2 + NI_WIN + NI_WOUT + NI_WKV + NI_POOL;
    for (int it = gw; it < NITEMS; it += NGW) {
        int r = it;
        if (r < NI_W1) { const int le = r >> 9, rr = r & 511, kb = rr >> 5, nb = rr & 31; const int n0 = 64 * nb, nn = n0 & 1023;
            const int drow = (nn >> 7) * 256 + (n0 >= 1024 ? 128 : 0) + (nn & 127);
            tr64_fp8(A.in[I_W1] + (size_t)le * 1024 * 2048, 2048, 64 * kb, n0, F.ws + WS_W18 + (size_t)le * 2048 * 1024, drow, 32.0f, scr, F.lane); continue; } r -= NI_W1;
        if (r < NI_W2) { const int le = r >> 8, rr = r & 255, kb = rr >> 4, nb = rr & 15;
            tr64_fp8(A.in[I_W2] + (size_t)le * 1024 * 1024, 1024, 64 * kb, 64 * nb, F.ws + WS_W28 + (size_t)le * 1024 * 1024, 64 * nb, 64.0f, scr, F.lane); continue; } r -= NI_W2;
        if (r < NI_WIN) { const int l = r / 448, rr = r % 448, kb = rr / 28, nb = rr % 28;
            tr64(A.in[I_W_IN] + (size_t)l * 1024 * NPROJ, NPROJ, 64 * kb, 64 * nb, TILEP(T_WIN) + (size_t)l * NPROJ * 1024, 1024, 64 * nb, scr, F.lane); continue; } r -= NI_WIN;
        if (r < NI_WOUT) { const int l = r >> 8, rr = r & 255, kb = rr >> 4, nb = rr & 15;
            tr64(A.in[I_W_OUT] + (size_t)l * 1024 * 1024, 1024, 64 * kb, 64 * nb, TILEP(T_WOUT) + (size_t)l * 1024 * 1024, 1024, 64 * nb, scr, F.lane); continue; } r -= NI_WOUT;
        if (r < NI_WKV) { const int l = r >> 7, rr = r & 127, kb = rr >> 3, nb = rr & 7;
            tr64(A.in[I_W_MEM_KV] + (size_t)l * 1024 * 512, 512, 64 * kb, 64 * nb, TILEP(T_WKV) + (size_t)l * 512 * 1024, 1024, 64 * nb, scr, F.lane); continue; } r -= NI_WKV;
        tr64(A.in[I_POOL_W] + (size_t)r * 64 * 64, 64, 0, 0, WSP(bf16, WS_POOLT) + (size_t)r * 64 * 64, 64, 0, scr, F.lane);
    }
    const int gt = blockIdx.x * (NWAVES * 64) + F.tid, NGT = F.G * NWAVES * 64;
    for (int i = gt; i < NLAYER * 4 * 128 * 128; i += NGT) { const int j = i & 127, ii = (i >> 7) & 127; WSP(bf16, WS_WMB)[i] = (bf16)(((j >> 6) <= (ii >> 6)) ? f2bf(A.in[I_GMLP_W][i]) : 0u); }
    for (int i = gt; i < NLAYER * 32 * 1024; i += NGT) { const int k = i & 1023, e = (i >> 10) & 31, l = i >> 15; WSP(bf16, WS_WRT)[i] = (bf16)f2bf(A.in[I_W_ROUTER][((size_t)l * 1024 + k) * 32 + e]); }
    LnPar px, pm; ln_load(px, A.in[I_LN_IN_G], A.in[I_LN_IN_B], F.lane); ln_load(pm, A.in[I_MEM_LN_G], A.in[I_MEM_LN_B], F.lane);
    for (int m = gw; m < NTOK + NBATCH * NMEM; m += NGW) {
        const bool ismem = m >= NTOK; const int row = ismem ? m - NTOK : m;
        const float* src = (ismem ? A.in[I_MEM] : A.in[I_X]) + (size_t)row * D + 8 * F.lane;
        f32x4 v[4]; v[0] = *(const f32x4*)(src); v[1] = *(const f32x4*)(src + 4); v[2] = *(const f32x4*)(src + 512); v[3] = *(const f32x4*)(src + 516);
        if (ismem) ln_affine(v, pm); else ln_affine(v, px);
        bf16* dst = (ismem ? TILEP(T_MEMN) : TILEP(T_HB)) + (size_t)row * D + 8 * F.lane;
        *(v4u*)dst = pack8(v[0], v[1]); *(v4u*)(dst + 512) = pack8(v[2], v[3]);
    }
}

struct DenseOrder {
    int nM, nN, G, c, a_t0, b_t0;
    __device__ __forceinline__ bool next(int i, pg8::Unit& u) const {
        const long L = (long)i * G + c; if (L >= (long)nM * nN) return false;
        int tm, tn; pg8::tile_of((int)L, nM, nN, tm, tn); u.pm = a_t0 + tm; u.pn = b_t0 + tn; u.lm = tm; u.ln = tn; u.a0 = 0; return true;
    }
    __device__ __forceinline__ void a_ready(const pg8::Unit&) const {}
    __device__ __forceinline__ void done(const pg8::Unit&) const {}
};
struct KvOrder {
    int G, c;
    __device__ __forceinline__ bool next(int i, pg8::Unit& u) const {
        const int L = i * G + c; if (L >= NLAYER * 32) return false;
        const int l = L >> 5, r = L & 31;
        if (r < 16) { u.pm = T_MEMN + r; u.pn = T_WKV + 2 * l; u.lm = l * 16 + r; u.ln = 0; u.a0 = 0; }
        else { u.pm = T_WKV + 2 * l + 1; u.pn = T_MEMN + (r - 16); u.lm = l; u.ln = r - 16; u.a0 = 1; }
        return true;
    }
    __device__ __forceinline__ void a_ready(const pg8::Unit&) const {}
    __device__ __forceinline__ void done(const pg8::Unit&) const {}
};
struct MoeOrder {
    int TM, NTN, G, c, a_t0, b_t0; const LAS int* toff;
    __device__ __forceinline__ bool next(int i, pg8::Unit& u) const {
        const long L = (long)i * G + c; if (L >= (long)TM * NTN) return false;
        int tm, tn; pg8::tile_of((int)L, TM, NTN, tm, tn);
        int e = 0;
#pragma unroll
        for (int j = 1; j < NEXP; ++j) e += (toff[j] <= tm) ? 1 : 0;
        e = __builtin_amdgcn_readfirstlane(e);
        u.pm = a_t0 + tm; u.pn = b_t0 + e * NTN + tn; u.lm = tm; u.ln = tn; u.a0 = e; return true;
    }
    __device__ __forceinline__ void a_ready(const pg8::Unit&) const {}
    __device__ __forceinline__ void done(const pg8::Unit&) const {}
};
__device__ __forceinline__ void compute_toff(Frame& F, int l) {
    RELANE(F);
    LAS int* toff = (LAS int*)(F.lds + TOFF_OFF);
    __syncthreads();
    if (F.wave == 0) {
        int t = 0;
        if (F.lane < NEXP) { const unsigned c = __hip_atomic_load(F.ctl + CW_CNT + (l * NEXP + F.lane) * 16, RLX_AGENT); t = (int)((c + 255u) >> 8); }
        int incl = t;
#pragma unroll
        for (int o = 1; o < 32; o <<= 1) { const int y = __shfl_up(incl, o); if ((F.lane & 31) >= o) incl += y; }
        if (F.lane < NEXP) toff[F.lane + 1] = incl;
        if (F.lane == 0) toff[0] = 0;
    }
    __syncthreads();
}

__device__ __forceinline__ void pd_phase(Frame& F, const Args& A, int l) {
    RELANE(F);
    LAS float* lgam = (LAS float*)(F.lds);
    LAS float* lbet = lgam + 1024;
    LAS int* cntl = (LAS int*)(F.lds + 8192);
    LAS int* basel = cntl + 32;
    LAS int* sel_e = basel + 32;
    LAS int* sel_r = sel_e + 512; LAS float* sel_g = (LAS float*)(sel_r + 512);
    const bf16* wr = WSP(bf16, WS_WRT) + (size_t)l * NEXP * D; const float* br = A.in[I_B_ROUTER] + l * NEXP;
    const bf16* pre = WSP(bf16, WS_PRE); bf16* hb = TILEP(T_HB); unsigned char* h8 = F.ws + WS_H8;
    const int m = F.lane & 15, g = F.lane >> 4;
    for (int i = F.tid; i < D; i += NWAVES * 64) { lgam[i] = A.in[I_LN1_G][l * D + i]; lbet[i] = A.in[I_LN1_B][l * D + i]; }
    const float br0 = br[m], br1 = br[16 + m];
    for (int blk = blockIdx.x; blk < NTOK / 128; blk += F.G) {
        if (F.tid < NEXP) cntl[F.tid] = 0;
        const size_t row = (size_t)blk * 128 + F.wave * 16 + m;
        const bf16* prow = pre + row * D + 16 * g;
        v4u raw[16][2];
#pragma unroll
        for (int j = 0; j < 16; ++j) { raw[j][0] = *(const v4u*)(prow + 64 * j); raw[j][1] = *(const v4u*)(prow + 64 * j + 8); }
        BAR_LDS();
        float s = 0.f;
#pragma unroll
        for (int j = 0; j < 16; ++j)
#pragma unroll
            for (int hf = 0; hf < 2; ++hf) { const f32x4 a = bf2lo(raw[j][hf]), b = bf2hi(raw[j][hf]); s += ((a.x + a.y) + (a.z + a.w)) + ((b.x + b.y) + (b.z + b.w)); }
#pragma unroll
        for (int j = 0; j < 16; ++j) asm volatile("" : "+v"(raw[j][0]), "+v"(raw[j][1]));
        s += __shfl_xor(s, 16); s += __shfl_xor(s, 32);
        const float mean = s * (1.f / 1024.f); float s2 = 0.f;
#pragma unroll
        for (int j = 0; j < 16; ++j)
#pragma unroll
            for (int hf = 0; hf < 2; ++hf) { const f32x4 a = bf2lo(raw[j][hf]) - mean, b = bf2hi(raw[j][hf]) - mean; s2 += ((a.x * a.x + a.y * a.y) + (a.z * a.z + a.w * a.w)) + ((b.x * b.x + b.y * b.y) + (b.z * b.z + b.w * b.w)); }
#pragma unroll
        for (int j = 0; j < 16; ++j) asm volatile("" : "+v"(raw[j][0]), "+v"(raw[j][1]));
        s2 += __shfl_xor(s2, 16); s2 += __shfl_xor(s2, 32);
        const float rstd = 1.f / sqrtf(s2 * (1.f / 1024.f) + LN_EPS);
        f32x4 a0 = {0.f, 0.f, 0.f, 0.f}, a1 = {0.f, 0.f, 0.f, 0.f};
        bf16* hrow = hb + row * D + 16 * g; unsigned char* qrow = h8 + row * D + 16 * g;
#pragma unroll
        for (int j = 0; j < 16; ++j) {
            v4u o[2]; v4u q8;
#pragma unroll
            for (int hf = 0; hf < 2; ++hf) { const int c = 64 * j + 16 * g + 8 * hf;
                const f32x4 ga = *(const LAS f32x4*)(lgam + c), gb = *(const LAS f32x4*)(lgam + c + 4), ba = *(const LAS f32x4*)(lbet + c), bb = *(const LAS f32x4*)(lbet + c + 4);
                const f32x4 ya = (bf2lo(raw[j][hf]) - mean) * rstd * ga + ba, yb = (bf2hi(raw[j][hf]) - mean) * rstd * gb + bb;
                o[hf] = pack8(ya, yb);
                const unsigned qa = pg8::cvt4_fp8(ya.x * 16.0f, ya.y * 16.0f, ya.z * 16.0f, ya.w * 16.0f), qb = pg8::cvt4_fp8(yb.x * 16.0f, yb.y * 16.0f, yb.z * 16.0f, yb.w * 16.0f);
                if (hf == 0) { q8.x = qa; q8.y = qb; } else { q8.z = qa; q8.w = qb; } }
            *(v4u*)(hrow + 64 * j) = o[0]; *(v4u*)(hrow + 64 * j + 8) = o[1]; *(v4u*)(qrow + 64 * j) = q8;
            const bf16* w0 = wr + (size_t)m * D + 64 * j + 16 * g; const bf16* w1 = w0 + 16 * D;
            const bf16x8 b00 = *(const bf16x8*)w0, b01 = *(const bf16x8*)(w0 + 8), b10 = *(const bf16x8*)w1, b11 = *(const bf16x8*)(w1 + 8);
            a0 = __builtin_amdgcn_mfma_f32_16x16x32_bf16(__builtin_bit_cast(bf16x8, o[0]), b00, a0, 0, 0, 0); a0 = __builtin_amdgcn_mfma_f32_16x16x32_bf16(__builtin_bit_cast(bf16x8, o[1]), b01, a0, 0, 0, 0);
            a1 = __builtin_amdgcn_mfma_f32_16x16x32_bf16(__builtin_bit_cast(bf16x8, o[0]), b10, a1, 0, 0, 0); a1 = __builtin_amdgcn_mfma_f32_16x16x32_bf16(__builtin_bit_cast(bf16x8, o[1]), b11, a1, 0, 0, 0);
            if (j & 1) { asm volatile("" ::: "memory"); __builtin_amdgcn_sched_barrier(0); }
        }
#pragma unroll
        for (int i = 0; i < 4; ++i) {
            float c0 = a0[i] + br0, c1 = a1[i] + br1; float tv[4]; int ti[4];
#pragma unroll
            for (int k = 0; k < 4; ++k) {
                float bv = (c0 >= c1) ? c0 : c1; int be = (c0 >= c1) ? m : 16 + m;
#pragma unroll
                for (int off = 1; off < 16; off <<= 1) { const float ov = __shfl_xor(bv, off); const int oe = __shfl_xor(be, off); const bool take = (ov > bv) || (ov == bv && oe < be); bv = take ? ov : bv; be = take ? oe : be; }
                tv[k] = bv; ti[k] = be;
                c0 = (be == m) ? -3.0e38f : c0; c1 = (be == 16 + m) ? -3.0e38f : c1;
            }
            if (m == 0) {
                float ex[4], sum = 0.f;
#pragma unroll
                for (int k = 0; k < 4; ++k) { ex[k] = __expf(tv[k] - tv[0]); sum += ex[k]; }
                const float inv = 1.0f / sum;
#pragma unroll
                for (int k = 0; k < 4; ++k) { const int p = (F.wave * 16 + 4 * g + i) * 4 + k; sel_e[p] = ti[k]; sel_r[p] = __hip_atomic_fetch_add(cntl + ti[k], 1, __ATOMIC_RELAXED, __HIP_MEMORY_SCOPE_WORKGROUP); sel_g[p] = ex[k] * inv; }
            }
        }
        BAR_LDS();
        if (F.tid < NEXP) basel[F.tid] = (int)__hip_atomic_fetch_add(F.ctl + CW_CNT + (l * NEXP + F.tid) * 16, (unsigned)cntl[F.tid], RLX_AGENT);
        BAR_LDS();
        { const int p = F.tid, e = sel_e[p], slot = basel[e] + sel_r[p];
          WSP(int, WS_TOKES)[(size_t)blk * 512 + p] = (e << 16) | slot; WSP(float, WS_TOKG)[(size_t)blk * 512 + p] = sel_g[p]; }
        BAR_LDS();
    }
}
__device__ __forceinline__ void pe_phase(Frame& F, int l) {
    RELANE(F);
    compute_toff(F, l);
    const LAS int* toff = (const LAS int*)(F.lds + TOFF_OFF);
    const unsigned char* h8 = F.ws + WS_H8; unsigned char* xp = F.ws + WS_XP8;
    for (int blk = blockIdx.x; blk < NTOK / 128; blk += F.G) {
        const int p0 = blk * 512 + F.wave * 64;
        const int es = WSP(int, WS_TOKES)[p0 + F.lane];
        const int rowl = toff[es >> 16] * 256 + (es & 0xffff);
        WSP(int, WS_ROWIDX)[p0 + F.lane] = rowl;
#pragma unroll 8
        for (int p = 0; p < 64; ++p) { const int row = __shfl(rowl, p); const int t = (p0 + p) >> 2;
            const v4u a = *(const v4u*)(h8 + (size_t)t * D + 16 * F.lane);
            *(v4u*)(xp + (size_t)row * D + 16 * F.lane) = a; }
    }
}
__device__ __forceinline__ void acc8_fp8(f32x4& a, f32x4& b, const v2u q, const float g) {
    typedef float f2v __attribute__((ext_vector_type(2)));
    const f2v p0 = __builtin_amdgcn_cvt_pk_f32_fp8((int)q.x, false), p1 = __builtin_amdgcn_cvt_pk_f32_fp8((int)q.x, true), p2 = __builtin_amdgcn_cvt_pk_f32_fp8((int)q.y, false), p3 = __builtin_amdgcn_cvt_pk_f32_fp8((int)q.y, true);
    a.x += g * p0.x; a.y += g * p0.y; a.z += g * p1.x; a.w += g * p1.y; b.x += g * p2.x; b.y += g * p2.y; b.z += g * p3.x; b.w += g * p3.y;
}
__device__ __forceinline__ void ph_phase(Frame& F, const Args& A, int l) {
    RELANE(F);
    const int gw = blockIdx.x * NWAVES + F.wave, NGW = F.G * NWAVES;
    LnPar lp; ln_load(lp, A.in[I_LN2_G] + l * D, A.in[I_LN2_B] + l * D, F.lane);
    bf16* hb = TILEP(T_HB); const unsigned char* ys = F.ws + WS_YS8;
    for (int t0 = gw * 16; t0 < NTOK; t0 += NGW * 16) {
        const int ri = WSP(int, WS_ROWIDX)[(size_t)t0 * 4 + F.lane]; const float gk = WSP(float, WS_TOKG)[(size_t)t0 * 4 + F.lane] * (1.0f / 64.0f);
#pragma nounroll
        for (int i = 0; i < 16; i += 4) {
            v4u hr[4][2]; v2u yr[4][4][2];
#pragma unroll
            for (int rr = 0; rr < 4; ++rr) { const bf16* hp = hb + (size_t)(t0 + i + rr) * D + 8 * F.lane; hr[rr][0] = *(const v4u*)hp; hr[rr][1] = *(const v4u*)(hp + 512);
#pragma unroll
                for (int k = 0; k < 4; ++k) { const int row = __shfl(ri, 4 * (i + rr) + k); const unsigned char* yp = ys + (size_t)row * D + 8 * F.lane; yr[rr][k][0] = *(const v2u*)yp; yr[rr][k][1] = *(const v2u*)(yp + 512); } }
#pragma unroll
            for (int rr = 0; rr < 4; ++rr) { const int t = t0 + i + rr;
                f32x4 v[4]; v[0] = bf2lo(hr[rr][0]) * DN_ALPHA; v[1] = bf2hi(hr[rr][0]) * DN_ALPHA; v[2] = bf2lo(hr[rr][1]) * DN_ALPHA; v[3] = bf2hi(hr[rr][1]) * DN_ALPHA;
#pragma unroll
                for (int k = 0; k < 4; ++k) { const float g = __shfl(gk, 4 * (i + rr) + k); acc8_fp8(v[0], v[1], yr[rr][k][0], g); acc8_fp8(v[2], v[3], yr[rr][k][1], g); }
                ln_affine(v, lp);
                if (l == NLAYER - 1) { float* op = F.out + (size_t)t * D + 8 * F.lane; *(f32x4*)op = v[0]; *(f32x4*)(op + 4) = v[1]; *(f32x4*)(op + 512) = v[2]; *(f32x4*)(op + 516) = v[3]; }
                else { bf16* op = hb + (size_t)t * D + 8 * F.lane; *(v4u*)op = pack8(v[0], v[1]); *(v4u*)(op + 512) = pack8(v[2], v[3]); } }
        }
    }
}

constexpr int MX_VT = 0, MX_K = 65536, MX_V = 65536 + 32768;
__device__ __forceinline__ void unpack8(const v4u raw, float (&f)[8]) {
    f[0] = __builtin_bit_cast(float, raw.x << 16); f[1] = __builtin_bit_cast(float, raw.x & 0xffff0000u); f[2] = __builtin_bit_cast(float, raw.y << 16); f[3] = __builtin_bit_cast(float, raw.y & 0xffff0000u);
    f[4] = __builtin_bit_cast(float, raw.z << 16); f[5] = __builtin_bit_cast(float, raw.z & 0xffff0000u); f[6] = __builtin_bit_cast(float, raw.w << 16); f[7] = __builtin_bit_cast(float, raw.w & 0xffff0000u);
}
__device__ __forceinline__ void mix_finish(float (&val)[8][8], const float* gain, bf16* grow, int q) {
    float ss = 0.f;
#pragma unroll
    for (int cb = 0; cb < 8; ++cb)
#pragma unroll
        for (int i = 0; i < 8; ++i) ss += val[cb][i] * val[cb][i];
    ss += __shfl_xor(ss, 16); ss += __shfl_xor(ss, 32);
    const float rs = 1.0f / sqrtf(ss * (1.0f / 256.0f) + RMS_EPS);
#pragma unroll
    for (int cb = 0; cb < 8; ++cb) { const f32x4 g0 = *(const f32x4*)(gain + 32 * cb + 8 * q), g1 = *(const f32x4*)(gain + 32 * cb + 8 * q + 4);
        v4u o; o.x = pk2(val[cb][0] * rs * g0.x, val[cb][1] * rs * g0.y); o.y = pk2(val[cb][2] * rs * g0.z, val[cb][3] * rs * g0.w);
        o.z = pk2(val[cb][4] * rs * g1.x, val[cb][5] * rs * g1.y); o.w = pk2(val[cb][6] * rs * g1.z, val[cb][7] * rs * g1.w);
        *(v4u*)(grow + 32 * cb + 8 * q) = o; }
}
__device__ __forceinline__ void pb_phase(Frame& F, const Args& A, int l) {
    for (int u = blockIdx.x; u < NTOK / 128; u += F.G) {
    RELANE(F);
    const int r = F.lane & 15, q = F.lane >> 4, w = F.wave;
    const bf16* P = WSP(bf16, WS_P); bf16* G = TILEP(T_G);
    const float* gng = A.in[I_GROUP_NORM_G] + l * 1024;
        const int row = u * 128 + 16 * w + r, tseq = (u & 15) * 128 + 16 * w + r, b = u >> 4;
        const bf16* prow = P + (size_t)row * NPROJ; bf16* grow = G + (size_t)row * 1024;
        float val[8][8];
#if MXMASK & 1
        {
            const float* cw = A.in[I_CONV_W] + l * 768;
#pragma unroll
            for (int cb = 0; cb < 8; ++cb) { const int col = 32 * cb + 8 * q;
                float gb[8], zc[8], zh[8], z[8], acc[8];
                unpack8(*(const v4u*)(prow + col), gb);
#pragma unroll
                for (int i = 0; i < 8; ++i) acc[i] = 0.f;
#pragma unroll
                for (int d = 0; d < 3; ++d) {
                    if (tseq - 2 + d >= 0) { const bf16* pr = prow - (size_t)(2 - d) * NPROJ;
                        unpack8(*(const v4u*)(pr + 256 + col), zc); unpack8(*(const v4u*)(pr + 512 + col), zh);
                        const f32x4 w0 = *(const f32x4*)(cw + d * 256 + col), w1 = *(const f32x4*)(cw + d * 256 + col + 4);
#pragma unroll
                        for (int i = 0; i < 8; ++i) z[i] = zc[i] * zh[i];
                        acc[0] += w0.x * z[0]; acc[1] += w0.y * z[1]; acc[2] += w0.z * z[2]; acc[3] += w0.w * z[3]; acc[4] += w1.x * z[4]; acc[5] += w1.y * z[5]; acc[6] += w1.z * z[6]; acc[7] += w1.w * z[7]; } }
#pragma unroll
                for (int i = 0; i < 8; ++i) val[cb][i] = gb[i] * acc[i];
                asm volatile("" ::: "memory"); }
            mix_finish(val, gng, grow, q);
        }
#endif
        asm volatile("" ::: "memory"); __builtin_amdgcn_sched_barrier(0);
#if MXMASK & 2
        {
            const bf16* pt = WSP(bf16, WS_POOLT) + (size_t)l * 4 * 4096;
            bf16x8 dfr[4][2];
#pragma unroll
            for (int g = 0; g < 4; ++g)
#pragma unroll
                for (int ks = 0; ks < 2; ++ks) { const int col = 768 + g * 64 + 32 * ks + 8 * q, wlen = 2 << g;
                    float acc[8], x[8], t8[8];
                    unpack8(*(const v4u*)(prow + col), x);
#pragma unroll
                    for (int i = 0; i < 8; ++i) acc[i] = x[i];
                    for (int d = 1; d < wlen; ++d) if (tseq - d >= 0) { unpack8(*(const v4u*)(prow - (size_t)d * NPROJ + col), t8);
#pragma unroll
                        for (int i = 0; i < 8; ++i) acc[i] += t8[i]; }
                    const float inv = 1.0f / (float)((tseq + 1 < wlen) ? tseq + 1 : wlen);
                    v4u o; o.x = pk2(acc[0] * inv - x[0], acc[1] * inv - x[1]); o.y = pk2(acc[2] * inv - x[2], acc[3] * inv - x[3]);
                    o.z = pk2(acc[4] * inv - x[4], acc[5] * inv - x[5]); o.w = pk2(acc[6] * inv - x[6], acc[7] * inv - x[7]);
                    dfr[g][ks] = __builtin_bit_cast(bf16x8, o);
                    asm volatile("" ::: "memory"); }
            const float* psc = A.in[I_POOL_SCALE] + l * 256;
#pragma unroll
            for (int g = 0; g < 4; ++g)
#pragma unroll
                for (int mt2 = 0; mt2 < 2; ++mt2) { const f32x4 s0 = *(const f32x4*)(psc + g * 64 + 32 * mt2 + 8 * q), s1 = *(const f32x4*)(psc + g * 64 + 32 * mt2 + 8 * q + 4);
#pragma unroll
                    for (int e = 0; e < 2; ++e) { const int dd = 32 * mt2 + 8 * (r >> 2) + 4 * e + (r & 3);
                        f32x4 o = {0.f, 0.f, 0.f, 0.f};
#pragma unroll
                        for (int ks = 0; ks < 2; ++ks) { const bf16x8 a = *(const bf16x8*)(pt + (size_t)(g * 64 + dd) * 64 + 32 * ks + 8 * q);
                            o = __builtin_amdgcn_mfma_f32_16x16x32_bf16(a, dfr[g][ks], o, 0, 0, 0); }
                        const f32x4 sc = e ? s1 : s0;
                        val[2 * g + mt2][4 * e + 0] = o[0] * sc.x; val[2 * g + mt2][4 * e + 1] = o[1] * sc.y; val[2 * g + mt2][4 * e + 2] = o[2] * sc.z; val[2 * g + mt2][4 * e + 3] = o[3] * sc.w; } }
            mix_finish(val, gng + 256, grow + 256, q);
        }
#endif
        asm volatile("" ::: "memory"); __builtin_amdgcn_sched_barrier(0);
#if MXMASK & 4
        {
            const float* lg = A.in[I_GMLP_LN_G] + l * 256; const float* lb = A.in[I_GMLP_LN_B] + l * 256;
            const f32x4 g4 = *(const f32x4*)(lg + 4 * F.lane), b4 = *(const f32x4*)(lb + 4 * F.lane);
            const int hh_l = F.lane >> 4, mt2_l = (F.lane & 15) >> 3, q_l = (F.lane & 7) >> 1, e_l = F.lane & 1;
#pragma unroll 2
            for (int jp = 0; jp < 8; ++jp) { const int j = 16 * w + 2 * jp;
                const bf16* p0 = P + (size_t)(u * 128 + j) * NPROJ + 1280 + 4 * F.lane;
                const v2u ra = *(const v2u*)p0, rb = *(const v2u*)(p0 + NPROJ);
                float va[4], vb[4];
                va[0] = gelu_tanh(__builtin_bit_cast(float, ra.x << 16)); va[1] = gelu_tanh(__builtin_bit_cast(float, ra.x & 0xffff0000u)); va[2] = gelu_tanh(__builtin_bit_cast(float, ra.y << 16)); va[3] = gelu_tanh(__builtin_bit_cast(float, ra.y & 0xffff0000u));
                vb[0] = gelu_tanh(__builtin_bit_cast(float, rb.x << 16)); vb[1] = gelu_tanh(__builtin_bit_cast(float, rb.x & 0xffff0000u)); vb[2] = gelu_tanh(__builtin_bit_cast(float, rb.y << 16)); vb[3] = gelu_tanh(__builtin_bit_cast(float, rb.y & 0xffff0000u));
                const float ma = wave_sum((va[0] + va[1]) + (va[2] + va[3])) * (1.f / 256.f), mb = wave_sum((vb[0] + vb[1]) + (vb[2] + vb[3])) * (1.f / 256.f);
                float sa = 0.f, sb = 0.f;
#pragma unroll
                for (int c = 0; c < 4; ++c) { va[c] -= ma; vb[c] -= mb; sa += va[c] * va[c]; sb += vb[c] * vb[c]; }
                const float ra_ = 1.f / sqrtf(wave_sum(sa) * (1.f / 256.f) + LN_EPS), rb_ = 1.f / sqrtf(wave_sum(sb) * (1.f / 256.f) + LN_EPS);
                const int ks = j >> 5, gg = (j & 31) >> 3, jj = j & 7;
                LAS unsigned char* dst = F.lds + MX_VT + ((((hh_l * 2 + mt2_l) * 2 + e_l) * 4 + ks) * 64 + 16 * gg + 4 * q_l) * 16 + jj * 2;
                const float ga[4] = {g4.x, g4.y, g4.z, g4.w}, ba[4] = {b4.x, b4.y, b4.z, b4.w};
#pragma unroll
                for (int c = 0; c < 4; ++c) *(LAS unsigned*)(dst + c * 16) = pk2(va[c] * ra_ * ga[c] + ba[c], vb[c] * rb_ * ga[c] + ba[c]);
            }
            __syncthreads();
            const bf16* wm = WSP(bf16, WS_WMB) + (size_t)l * 4 * 128 * 128; const float* gbias = A.in[I_GMLP_B] + l * 512;
            const int nks = (w < 4) ? 2 : 4;
#pragma unroll
            for (int hh = 0; hh < 4; ++hh) {
                bf16x8 wf[4];
#pragma unroll
                for (int ks = 0; ks < 4; ++ks) wf[ks] = *(const bf16x8*)(wm + (size_t)(hh * 128 + 16 * w + r) * 128 + 32 * ks + 8 * q);
                const float bias = gbias[hh * 128 + 16 * w + r];
#pragma unroll
                for (int mt2 = 0; mt2 < 2; ++mt2) {
                    float uu[8]; unpack8(*(const v4u*)(prow + 1024 + hh * 64 + 32 * mt2 + 8 * q), uu);
#pragma unroll
                    for (int e = 0; e < 2; ++e) { f32x4 o = {0.f, 0.f, 0.f, 0.f};
#pragma unroll
                        for (int ks = 0; ks < 4; ++ks) if (ks < nks) { const bf16x8 a = *(const LAS bf16x8*)(F.lds + MX_VT + ((((hh * 2 + mt2) * 2 + e) * 4 + ks) * 64 + F.lane) * 16);
                            o = __builtin_amdgcn_mfma_f32_16x16x32_bf16(a, wf[ks], o, 0, 0, 0); }
#pragma unroll
                        for (int i = 0; i < 4; ++i) val[2 * hh + mt2][4 * e + i] = gelu_tanh(uu[4 * e + i]) * (o[i] + bias); } }
            }
            mix_finish(val, gng + 512, grow + 512, q);
        }
#endif
        asm volatile("" ::: "memory"); __builtin_amdgcn_sched_barrier(0);
#if MXMASK & 8
        {
            const bf16* kb = WSP(bf16, WS_KB) + ((size_t)l * 4096 + (size_t)b * 256) * 256;
            const bf16* vt = WSP(bf16, WS_VT) + (size_t)l * 256 * 4096 + (size_t)b * 256;
            float rsum[4];
#pragma unroll
            for (int hh = 0; hh < 4; ++hh) {
                __syncthreads();
#pragma unroll
                for (int i = 0; i < 4; ++i) { const int idx = F.tid + 512 * i;
                    { const int key = idx >> 3, cidx = idx & 7; const v4u x = *(const v4u*)(kb + (size_t)key * 256 + hh * 64 + 8 * cidx);
                      *(LAS v4u*)(F.lds + MX_K + ((((key >> 4) * 2 + (cidx >> 2)) * 64) + 16 * (cidx & 3) + (key & 15)) * 16) = x; }
                    { const int d = idx >> 5, c16 = idx & 31; const v4u x = *(const v4u*)(vt + (size_t)(hh * 64 + d) * 4096 + 8 * c16);
                      const int key0 = 8 * c16, s = key0 >> 5, kk = key0 & 31, half = kk >> 4, gA = (kk & 15) >> 2, mt2 = d >> 5, rem = d & 31, m = 4 * (rem >> 3) + (rem & 3), e = (rem >> 2) & 1;
                      LAS unsigned char* dst = F.lds + MX_V + ((((mt2 * 2 + e) * 8 + s) * 64) + 16 * gA + m) * 16 + half * 8;
                      v2u lo; lo.x = x.x; lo.y = x.y; v2u hi; hi.x = x.z; hi.y = x.w; *(LAS v2u*)dst = lo; *(LAS v2u*)(dst + 256) = hi; } }
                const bf16x8 q0 = *(const bf16x8*)(prow + 1536 + hh * 64 + 8 * q), q1 = *(const bf16x8*)(prow + 1536 + hh * 64 + 32 + 8 * q);
                __syncthreads();
                f32x4 st[16];
#pragma unroll
                for (int t = 0; t < 16; ++t) { const bf16x8 k0 = *(const LAS bf16x8*)(F.lds + MX_K + ((t * 2 + 0) * 64 + F.lane) * 16), k1 = *(const LAS bf16x8*)(F.lds + MX_K + ((t * 2 + 1) * 64 + F.lane) * 16);
                    f32x4 z = {0.f, 0.f, 0.f, 0.f}; z = __builtin_amdgcn_mfma_f32_16x16x32_bf16(k0, q0, z, 0, 0, 0); st[t] = __builtin_amdgcn_mfma_f32_16x16x32_bf16(k1, q1, z, 0, 0, 0); }
                float mx = -3.0e38f;
#pragma unroll
                for (int t = 0; t < 16; ++t) mx = fmaxf(fmaxf(mx, fmaxf(st[t][0], st[t][1])), fmaxf(st[t][2], st[t][3]));
                mx = fmaxf(mx, __shfl_xor(mx, 16)); mx = fmaxf(mx, __shfl_xor(mx, 32));
                float sum = 0.f; const float c2 = 0.125f * 1.4426950408889634f, mo = mx * c2;
#pragma unroll
                for (int t = 0; t < 16; ++t)
#pragma unroll
                    for (int i = 0; i < 4; ++i) { const float p = __builtin_amdgcn_exp2f(st[t][i] * c2 - mo); st[t][i] = p; sum += p; }
                sum += __shfl_xor(sum, 16); sum += __shfl_xor(sum, 32); rsum[hh] = 1.0f / sum;
                bf16x8 pb[8];
#pragma unroll
                for (int s = 0; s < 8; ++s) { v4u o; o.x = pk2(st[2 * s][0], st[2 * s][1]); o.y = pk2(st[2 * s][2], st[2 * s][3]); o.z = pk2(st[2 * s + 1][0], st[2 * s + 1][1]); o.w = pk2(st[2 * s + 1][2], st[2 * s + 1][3]);
                    pb[s] = __builtin_bit_cast(bf16x8, o); }
#pragma unroll
                for (int mt2 = 0; mt2 < 2; ++mt2)
#pragma unroll
                    for (int e = 0; e < 2; ++e) { f32x4 o = {0.f, 0.f, 0.f, 0.f};
#pragma unroll
                        for (int s = 0; s < 8; ++s) { const bf16x8 a = *(const LAS bf16x8*)(F.lds + MX_V + (((mt2 * 2 + e) * 8 + s) * 64 + F.lane) * 16);
                            o = __builtin_amdgcn_mfma_f32_16x16x32_bf16(a, pb[s], o, 0, 0, 0); }
#pragma unroll
                        for (int i = 0; i < 4; ++i) val[2 * hh + mt2][4 * e + i] = o[i] * rsum[hh]; }
            }
            mix_finish(val, gng + 768, grow + 768, q);
        }
#endif
        __syncthreads();
    }
}

#if NAIVE_MIX
__global__ void __launch_bounds__(256) nv_mix_pre(const bf16* P, const float* lng, const float* lnb, float* Vn, float* Dp) {
    const int row = blockIdx.x * 4 + (threadIdx.x >> 6), lane = threadIdx.x & 63;
    const bf16* p = P + (size_t)row * NPROJ;
    float v[4]; float s = 0.f;
    for (int i = 0; i < 4; ++i) { v[i] = gelu_tanh(bf2f(p[1280 + 4 * lane + i])); s += v[i]; }
    const float mean = wave_sum(s) * (1.f / 256.f); float s2 = 0.f;
    for (int i = 0; i < 4; ++i) { v[i] -= mean; s2 += v[i] * v[i]; }
    const float rstd = 1.f / sqrtf(wave_sum(s2) * (1.f / 256.f) + LN_EPS);
    for (int i = 0; i < 4; ++i) Vn[(size_t)row * 256 + 4 * lane + i] = v[i] * rstd * lng[4 * lane + i] + lnb[4 * lane + i];
    const int t = row % SEQ, w = 2 << (lane >> 4), cnt = (t + 1 < w) ? t + 1 : w;
    for (int i = 0; i < 4; ++i) { const int c = 4 * lane + i; float acc = 0.f;
        for (int d = 0; d < cnt; ++d) acc += bf2f(P[(size_t)(row - d) * NPROJ + 768 + c]);
        Dp[(size_t)row * 256 + c] = acc / (float)cnt - bf2f(p[768 + c]); }
}
__global__ void __launch_bounds__(256) nv_mix_main(const bf16* P, const float* Vn, const float* Dp, const bf16* Kb, const bf16* VT, const float* conv_w, const float* pool_w, const float* pool_scale,
                                                   const float* gmlp_w, const float* gmlp_b, float* Y) {
    const int row = blockIdx.x >> 2, grp = blockIdx.x & 3, c = threadIdx.x, t = row % SEQ;
    const bf16* p = P + (size_t)row * NPROJ; float y = 0.f;
    if (grp == 0) {
        float z[3];
        for (int d = 0; d < 3; ++d) { const int tt = t - 2 + d; z[d] = (tt >= 0) ? bf2f(P[(size_t)(row - 2 + d) * NPROJ + 256 + c]) * bf2f(P[(size_t)(row - 2 + d) * NPROJ + 512 + c]) : 0.f; }
        y = bf2f(p[c]) * (conv_w[c] * z[0] + conv_w[256 + c] * z[1] + conv_w[512 + c] * z[2]);
    } else if (grp == 1) {
        const int gi = c >> 6, dd = c & 63; float acc = 0.f;
        for (int cc = 0; cc < 64; ++cc) acc += Dp[(size_t)row * 256 + gi * 64 + cc] * pool_w[(gi * 64 + cc) * 64 + dd];
        y = acc * pool_scale[c];
    } else if (grp == 2) {
        const int hh = c >> 6, i = t & 127, jmax = ((i >> 6) + 1) * 64; const size_t blk0 = (size_t)(row - i); float acc = 0.f;
        for (int j = 0; j < jmax; ++j) acc += gmlp_w[(hh * 128 + i) * 128 + j] * Vn[(blk0 + j) * 256 + c];
        y = gelu_tanh(bf2f(p[1024 + c])) * (acc + gmlp_b[hh * 128 + i]);
    } else {
        const int hh = c >> 6, lane = c & 63, b = row / SEQ;
        const float q = bf2f(p[1536 + hh * 64 + lane]);
        float sc[4] = {0.f, 0.f, 0.f, 0.f};
        for (int d = 0; d < 64; ++d) { const float qd = __shfl(q, d);
            for (int m = 0; m < 4; ++m) sc[m] += qd * bf2f(Kb[(size_t)(b * 256 + lane + 64 * m) * 256 + hh * 64 + d]); }
        float mx = -3.0e38f;
        for (int m = 0; m < 4; ++m) { sc[m] *= 0.125f; mx = fmaxf(mx, sc[m]); }
        for (int o = 1; o < 64; o <<= 1) mx = fmaxf(mx, __shfl_xor(mx, o));
        float sum = 0.f;
        for (int m = 0; m < 4; ++m) { sc[m] = __expf(sc[m] - mx); sum += sc[m]; }
        sum = wave_sum(sum);
        float o = 0.f;
        for (int m = 0; m < 4; ++m) for (int j = 0; j < 64; ++j) { const float pj = __shfl(sc[m], j); o += pj * bf2f(VT[(size_t)(hh * 64 + lane) * 4096 + b * 256 + j + 64 * m]); }
        y = o / sum;
    }
    Y[(size_t)row * 1024 + grp * 256 + c] = y;
}
__global__ void __launch_bounds__(256) nv_mix_norm(const float* Y, const float* gng, bf16* G) {
    const int wv = blockIdx.x * 4 + (threadIdx.x >> 6), lane = threadIdx.x & 63, row = wv >> 2, grp = wv & 3;
    const float* y = Y + (size_t)row * 1024 + grp * 256; float v[4], s2 = 0.f;
    for (int i = 0; i < 4; ++i) { v[i] = y[4 * lane + i]; s2 += v[i] * v[i]; }
    const float r = 1.f / sqrtf(wave_sum(s2) * (1.f / 256.f) + RMS_EPS);
    for (int i = 0; i < 4; ++i) G[(size_t)row * 1024 + grp * 256 + 4 * lane + i] = (bf16)f2bf(v[i] * r * gng[grp * 256 + 4 * lane + i]);
}
#endif

constexpr int PH_PRO = 0, PH_KV = 1, PH_L0 = 2, PH_PER_LAYER = 8, N_PHASES = PH_L0 + NLAYER * PH_PER_LAYER;
__global__ void __launch_bounds__(NWAVES * 64, 2) fwd(Args args) {
    const Args& A = args;
    extern __shared__ __attribute__((aligned(16))) unsigned char lds[];
    Frame F;
    F.lds = (LAS unsigned char*)lds;
    F.MISC = (volatile LAS unsigned*)(F.lds + MISC_OFF);
    F.tid = threadIdx.x; F.lane = F.tid & 63; F.wave = __builtin_amdgcn_readfirstlane(F.tid >> 6);
    F.G = gridDim.x; F.ws = args.ws; F.ctl = (gu32*)(args.ws + WS_CTL); F.out = args.out;
    for (int u = F.tid; u < (LDS_BYTES - LDSCTL_OFF) / 4; u += NWAVES * 64) ((LAS unsigned*)(F.lds + LDSCTL_OFF))[u] = 0u;
    __syncthreads();
#if MK_ONE_LAUNCH
    XcdBarrier bar = xcd_barrier_post((unsigned*)(F.ctl + CW_BAR), F.MISC + 8);
#define GRID_BAR() xcd_barrier(bar)
#else
#define GRID_BAR() do { } while (0)
#endif
    const int lo = args.ph_lo, hi = args.ph_hi;
#define IN(k) (lo <= (k) && (k) < hi)
#define REP(q) for (int rep_ = 0; rep_ < ((DUP_PHASE == (q)) ? 2 : 1); ++rep_)
#define BOTH(k) (IN(k) && IN((k) + 1))
    const pg8::Gemm gm{(const pg8::bf16_t*)F.ws, (const pg8::bf16_t*)F.ws, D};
    const int c = (int)blockIdx.x;

    REP(100) if (IN(PH_PRO) && (PHMASK & 1)) { p0_prologue(F, args); if (BOTH(PH_PRO)) GRID_BAR(); }
    REP(101) if (IN(PH_KV) && (PHMASK & 2)) {
        KvOrder S{F.G, c};
        pg8::EpiBf16Sel E{WSP(bf16, WS_KB), WSP(bf16, WS_VT), 256, 4096};
        pg8::gemm_phase<pg8::EpiBf16Sel, KvOrder, true, true>(F.lds + RING_OFF, gm, S, E);
        if (BOTH(PH_KV)) GRID_BAR();
    }
    for (int l = 0; l < NLAYER; ++l) {
        const int pb = PH_L0 + l * PH_PER_LAYER;
        REP(0) if (IN(pb + 0) && (PHMASK & 4)) {
            DenseOrder S{NTOK / 256, NPROJ / 256, F.G, c, T_HB, T_WIN + l * (NPROJ / 256)};
            pg8::EpiBf16Sel E{WSP(bf16, WS_P), WSP(bf16, WS_P), NPROJ, NPROJ};
            pg8::gemm_phase<pg8::EpiBf16Sel, DenseOrder, true, true>(F.lds + RING_OFF, gm, S, E);
            if (BOTH(pb + 0)) GRID_BAR();
        }
        REP(1) if (IN(pb + 1) && (PHMASK & 512)) {
            pb_phase(F, args, l);
            if (BOTH(pb + 1)) GRID_BAR();
        }
        REP(2) if (IN(pb + 2) && (PHMASK & 8)) {
            DenseOrder S{NTOK / 256, D / 256, F.G, c, T_G, T_WOUT + l * (D / 256)};
            pg8::EpiResBf16 E{TILEP(T_HB), WSP(bf16, WS_PRE), DN_ALPHA};
            pg8::gemm_phase<pg8::EpiResBf16, DenseOrder, true, true>(F.lds + RING_OFF, gm, S, E);
            if (BOTH(pb + 2)) GRID_BAR();
        }
        if (IN(pb + 3) && (PHMASK & 16)) { pd_phase(F, args, l); if (BOTH(pb + 3)) GRID_BAR(); }
        REP(4) if (IN(pb + 4) && (PHMASK & 32)) { pe_phase(F, l); if (BOTH(pb + 4)) GRID_BAR(); }
        REP(5) if (IN(pb + 5) && (PHMASK & 64)) {
            compute_toff(F, l);
            const LAS int* toff = (const LAS int*)(F.lds + TOFF_OFF);
            MoeOrder S{__builtin_amdgcn_readfirstlane(toff[NEXP]), 8, F.G, c, Q8(WS_XP8), Q8(WS_W18) + l * NEXP * 8, toff};
            pg8::EpiSwiglu E{F.ws + WS_ACT8, A.in[I_B1] + (size_t)l * NEXP * 2048};
            pg8::gemm_phase<pg8::EpiSwiglu, MoeOrder, true, true, true>(F.lds + RING_OFF, gm, S, E);
            if (BOTH(pb + 5)) GRID_BAR();
        }
        REP(6) if (IN(pb + 6) && (PHMASK & 128)) {
            compute_toff(F, l);
            const LAS int* toff = (const LAS int*)(F.lds + TOFF_OFF);
            MoeOrder S{__builtin_amdgcn_readfirstlane(toff[NEXP]), 4, F.G, c, Q8(WS_ACT8), Q8(WS_W28) + l * NEXP * 4, toff};
            pg8::EpiDown E{F.ws + WS_YS8, A.in[I_B2] + (size_t)l * NEXP * 1024};
            pg8::gemm_phase<pg8::EpiDown, MoeOrder, true, true, true>(F.lds + RING_OFF, gm, S, E);
            if (BOTH(pb + 6)) GRID_BAR();
        }
        if (IN(pb + 7) && (PHMASK & 256)) { ph_phase(F, args, l); if (BOTH(pb + 7)) GRID_BAR(); }
    }
#undef IN
#undef BOTH
}

extern "C" void kernel_launch(void* const* d_in, const int* in_sizes, int n_in, void* d_out, int out_size, void* d_ws, size_t ws_size, hipStream_t stream) {
    static int grid = 0;
    if (grid == 0) {
        if (n_in != 27 || out_size != NTOK * D || ws_size < WS_END) { fprintf(stderr, "kernel_launch: unexpected problem (n_in %d, out %d, ws %zu < %zu)\n", n_in, out_size, ws_size, (size_t)WS_END); grid = -1; return; }
        int dev = 0, cus = 0, per_cu = 0;
        if (hipGetDevice(&dev) != hipSuccess || hipDeviceGetAttribute(&cus, hipDeviceAttributeMultiprocessorCount, dev) != hipSuccess) { grid = -1; return; }
        if (hipFuncSetAttribute((const void*)fwd, hipFuncAttributeMaxDynamicSharedMemorySize, LDS_BYTES) != hipSuccess) { fprintf(stderr, "kernel_launch: hipFuncSetAttribute failed\n"); grid = -1; return; }
        if (hipOccupancyMaxActiveBlocksPerMultiprocessor(&per_cu, (const void*)fwd, NWAVES * 64, LDS_BYTES) != hipSuccess || per_cu < 1) fprintf(stderr, "kernel_launch: occupancy query says %d\n", per_cu);
        (void)hipGetLastError();
        grid = cus;
    }
    if (grid < 0) return;
    if (hipMemsetAsync((char*)d_ws + WS_CTL, 0, CTL_ZERO_BYTES, stream) != hipSuccess) return;
    Args a{};
    for (int i = 0; i < 27; ++i) a.in[i] = (const float*)d_in[i];
    a.out = (float*)d_out; a.ws = (unsigned char*)d_ws;
#if MK_ONE_LAUNCH
    a.ph_lo = 0; a.ph_hi = N_PHASES;
    hipLaunchKernelGGL(fwd, dim3(grid), dim3(NWAVES * 64), LDS_BYTES, stream, a);
#else
    unsigned char* ws = (unsigned char*)d_ws;
    for (int p = 0; p < N_PHASES; ++p) {
        const int l = (p - PH_L0) / PH_PER_LAYER, q = (p - PH_L0) % PH_PER_LAYER;
        if (p >= PH_L0 && q == 1) {
#if NAIVE_MIX
            const float* const* in = (const float* const*)d_in;
            hipLaunchKernelGGL(nv_mix_pre, dim3(NTOK / 4), dim3(256), 0, stream, (const bf16*)(ws + WS_P), in[10] + l * 256, in[11] + l * 256, (float*)(ws + WS_NV_VN), (float*)(ws + WS_NV_DP));
            hipLaunchKernelGGL(nv_mix_main, dim3(NTOK * 4), dim3(256), 0, stream, (const bf16*)(ws + WS_P), (const float*)(ws + WS_NV_VN), (const float*)(ws + WS_NV_DP),
                               (const bf16*)(ws + WS_KB) + (size_t)l * 4096 * 256, (const bf16*)(ws + WS_VT) + (size_t)l * 256 * 4096, in[7] + l * 768, in[8] + l * 4 * 64 * 64, in[9] + l * 256,
                               in[12] + l * 4 * 128 * 128, in[13] + l * 4 * 128, (float*)(ws + WS_NV_Y));
            hipLaunchKernelGGL(nv_mix_norm, dim3(NTOK), dim3(256), 0, stream, (const float*)(ws + WS_NV_Y), in[15] + l * 1024, (bf16*)(ws + (size_t)T_G * TILE));
            continue;
#endif
        }
        a.ph_lo = p; a.ph_hi = p + 1;
        hipLaunchKernelGGL(fwd, dim3(grid), dim3(NWAVES * 64), LDS_BYTES, stream, a);
    }
#endif
}
```

```cpp
#include <hip/hip_runtime.h>
#include <cstdio>
#include <cstdint>

#ifndef MK_ONE_LAUNCH
#define MK_ONE_LAUNCH 1
#endif
#ifndef PHMASK
#define PHMASK 0xffff
#endif
#ifndef MXMASK
#define MXMASK 15
#endif
#ifndef DUP_PHASE
#define DUP_PHASE -1
#endif
#ifndef DUP_EPI
#define DUP_EPI 0
#endif
#ifndef PROBE_MODE
#define PROBE_MODE 0
#endif
#ifndef NAIVE_MIX
#define NAIVE_MIX 0
#endif

namespace pg8 {
#define PG8_LAS __attribute__((address_space(3)))
typedef unsigned short bf16_t;
typedef short bf16x8 __attribute__((ext_vector_type(8)));
typedef float f32x4 __attribute__((ext_vector_type(4)));
typedef float f32x2 __attribute__((ext_vector_type(2)));
typedef unsigned u32x4 __attribute__((ext_vector_type(4)));
typedef unsigned u32x2 __attribute__((ext_vector_type(2)));
constexpr int BM = 256, BK = 64, HALF = 128, HTB = HALF * BK * 2  , STAGE_BYTES = 8 * HTB, NXCD = 8, WGM = 8;

__host__ __device__ __forceinline__ int lds_byte(int r, int c) { const int st = (r >> 4) * 2 + (c >> 5), rr = r & 15, cc = c & 31, ob = rr * 64 + cc * 2; return st * 1024 + (ob ^ (((ob >> 9) & 1) << 5)); }
__host__ __device__ __forceinline__ void stage_rc(int b, int& R, int& C) { const int st = b / 1024, sb = b % 1024, swz = sb ^ (((sb >> 9) & 1) << 5); R = (st >> 1) * 16 + swz / 64; C = (st & 1) * 32 + (swz % 64) / 2; }
__host__ __device__ __forceinline__ int perm32(int rho) { const int n = rho >> 4, i = rho & 15; return 8 * (i >> 2) + 4 * n + (i & 3); }

struct Unit { int pm, pn, lm, ln, a0; };
struct Gemm { const bf16_t* A; const bf16_t* Bt; int K; };

__device__ __forceinline__ void tile_of(int L, int nM, int nN, int& tm, int& tn) {
    const int nwg = nM * nN; int wgid = L; { const int q = nwg / NXCD, r = nwg % NXCD, xcd = wgid % NXCD, off = wgid / NXCD; wgid = (xcd < r ? xcd * (q + 1) : r * (q + 1) + (xcd - r) * q) + off; }
    const int nig = WGM * nN, gid = wgid / nig, fm = gid * WGM, gsz = (nM - fm) < WGM ? (nM - fm) : WGM;
    tm = fm + ((wgid % nig) % gsz); tn = (wgid % nig) / gsz;
}

typedef int v8i __attribute__((ext_vector_type(8)));
__device__ __forceinline__ v8i cat8(bf16x8 a, bf16x8 b) { typedef short s16x16 __attribute__((ext_vector_type(16))); return __builtin_bit_cast(v8i, __builtin_shufflevector(a, b, 0, 1, 2, 3, 4, 5, 6, 7, 8, 9, 10, 11, 12, 13, 14, 15)); }
__device__ __forceinline__ bf16x8 half8(v8i x, int k) { typedef int v4i __attribute__((ext_vector_type(4))); return __builtin_bit_cast(bf16x8, k ? __builtin_shufflevector(x, x, 4, 5, 6, 7) : __builtin_shufflevector(x, x, 0, 1, 2, 3)); }
__device__ __forceinline__ void mfma_fp8_acc(f32x4& acc, const v8i& a, const v8i& b) { asm volatile("v_mfma_f32_16x16x128_f8f6f4 %0, %1, %2, %0" : "+v"(acc) : "v"(a), "v"(b)); }
__device__ __forceinline__ unsigned cvt4_fp8(float a, float b, float c, float d) {
    a = __builtin_amdgcn_fmed3f(a, -448.f, 448.f); b = __builtin_amdgcn_fmed3f(b, -448.f, 448.f); c = __builtin_amdgcn_fmed3f(c, -448.f, 448.f); d = __builtin_amdgcn_fmed3f(d, -448.f, 448.f);
    int r = __builtin_amdgcn_cvt_pk_fp8_f32(a, b, 0, false); r = __builtin_amdgcn_cvt_pk_fp8_f32(c, d, r, true); return (unsigned)r; }
__device__ __forceinline__ unsigned cvt_pk_bf16(float lo, float hi) { unsigned r; asm volatile("v_cvt_pk_bf16_f32 %0, %1, %2" : "=v"(r) : "v"(lo), "v"(hi)); return r; }


struct EpiBf16Sel {
    static constexpr bool PERM = true, AFTER_DRAIN = false, DUP = (DUP_EPI & 4) != 0, DUPK = false; static constexpr int NSTORE = 16;
    bf16_t* o0; bf16_t* o1; int ld0, ld1; int mode;
    __device__ __forceinline__ void operator()(const f32x4 (&acc)[2][2][4][2], const Unit& u, int wr, int wc, int fr, int fq) const {
        bf16_t* base = u.a0 == 0 ? o0 : o1; const int ldc = u.a0 == 0 ? ld0 : ld1;
        const int row0 = u.lm * BM + wr * 64 + fr, col0 = u.ln * BM + wc * 32 + 8 * fq;
#pragma unroll
        for (int ai = 0; ai < 2; ++ai)
#pragma unroll
            for (int m = 0; m < 4; ++m) { bf16_t* rowp = base + (size_t)(row0 + ai * HALF + m * 16) * ldc + col0;
#pragma unroll
                for (int bj = 0; bj < 2; ++bj) { const f32x4 v0 = acc[ai][bj][m][0], v1 = acc[ai][bj][m][1];
                    u32x4 w; w.x = cvt_pk_bf16(v0[0], v0[1]); w.y = cvt_pk_bf16(v0[2], v0[3]); w.z = cvt_pk_bf16(v1[0], v1[1]); w.w = cvt_pk_bf16(v1[2], v1[3]);
                    *(u32x4*)(rowp + bj * HALF) = w; } }
    }
};
struct EpiResBf16 {
    static constexpr bool PERM = true, AFTER_DRAIN = false, DUP = (DUP_EPI & 8) != 0, DUPK = false; static constexpr int NSTORE = 16;
    const bf16_t* h; bf16_t* pre; float alpha; int mode;
    __device__ __forceinline__ void operator()(const f32x4 (&acc)[2][2][4][2], const Unit& u, int wr, int wc, int fr, int fq) const {
        const int row0 = u.lm * BM + wr * 64 + fr, col0 = u.ln * BM + wc * 32 + 8 * fq;
#pragma unroll
        for (int ai = 0; ai < 2; ++ai)
#pragma unroll
            for (int m = 0; m < 4; ++m) { const size_t off = (size_t)(row0 + ai * HALF + m * 16) * 1024 + col0;
#pragma unroll
                for (int bj = 0; bj < 2; ++bj) { const u32x4 hv = *(const u32x4*)(h + off + bj * HALF); const f32x4 a0 = acc[ai][bj][m][0], a1 = acc[ai][bj][m][1];
                    u32x4 w;
                    w.x = cvt_pk_bf16(__builtin_bit_cast(float, hv.x << 16) * alpha + a0[0], __builtin_bit_cast(float, hv.x & 0xffff0000u) * alpha + a0[1]);
                    w.y = cvt_pk_bf16(__builtin_bit_cast(float, hv.y << 16) * alpha + a0[2], __builtin_bit_cast(float, hv.y & 0xffff0000u) * alpha + a0[3]);
                    w.z = cvt_pk_bf16(__builtin_bit_cast(float, hv.z << 16) * alpha + a1[0], __builtin_bit_cast(float, hv.z & 0xffff0000u) * alpha + a1[1]);
                    w.w = cvt_pk_bf16(__builtin_bit_cast(float, hv.w << 16) * alpha + a1[2], __builtin_bit_cast(float, hv.w & 0xffff0000u) * alpha + a1[3]);
                    *(u32x4*)(pre + off + bj * HALF) = w; }
                asm volatile("" ::: "memory"); }
    }
};
struct EpiSwiglu {
    static constexpr bool PERM = true, AFTER_DRAIN = false, DUP = (DUP_EPI & 1) != 0, DUPK = (DUP_EPI & 16) != 0; static constexpr int NSTORE = 8;
    unsigned char* act; const float* b1; int mode;
    __device__ __forceinline__ void operator()(const f32x4 (&acc)[2][2][4][2], const Unit& u, int wr, int wc, int fr, int fq) const {
        const int row0 = u.lm * BM + wr * 64 + fr, lc0 = u.ln * HALF + wc * 32 + 8 * fq;
        const float* bb = b1 + (size_t)u.a0 * 2048 + lc0;
        f32x4 bg0 = {0.f, 0.f, 0.f, 0.f}, bg1 = bg0, bl0 = bg0, bl1 = bg0;
        if (mode != 3) { bg0 = *(const f32x4*)(bb); bg1 = *(const f32x4*)(bb + 4); bl0 = *(const f32x4*)(bb + 1024); bl1 = *(const f32x4*)(bb + 1028); }
        constexpr float DS = (DUPK ? 0.5f : 1.0f) / 512.0f;
#pragma unroll
        for (int ai = 0; ai < 2; ++ai)
#pragma unroll
            for (int m = 0; m < 4; ++m) {
                u32x2 w; unsigned* wp = (unsigned*)&w;
#pragma unroll
                for (int n = 0; n < 2; ++n) { const f32x4 g4 = acc[ai][0][m][n] * DS + (n ? bg1 : bg0), l4 = acc[ai][1][m][n] * DS + (n ? bl1 : bl0); float r4[4];
#pragma unroll
                    for (int j = 0; j < 4; ++j) { const float g = fminf(g4[j], 7.0f), li = fminf(fmaxf(l4[j], -7.0f), 7.0f);
                        const float sg = __builtin_amdgcn_rcpf(1.0f + __builtin_amdgcn_exp2f(g * (-1.702f * 1.4426950408889634f))); r4[j] = g * sg * (li + 1.0f) * 4.0f; }
                    wp[n] = cvt4_fp8(r4[0], r4[1], r4[2], r4[3]); }
                if (mode != 1) *(u32x2*)(act + (size_t)(row0 + ai * HALF + m * 16) * 1024 + lc0) = w; }
    }
};
struct EpiDown {
    static constexpr bool PERM = true, AFTER_DRAIN = false, DUP = (DUP_EPI & 2) != 0, DUPK = (DUP_EPI & 32) != 0; static constexpr int NSTORE = 16;
    unsigned char* ys; const float* b2; int mode;
    __device__ __forceinline__ void operator()(const f32x4 (&acc)[2][2][4][2], const Unit& u, int wr, int wc, int fr, int fq) const {
        const int row0 = u.lm * BM + wr * 64 + fr, col0 = u.ln * BM + wc * 32 + 8 * fq;
        f32x4 bv[2][2];
#pragma unroll
        for (int bj = 0; bj < 2; ++bj)
#pragma unroll
            for (int n = 0; n < 2; ++n) bv[bj][n] = (mode != 3) ? *(const f32x4*)(b2 + (size_t)u.a0 * 1024 + col0 + bj * HALF + 4 * n) * 64.0f : (f32x4){0.f, 0.f, 0.f, 0.f};
#pragma unroll
        for (int ai = 0; ai < 2; ++ai)
#pragma unroll
            for (int m = 0; m < 4; ++m) { unsigned char* rowp = ys + (size_t)(row0 + ai * HALF + m * 16) * 1024 + col0;
#pragma unroll
                for (int bj = 0; bj < 2; ++bj) { const f32x4 v0 = acc[ai][bj][m][0] * (DUPK ? 0.125f : 0.25f) + bv[bj][0], v1 = acc[ai][bj][m][1] * (DUPK ? 0.125f : 0.25f) + bv[bj][1];
                    u32x2 w; w.x = cvt4_fp8(v0[0], v0[1], v0[2], v0[3]); w.y = cvt4_fp8(v1[0], v1[1], v1[2], v1[3]);
                    if (mode != 1) *(u32x2*)(rowp + bj * HALF) = w; } }
    }
};

template <class Epi, class Sched, bool ALIGN_EPI = false, bool SP2 = false, bool FP8 = false, bool KROT = true>
__device__ __forceinline__ void gemm_phase(PG8_LAS unsigned char* lds, const Gemm g, const Sched& S, const Epi& E) {
    int tid_l = threadIdx.x; asm volatile("" : "+v"(tid_l));
    const int tid = tid_l, wid = __builtin_amdgcn_readfirstlane(tid >> 6), lane = tid & 63, wr = wid >> 2, wc = wid & 3, fr = lane & 15, fq = lane >> 4;
    const int RB = g.K * (FP8 ? 1 : 2), nt = RB / 128;
    unsigned voffA[2], voffB[2];
#pragma unroll
    for (int i = 0; i < 2; ++i) { int R, C; stage_rc(tid * 16 + i * 8192, R, C); const int Rb = Epi::PERM ? ((R & ~31) + perm32(R & 31)) : R;
        voffA[i] = (unsigned)(R * RB + C * 2); voffB[i] = (unsigned)(Rb * RB + C * 2); }
    const size_t kstep = (size_t)(BK * 2);
    const size_t hstep = (size_t)HALF * RB;
    const size_t tstep = 2 * hstep;
    const unsigned ldsw = (unsigned)wid * 1024u;
    const int aoff = lds_byte(wr * 64 + fr, fq * 8), boff = lds_byte(wc * 32 + fr, fq * 8);
#define PG8_SA(b, h) (((b) * 2 + (h)) * HTB)
#define PG8_SB(b, h) ((4 + (b) * 2 + (h)) * HTB)
#define PG8_STAGE(bufoff, gbase, voff) do { _Pragma("unroll") for (int _i = 0; _i < 2; ++_i) \
        __builtin_amdgcn_global_load_lds((const unsigned*)((const char*)(gbase) + (voff)[_i]), (PG8_LAS unsigned*)(lds + (bufoff) + ldsw + _i * 8192), 16, 0, 0); } while (0)
#define PG8_LDA(dst, b, h) do { _Pragma("unroll") for (int m = 0; m < 4; ++m) dst[m] = cat8(*(const PG8_LAS bf16x8*)(lds + PG8_SA(b, h) + aoff + m * 2048), *(const PG8_LAS bf16x8*)(lds + PG8_SA(b, h) + aoff + m * 2048 + 1024)); } while (0)
#define PG8_LDB(dst, b, h) do { _Pragma("unroll") for (int n = 0; n < 2; ++n) dst[n] = cat8(*(const PG8_LAS bf16x8*)(lds + PG8_SB(b, h) + boff + n * 2048), *(const PG8_LAS bf16x8*)(lds + PG8_SB(b, h) + boff + n * 2048 + 1024)); } while (0)
#define PG8_MMA(ai, bj, At, Bt) do { __builtin_amdgcn_s_setprio(1); _Pragma("unroll") for (int m = 0; m < 4; ++m) _Pragma("unroll") for (int n = 0; n < 2; ++n) { \
        if constexpr (FP8) mfma_fp8_acc(acc[ai][bj][m][n], Bt[n], At[m]); \
        else { _Pragma("unroll") for (int k = 0; k < 2; ++k) acc[ai][bj][m][n] = __builtin_amdgcn_mfma_f32_16x16x32_bf16(half8(Bt[n], k), half8(At[m], k), acc[ai][bj][m][n], 0, 0, 0); } } \
        __builtin_amdgcn_s_setprio(0); } while (0)
#define PG8_WAIT_V(n) asm volatile("s_waitcnt vmcnt(" #n ")" ::: "memory")
#define PG8_WAIT_L(n) asm volatile("s_waitcnt lgkmcnt(" #n ")" ::: "memory")
#define PG8_BAR __builtin_amdgcn_s_barrier()
#define PG8_SCHED __builtin_amdgcn_sched_barrier(0)
    Unit cur, nxt; int ui = 0;
    if (!S.next(0, cur)) return;
    f32x4 acc[2][2][4][2];
#pragma unroll
    for (int a = 0; a < 2; ++a)
#pragma unroll
        for (int b = 0; b < 2; ++b)
#pragma unroll
            for (int m = 0; m < 4; ++m)
#pragma unroll
                for (int n = 0; n < 2; ++n) acc[a][b][m][n] = (f32x4){0.f, 0.f, 0.f, 0.f};
    v8i At[4], B0[2], B1[2];
    const char* cA = (const char*)g.A + (size_t)cur.pm * tstep; const char* cB = (const char*)g.Bt + (size_t)cur.pn * tstep;
#define PG8_ROT(u) ((unsigned)(2 * (((u).lm + (u).ln) & (nt / 2 - 1))) * 128u)
#define PG8_KOFF(i, rb) ((size_t)((((unsigned)(i)) * 128u + (rb)) & (unsigned)(RB - 1)))
    unsigned rbc = KROT ? PG8_ROT(cur) : 0u, rbn = 0u;
    S.a_ready(cur);
    if constexpr (SP2) {
        PG8_STAGE(PG8_SB(0, 0), cB + PG8_KOFF(0, rbc), voffB); PG8_STAGE(PG8_SB(0, 1), cB + PG8_KOFF(0, rbc) + hstep, voffB); PG8_STAGE(PG8_SA(0, 0), cA + PG8_KOFF(0, rbc), voffA); PG8_STAGE(PG8_SA(0, 1), cA + PG8_KOFF(0, rbc) + hstep, voffA);
        if (wr == 1) PG8_BAR;
        PG8_WAIT_V(2); PG8_BAR;
        PG8_STAGE(PG8_SB(1, 0), cB + PG8_KOFF(1, rbc), voffB); PG8_STAGE(PG8_SA(1, 0), cA + PG8_KOFF(1, rbc), voffA); PG8_STAGE(PG8_SB(1, 1), cB + PG8_KOFF(1, rbc) + hstep, voffB);
        PG8_WAIT_V(6); PG8_BAR;
    } else {
        PG8_STAGE(PG8_SB(0, 0), cB + PG8_KOFF(0, rbc), voffB); PG8_STAGE(PG8_SA(0, 0), cA + PG8_KOFF(0, rbc), voffA); PG8_STAGE(PG8_SB(0, 1), cB + PG8_KOFF(0, rbc) + hstep, voffB); PG8_STAGE(PG8_SA(0, 1), cA + PG8_KOFF(0, rbc) + hstep, voffA);
        if (wr == 1) PG8_BAR;
        PG8_WAIT_V(4); PG8_BAR;
        PG8_STAGE(PG8_SB(1, 0), cB + PG8_KOFF(1, rbc), voffB); PG8_STAGE(PG8_SA(1, 0), cA + PG8_KOFF(1, rbc), voffA); PG8_STAGE(PG8_SB(1, 1), cB + PG8_KOFF(1, rbc) + hstep, voffB);
        PG8_WAIT_V(6); PG8_BAR;
    }
    for (;;) {
        const bool has_next = S.next(ui + 1, nxt);
        const char* nA = has_next ? (const char*)g.A + (size_t)nxt.pm * tstep : cA; const char* nB = has_next ? (const char*)g.Bt + (size_t)nxt.pn * tstep : cB;
        rbn = has_next ? (KROT ? PG8_ROT(nxt) : 0u) : rbc;
#pragma nounroll
        for (int t = 0; t < nt; t += 2) {
            const bool last = (t == nt - 2);
            const char* a1 = cA + PG8_KOFF(t + 1, rbc);
            const char* a2 = last ? nA + PG8_KOFF(0, rbn) : cA + PG8_KOFF(t + 2, rbc); const char* b2 = last ? nB + PG8_KOFF(0, rbn) : cB + PG8_KOFF(t + 2, rbc);
            const char* a3 = a2 + kstep; const char* b3 = b2 + kstep;
            if (last && has_next) S.a_ready(nxt);
            if constexpr (SP2) {
            PG8_LDB(B0, 0, 0); PG8_LDB(B1, 0, 1); PG8_SCHED; PG8_LDA(At, 0, 0); PG8_STAGE(PG8_SA(1, 1), a1 + hstep, voffA);
            PG8_WAIT_V(8); PG8_WAIT_L(0); PG8_BAR; PG8_MMA(0, 0, At, B0); PG8_MMA(0, 1, At, B1); PG8_BAR; PG8_SCHED;
            PG8_LDA(At, 0, 1); PG8_STAGE(PG8_SB(0, 0), b2, voffB); PG8_STAGE(PG8_SB(0, 1), b2 + hstep, voffB); PG8_STAGE(PG8_SA(0, 0), a2, voffA);
            PG8_WAIT_V(8); PG8_WAIT_L(0); PG8_BAR; PG8_MMA(1, 0, At, B0); PG8_MMA(1, 1, At, B1); PG8_BAR; PG8_SCHED;
            PG8_LDB(B0, 1, 0); PG8_LDB(B1, 1, 1); PG8_SCHED; PG8_LDA(At, 1, 0); PG8_STAGE(PG8_SA(0, 1), a2 + hstep, voffA);
            PG8_WAIT_V(8); PG8_WAIT_L(0); PG8_BAR; PG8_MMA(0, 0, At, B0); PG8_MMA(0, 1, At, B1); PG8_BAR; PG8_SCHED;
            PG8_LDA(At, 1, 1); PG8_STAGE(PG8_SB(1, 0), b3, voffB); PG8_STAGE(PG8_SB(1, 1), b3 + hstep, voffB); PG8_STAGE(PG8_SA(1, 0), a3, voffA);
            PG8_WAIT_V(8); PG8_WAIT_L(0); PG8_BAR; PG8_MMA(1, 0, At, B0); PG8_MMA(1, 1, At, B1); PG8_BAR; PG8_SCHED;
            } else {
            PG8_LDB(B0, 0, 0); PG8_SCHED; PG8_LDA(At, 0, 0); PG8_STAGE(PG8_SA(1, 1), a1 + hstep, voffA);
            PG8_WAIT_L(8); PG8_BAR; PG8_WAIT_L(0); PG8_MMA(0, 0, At, B0); PG8_BAR; PG8_SCHED;
            PG8_LDB(B1, 0, 1); PG8_STAGE(PG8_SB(0, 0), b2, voffB);
            PG8_BAR; PG8_WAIT_L(0); PG8_MMA(0, 1, At, B1); PG8_BAR;
            PG8_LDA(At, 0, 1); PG8_STAGE(PG8_SA(0, 0), a2, voffA);
            PG8_BAR; PG8_WAIT_L(0); PG8_MMA(1, 0, At, B0); PG8_BAR; PG8_SCHED;
            PG8_STAGE(PG8_SB(0, 1), b2 + hstep, voffB);
            PG8_WAIT_V(6); PG8_BAR; PG8_MMA(1, 1, At, B1); PG8_BAR;
            PG8_LDB(B0, 1, 0); PG8_SCHED; PG8_LDA(At, 1, 0); PG8_STAGE(PG8_SA(0, 1), a2 + hstep, voffA);
            PG8_WAIT_L(8); PG8_BAR; PG8_WAIT_L(0); PG8_MMA(0, 0, At, B0); PG8_BAR; PG8_SCHED;
            PG8_LDB(B1, 1, 1); PG8_STAGE(PG8_SB(1, 0), b3, voffB);
            PG8_BAR; PG8_WAIT_L(0); PG8_MMA(0, 1, At, B1); PG8_BAR;
            PG8_LDA(At, 1, 1); PG8_STAGE(PG8_SA(1, 0), a3, voffA);
            PG8_BAR; PG8_WAIT_L(0); PG8_MMA(1, 0, At, B0); PG8_BAR; PG8_SCHED;
            PG8_STAGE(PG8_SB(1, 1), b3 + hstep, voffB);
            PG8_WAIT_V(6); PG8_BAR; PG8_MMA(1, 1, At, B1); PG8_BAR;
            }
        }
        if constexpr (ALIGN_EPI) { if (wr == 0) PG8_BAR; }
        if constexpr (FP8) asm volatile("s_nop 15\n\ts_nop 15" ::: "memory");
        if constexpr (!Epi::AFTER_DRAIN) { if (E.mode != 2) E(acc, cur, wr, wc, fr, fq); if constexpr (Epi::DUP) { asm volatile("" ::: "memory"); E(acc, cur, wr, wc, fr, fq); } S.done(cur); }
        if (!has_next) break;
#pragma unroll
        for (int a = 0; a < 2; ++a)
#pragma unroll
            for (int b = 0; b < 2; ++b)
#pragma unroll
                for (int m = 0; m < 4; ++m)
#pragma unroll
                    for (int n = 0; n < 2; ++n) acc[a][b][m][n] = (f32x4){0.f, 0.f, 0.f, 0.f};
        cur = nxt; cA = nA; cB = nB; rbc = rbn; ++ui;
        if constexpr (ALIGN_EPI) { if (wr == 1) PG8_BAR; }
    }
    PG8_WAIT_V(0);
    if constexpr (!ALIGN_EPI) { if (wr == 0) PG8_BAR; }
    PG8_BAR;
    if constexpr (Epi::AFTER_DRAIN) { E.fused(acc, cur, wr, wc, fr, fq, lds, wid, lane); S.done(cur); }
#undef PG8_SA
#undef PG8_SB
#undef PG8_STAGE
#undef PG8_LDA
#undef PG8_LDB
#undef PG8_MMA
#undef PG8_WAIT_V
#undef PG8_ROT
#undef PG8_KOFF
#undef PG8_WAIT_L
#undef PG8_BAR
#undef PG8_SCHED
}
}

#define GAS __attribute__((address_space(1)))
#define LAS __attribute__((address_space(3)))
typedef unsigned short bf16;
typedef unsigned v4u __attribute__((ext_vector_type(4)));
typedef unsigned v2u __attribute__((ext_vector_type(2)));
typedef float f32x4 __attribute__((ext_vector_type(4)));
typedef short bf16x8 __attribute__((ext_vector_type(8)));
typedef GAS unsigned gu32;
typedef GAS unsigned long long gu64;
#define RLX_AGENT __ATOMIC_RELAXED, __HIP_MEMORY_SCOPE_AGENT
#define LDS_WAIT() asm volatile("s_waitcnt lgkmcnt(0)" ::: "memory")
#define VM_WAIT() asm volatile("s_waitcnt vmcnt(0)" ::: "memory")
__device__ __forceinline__ unsigned long long rt() { return __builtin_amdgcn_s_memrealtime(); }
__device__ __forceinline__ unsigned f2bf(float f) { unsigned u = __builtin_bit_cast(unsigned, f); return (u + 0x7fffu + ((u >> 16) & 1u)) >> 16; }
__device__ __forceinline__ unsigned pk2(float lo, float hi) { return f2bf(lo) | (f2bf(hi) << 16); }

#define XB_TMO      128
#define XB_XCNT(j)  (256  + 64 * (j))
#define XB_XSUB(j)  (1280 + 64 * (j))
#define XB_XGEN(j)  (2304 + 64 * (j))
#define XB_TOP      3328
#define XB_TOPGEN   3392
#define XCD_BAR_WORDS 3456
#define XB_SPIN_CAP (1u << 18)

__device__ __forceinline__ unsigned xb_ld(unsigned* p)              { return __hip_atomic_load(p, __ATOMIC_RELAXED, __HIP_MEMORY_SCOPE_AGENT); }
__device__ __forceinline__ unsigned xb_add(unsigned* p, unsigned v) { return __hip_atomic_fetch_add(p, v, __ATOMIC_RELAXED, __HIP_MEMORY_SCOPE_AGENT); }
__device__ __forceinline__ unsigned xb_xcc_id() { return (unsigned)__builtin_amdgcn_s_getreg((3 << 11) | 20) & 0xFu; }
#define XB_SPIN(cond, bar) do { unsigned _sp = 0; while (cond) { __builtin_amdgcn_s_sleep(1); \
    if ((++_sp & 255u) == 0u) { if (xb_ld(&(bar)[XB_TMO])) break; if (_sp > XB_SPIN_CAP) { atomicAdd(&(bar)[XB_TMO], 1u); break; } } } } while (0)

struct XcdBarrier {
    unsigned* bar; unsigned x;
    volatile LAS unsigned* st;
};

__device__ __forceinline__ XcdBarrier xcd_barrier_post(unsigned* bar, volatile LAS unsigned* st) {
    XcdBarrier b; b.bar = bar; b.x = xb_xcc_id(); b.st = st;
    if (threadIdx.x == 0) (void)xb_add(&bar[XB_XCNT(b.x)], 1u);
    return b;
}
__device__ __forceinline__ void xcd_barrier_complete(unsigned* bar, unsigned x, unsigned& nloc, unsigned& nx) {
    const unsigned G = gridDim.x * gridDim.y * gridDim.z;
    unsigned sum, cnt, mine, sp = 0u;
    for (;;) {
        sum = 0u; cnt = 0u; mine = 0u;
#pragma unroll
        for (unsigned j = 0; j < 16; ++j) { const unsigned c = xb_ld(&bar[XB_XCNT(j)]); sum += c; cnt += (c > 0u) ? 1u : 0u; mine = (j == x) ? c : mine; }
        if (sum == G) break;
        __builtin_amdgcn_s_sleep(1);
        if ((++sp & 255u) == 0u) { if (xb_ld(&bar[XB_TMO])) break; if (sp > XB_SPIN_CAP) { atomicAdd(&bar[XB_TMO], 1u); break; } }
    }
    nloc = mine > 0u ? mine : 1u; nx = cnt > 0u ? cnt : 1u;
}

__device__ __forceinline__ void xcd_barrier(const XcdBarrier& b) {
    asm volatile("s_waitcnt vmcnt(0)" ::: "memory");
    __syncthreads();
    if (threadIdx.x == 0) {
        unsigned* bar = b.bar;
        __builtin_amdgcn_s_waitcnt(0);
        unsigned nloc = b.st[0], nx = b.st[1];
        if (nloc == 0u) { xcd_barrier_complete(bar, b.x, nloc, nx); b.st[0] = nloc; b.st[1] = nx; }
        const unsigned old = xb_add(&bar[XB_XSUB(b.x)], 1u);
        const unsigned gen = old / nloc;
        if (old + 1u == (gen + 1u) * nloc) {
            __builtin_amdgcn_fence(__ATOMIC_RELEASE, "agent");
            asm volatile("s_waitcnt vmcnt(0)" ::: "memory");
            const unsigned og = xb_add(&bar[XB_TOP], 1u);
            const unsigned tg = og / nx;
            if (og + 1u == (tg + 1u) * nx) xb_add(&bar[XB_TOPGEN], 1u);
            else XB_SPIN(xb_ld(&bar[XB_TOPGEN]) == tg, bar);
            __builtin_amdgcn_fence(__ATOMIC_ACQUIRE, "agent");
            xb_add(&bar[XB_XGEN(b.x)], 1u);
            asm volatile("s_waitcnt vmcnt(0)" ::: "memory");
        } else {
            XB_SPIN(xb_ld(&bar[XB_XGEN(b.x)]) == gen, bar);
            __builtin_amdgcn_fence(__ATOMIC_ACQUIRE, "agent");
            asm volatile("s_waitcnt vmcnt(0)" ::: "memory");
        }
    }
    __syncthreads();
}


constexpr int NWAVES = 8;
constexpr int NTOK = 32768, D = 1024, NPROJ = 1792, NLAYER = 4, NEXP = 32, SEQ = 2048, NBATCH = 16, NMEM = 256;
constexpr float LN_EPS = 1e-5f, RMS_EPS = 1e-6f;
constexpr float DN_ALPHA = 1.6817928305074292f;
constexpr int XP_TILES = NTOK * 4 / 256 + NEXP;

constexpr size_t MiB = 1u << 20, TILE = 512 * 1024;
constexpr size_t WS_CTL = 0, CTL_ZERO_BYTES = 1 * MiB;
constexpr size_t WS_WMB = 1 * MiB;
constexpr size_t WS_POOLT = WS_WMB + 512 * 1024;
constexpr size_t WS_WRT = WS_POOLT + 128 * 1024;
constexpr int T_WIN = 4, T_WOUT = T_WIN + 28, T_WKV = T_WOUT + 16, T_MEMN = T_WKV + 8, T_HB = T_MEMN + 16, T_G = T_HB + 128, T_END = T_G + 128;
constexpr size_t QT = 256 * 1024;
constexpr size_t WS_W18 = (size_t)T_END * TILE;
constexpr size_t WS_W28 = WS_W18 + 256 * MiB;
constexpr size_t WS_H8 = WS_W28 + 128 * MiB;
constexpr size_t WS_XP8 = WS_H8 + 32 * MiB;
constexpr size_t WS_ACT8 = WS_XP8 + (size_t)XP_TILES * QT;
constexpr size_t WS_YS8 = WS_ACT8 + (size_t)XP_TILES * QT;
constexpr size_t WS_P = WS_YS8 + (size_t)XP_TILES * QT;
#define Q8(off) ((int)((off) / QT))
constexpr size_t WS_PRE = WS_P + 112 * MiB;
constexpr size_t WS_KB = WS_PRE + 64 * MiB;
constexpr size_t WS_VT = WS_KB + 8 * MiB;
constexpr size_t WS_TOKES = WS_VT + 8 * MiB;
constexpr size_t WS_TOKG = WS_TOKES + 512 * 1024;
constexpr size_t WS_ROWIDX = WS_TOKG + 512 * 1024;
constexpr size_t WS_NV_VN = WS_ROWIDX + 512 * 1024;
constexpr size_t WS_NV_DP = WS_NV_VN + 32 * MiB;
constexpr size_t WS_NV_Y = WS_NV_DP + 32 * MiB;
constexpr size_t WS_END = WS_NV_Y + 128 * MiB;
constexpr int CW_TMO = 0, CW_CODE = 1;
constexpr int CW_BAR = 4096;
constexpr int CW_CNT = 16384;
static_assert((CW_CNT + NLAYER * NEXP * 16) * 4 <= (int)CTL_ZERO_BYTES, "CTL words inside the memset region");
constexpr int RING_OFF = 0, RING_BYTES = 131072;
constexpr int LDSCTL_OFF = 163840 - 1024, MISC_OFF = LDSCTL_OFF + 320, TOFF_OFF = MISC_OFF + 128;
constexpr int LDS_BYTES = 163840;
static_assert(TOFF_OFF + 160 <= LDS_BYTES, "LDS map");

__device__ __forceinline__ float bf2f(unsigned short b) { return __builtin_bit_cast(float, (unsigned)b << 16); }
__device__ __forceinline__ float wave_sum(float v) {
#pragma unroll
    for (int o = 1; o < 64; o <<= 1) v += __shfl_xor(v, o);
    return v;
}
__device__ __forceinline__ float gelu_tanh(float x) {
    const float u = 0.7978845608028654f * (x + 0.044715f * x * x * x);
    return x * __builtin_amdgcn_rcpf(1.0f + __builtin_amdgcn_exp2f(u * (-2.0f * 1.4426950408889634f)));
}

struct Frame {
    LAS unsigned char* lds;
    volatile LAS unsigned* MISC;
    gu32* ctl;
    unsigned char* ws;
    int tid, lane, wave, G;
    float* out;
};
struct Args { const float* in[27]; float* out; unsigned char* ws; int ph_lo, ph_hi; };
enum { I_X = 0, I_MEM, I_LN_IN_G, I_LN_IN_B, I_MEM_LN_G, I_MEM_LN_B, I_W_IN, I_CONV_W, I_POOL_W, I_POOL_SCALE, I_GMLP_LN_G, I_GMLP_LN_B, I_GMLP_W, I_GMLP_B, I_W_MEM_KV, I_GROUP_NORM_G, I_W_OUT,
       I_LN1_G, I_LN1_B, I_W_ROUTER, I_B_ROUTER, I_W1, I_B1, I_W2, I_B2, I_LN2_G, I_LN2_B };
#define RELANE(F) do { int t_ = threadIdx.x; asm volatile("" : "+v"(t_)); (F).tid = t_; (F).lane = t_ & 63; (F).wave = __builtin_amdgcn_readfirstlane(t_ >> 6); } while (0)
#define WSP(T, off) ((T*)(F.ws + (off)))
#define TILEP(t) ((bf16*)(F.ws + (size_t)(t) * TILE))

__device__ __forceinline__ void tr64(const float* W, int ldw, int k0, int n0, bf16* WT, int ldt, int drow0, LAS float* scr, int lane) {
    const int c4 = 4 * (lane & 15), kq = lane >> 4;
#pragma unroll
    for (int i = 0; i < 16; ++i) { const int kk = 4 * i + kq; const f32x4 v = *(const f32x4*)(W + (size_t)(k0 + kk) * ldw + n0 + c4);
        LAS float* s = scr + kk * 65 + c4; s[0] = v.x; s[1] = v.y; s[2] = v.z; s[3] = v.w; }
    LDS_WAIT(); asm volatile("" ::: "memory");
    const int ck = lane & 7;
#pragma unroll
    for (int j = 0; j < 8; ++j) { const int n = (lane >> 3) + 8 * j; const LAS float* s = scr + (8 * ck) * 65 + n;
        v4u o; o.x = pk2(s[0 * 65], s[1 * 65]); o.y = pk2(s[2 * 65], s[3 * 65]); o.z = pk2(s[4 * 65], s[5 * 65]); o.w = pk2(s[6 * 65], s[7 * 65]);
        *(v4u*)(WT + (size_t)(drow0 + n) * ldt + k0 + 8 * ck) = o; }
    LDS_WAIT(); asm volatile("" ::: "memory");
}
struct Fp8Item { const float* src; unsigned char* dst; int ldw; float scale; };
__device__ __forceinline__ Fp8Item fp8_item(const Args& A, unsigned char* ws, int r) {
    constexpr int NI1 = NLAYER * NEXP * 8 * 64;
    Fp8Item it;
    if (r < NI1) { const int le = r >> 9, rr = r & 511, kb = rr >> 6, nb = rr & 63; const int n0 = 32 * nb, nn = n0 & 1023;
        const int drow = (nn >> 7) * 256 + (n0 >= 1024 ? 128 : 0) + (nn & 127);
        it.src = A.in[I_W1] + (size_t)le * 1024 * 2048 + (size_t)(128 * kb) * 2048 + n0; it.ldw = 2048; it.scale = 32.0f;
        it.dst = ws + WS_W18 + (size_t)le * 2048 * 1024 + (size_t)drow * 1024 + 128 * kb; }
    else { r -= NI1; const int le = r >> 8, rr = r & 255, kb = rr >> 5, nb = rr & 31;
        it.src = A.in[I_W2] + (size_t)le * 1024 * 1024 + (size_t)(128 * kb) * 1024 + 32 * nb; it.ldw = 1024; it.scale = 64.0f;
        it.dst = ws + WS_W28 + (size_t)le * 1024 * 1024 + (size_t)(32 * nb) * 1024 + 128 * kb; }
    return it;
}
__device__ __forceinline__ void fp8_load(f32x4 (&v)[16], const Fp8Item& it, int lane) {
    const float* p = it.src + (size_t)(lane >> 3) * it.ldw + 4 * (lane & 7);
#pragma unroll
    for (int i = 0; i < 16; ++i) v[i] = *(const f32x4*)(p + (size_t)(8 * i) * it.ldw);
}
__device__ __forceinline__ void fp8_store(const f32x4 (&v)[16], const Fp8Item& it, LAS float* scr, int lane) {
    const int c4 = 4 * (lane & 7), kr = lane >> 3;
#pragma unroll
    for (int i = 0; i < 16; ++i) { const int kk = 8 * i + kr; *(LAS f32x4*)(scr + ((kk & 15) * 8 + (kk >> 4)) * 36 + c4) = v[i] * it.scale; }
    LDS_WAIT(); asm volatile("" ::: "memory");
    const int ck = lane & 7, nl = lane >> 3;
#pragma unroll
    for (int j = 0; j < 4; ++j) { const int n = nl + 8 * j; const LAS float* s = scr + ck * 36 + n;
        v4u o;
        o.x = pg8::cvt4_fp8(s[0 * 288], s[1 * 288], s[2 * 288], s[3 * 288]); o.y = pg8::cvt4_fp8(s[4 * 288], s[5 * 288], s[6 * 288], s[7 * 288]);
        o.z = pg8::cvt4_fp8(s[8 * 288], s[9 * 288], s[10 * 288], s[11 * 288]); o.w = pg8::cvt4_fp8(s[12 * 288], s[13 * 288], s[14 * 288], s[15 * 288]);
        *(v4u*)(it.dst + (size_t)n * 1024 + 16 * ck) = o; }
    LDS_WAIT(); asm volatile("" ::: "memory");
}
#define BAR_LDS() do { asm volatile("s_waitcnt lgkmcnt(0)" ::: "memory"); __builtin_amdgcn_s_barrier(); asm volatile("" ::: "memory"); } while (0)
__device__ __forceinline__ f32x4 bf2lo(const v4u r) { f32x4 o; o.x = __builtin_bit_cast(float, r.x << 16); o.y = __builtin_bit_cast(float, r.x & 0xffff0000u); o.z = __builtin_bit_cast(float, r.y << 16); o.w = __builtin_bit_cast(float, r.y & 0xffff0000u); return o; }
__device__ __forceinline__ f32x4 bf2hi(const v4u r) { f32x4 o; o.x = __builtin_bit_cast(float, r.z << 16); o.y = __builtin_bit_cast(float, r.z & 0xffff0000u); o.z = __builtin_bit_cast(float, r.w << 16); o.w = __builtin_bit_cast(float, r.w & 0xffff0000u); return o; }
__device__ __forceinline__ v4u pack8(const f32x4 a, const f32x4 b) { v4u o; o.x = pg8::cvt_pk_bf16(a.x, a.y); o.y = pg8::cvt_pk_bf16(a.z, a.w); o.z = pg8::cvt_pk_bf16(b.x, b.y); o.w = pg8::cvt_pk_bf16(b.z, b.w); return o; }
struct LnPar { f32x4 g[4], b[4]; };
__device__ __forceinline__ void ln_load(LnPar& p, const float* gam, const float* bet, int lane) {
#pragma unroll
    for (int j = 0; j < 4; ++j) { const int o = 8 * lane + 512 * (j >> 1) + 4 * (j & 1); p.g[j] = *(const f32x4*)(gam + o); p.b[j] = *(const f32x4*)(bet + o); }
}
__device__ __forceinline__ void ln_affine(f32x4 (&v)[4], const LnPar& p) {
    float s = 0.f;
#pragma unroll
    for (int j = 0; j < 4; ++j) s += (v[j].x + v[j].y) + (v[j].z + v[j].w);
    const float mean = wave_sum(s) * (1.f / 1024.f); float s2 = 0.f;
#pragma unroll
    for (int j = 0; j < 4; ++j) { v[j] = v[j] - mean; s2 += (v[j].x * v[j].x + v[j].y * v[j].y) + (v[j].z * v[j].z + v[j].w * v[j].w); }
    const float rstd = 1.f / sqrtf(wave_sum(s2) * (1.f / 1024.f) + LN_EPS);
#pragma unroll
    for (int j = 0; j < 4; ++j) v[j] = v[j] * rstd * p.g[j] + p.b[j];
}
__device__ __forceinline__ void p0_prologue(Frame& F, const Args& A) {
    RELANE(F);
    LAS float* scr = (LAS float*)(F.lds + RING_OFF + F.wave * 18432);
    const int gw = blockIdx.x * NWAVES + F.wave, NGW = F.G * NWAVES;
    constexpr int NI_W1 = NLAYER * NEXP * 16 * 32, NI_W2 = NLAYER * NEXP * 16 * 16, NI_WIN = NLAYER * 16 * 28, NI_WOUT = NLAYER * 16 * 16, NI_WKV = NLAYER * 16 * 8, NI_POOL = NLAYER * 4;
    constexpr int NITEMS = NI_W1 + NI_W2 + NI_WIN + NI_WOUT + NI_WKV + NI_POOL;
    {
        constexpr int NF = NI_W1 + NI_W2;
        int r = gw; f32x4 cur[16]; Fp8Item ic = fp8_item(A, F.ws, r < NF ? r : 0);
        if (r < NF) fp8_load(cur, ic, F.lane);
        while (r < NF) {
            const int rn = r + NGW; f32x4 nxt[16]; const Fp8Item in_ = fp8_item(A, F.ws, rn < NF ? rn : r);
            if (rn < NF) fp8_load(nxt, in_, F.lane);
            fp8_store(cur, ic, scr, F.lane);
#pragma unroll
            for (int i = 0; i < 16; ++i) cur[i] = nxt[i];
            ic = in_; r = rn;
        }
    }
    for (int it = gw; it < NITEMS - NI_W1 - NI_W2; it += NGW) {
        int r = it;
        if (r < NI_WIN) { const int l = r / 448, rr = r % 448, kb = rr / 28, nb = rr % 28;
            tr64(A.in[I_W_IN] + (size_t)l * 1024 * NPROJ, NPROJ, 64 * kb, 64 * nb, TILEP(T_WIN) + (size_t)l * NPROJ * 1024, 1024, 64 * nb, scr, F.lane); continue; } r -= NI_WIN;
        if (r < NI_WOUT) { const int l = r >> 8, rr = r & 255, kb = rr >> 4, nb = rr & 15;
            tr64(A.in[I_W_OUT] + (size_t)l * 1024 * 1024, 1024, 64 * kb, 64 * nb, TILEP(T_WOUT) + (size_t)l * 1024 * 1024, 1024, 64 * nb, scr, F.lane); continue; } r -= NI_WOUT;
        if (r < NI_WKV) { const int l = r >> 7, rr = r & 127, kb = rr >> 3, nb = rr & 7;
            tr64(A.in[I_W_MEM_KV] + (size_t)l * 1024 * 512, 512, 64 * kb, 64 * nb, TILEP(T_WKV) + (size_t)l * 512 * 1024, 1024, 64 * nb, scr, F.lane); continue; } r -= NI_WKV;
        tr64(A.in[I_POOL_W] + (size_t)r * 64 * 64, 64, 0, 0, WSP(bf16, WS_POOLT) + (size_t)r * 64 * 64, 64, 0, scr, F.lane);
    }
    const int gt = blockIdx.x * (NWAVES * 64) + F.tid, NGT = F.G * NWAVES * 64;
    for (int i = gt; i < NLAYER * 4 * 128 * 128; i += NGT) { const int j = i & 127, ii = (i >> 7) & 127; WSP(bf16, WS_WMB)[i] = (bf16)(((j >> 6) <= (ii >> 6)) ? f2bf(A.in[I_GMLP_W][i]) : 0u); }
    for (int i = gt; i < NLAYER * 32 * 1024; i += NGT) { const int k = i & 1023, e = (i >> 10) & 31, l = i >> 15; WSP(bf16, WS_WRT)[i] = (bf16)f2bf(A.in[I_W_ROUTER][((size_t)l * 1024 + k) * 32 + e]); }
    LnPar px, pm; ln_load(px, A.in[I_LN_IN_G], A.in[I_LN_IN_B], F.lane); ln_load(pm, A.in[I_MEM_LN_G], A.in[I_MEM_LN_B], F.lane);
    for (int m = gw; m < NTOK + NBATCH * NMEM; m += NGW) {
        const bool ismem = m >= NTOK; const int row = ismem ? m - NTOK : m;
        const float* src = (ismem ? A.in[I_MEM] : A.in[I_X]) + (size_t)row * D + 8 * F.lane;
        f32x4 v[4]; v[0] = *(const f32x4*)(src); v[1] = *(const f32x4*)(src + 4); v[2] = *(const f32x4*)(src + 512); v[3] = *(const f32x4*)(src + 516);
        if (ismem) ln_affine(v, pm); else ln_affine(v, px);
        bf16* dst = (ismem ? TILEP(T_MEMN) : TILEP(T_HB)) + (size_t)row * D + 8 * F.lane;
        *(v4u*)dst = pack8(v[0], v[1]); *(v4u*)(dst + 512) = pack8(v[2], v[3]);
    }
}

struct DenseOrder {
    int nM, nN, G, c, a_t0, b_t0;
    __device__ __forceinline__ bool next(int i, pg8::Unit& u) const {
        const long L = (long)i * G + c; if (L >= (long)nM * nN) return false;
        int tm, tn; pg8::tile_of((int)L, nM, nN, tm, tn); u.pm = a_t0 + tm; u.pn = b_t0 + tn; u.lm = tm; u.ln = tn; u.a0 = 0; return true;
    }
    __device__ __forceinline__ void a_ready(const pg8::Unit&) const {}
    __device__ __forceinline__ void done(const pg8::Unit&) const {}
};
struct KvOrder {
    int G, c;
    __device__ __forceinline__ bool next(int i, pg8::Unit& u) const {
        const int L = i * G + c; if (L >= NLAYER * 32) return false;
        const int l = L >> 5, r = L & 31;
        if (r < 16) { u.pm = T_MEMN + r; u.pn = T_WKV + 2 * l; u.lm = l * 16 + r; u.ln = 0; u.a0 = 0; }
        else { u.pm = T_WKV + 2 * l + 1; u.pn = T_MEMN + (r - 16); u.lm = l; u.ln = r - 16; u.a0 = 1; }
        return true;
    }
    __device__ __forceinline__ void a_ready(const pg8::Unit&) const {}
    __device__ __forceinline__ void done(const pg8::Unit&) const {}
};
struct MoeOrder {
    int TM, NTN, G, c, a_t0, b_t0; const LAS int* toff;
    __device__ __forceinline__ bool next(int i, pg8::Unit& u) const {
        const long L = (long)i * G + c; if (L >= (long)TM * NTN) return false;
        int tm, tn; pg8::tile_of((int)L, TM, NTN, tm, tn);
        int e = 0;
#pragma unroll
        for (int j = 1; j < NEXP; ++j) e += (toff[j] <= tm) ? 1 : 0;
        e = __builtin_amdgcn_readfirstlane(e);
        u.pm = a_t0 + tm; u.pn = b_t0 + e * NTN + tn; u.lm = tm; u.ln = tn; u.a0 = e; return true;
    }
    __device__ __forceinline__ void a_ready(const pg8::Unit&) const {}
    __device__ __forceinline__ void done(const pg8::Unit&) const {}
};
__device__ __forceinline__ void compute_toff(Frame& F, int l) {
    RELANE(F);
    LAS int* toff = (LAS int*)(F.lds + TOFF_OFF);
    __syncthreads();
    if (F.wave == 0) {
        int t = 0;
        if (F.lane < NEXP) { const unsigned c = __hip_atomic_load(F.ctl + CW_CNT + (l * NEXP + F.lane) * 16, RLX_AGENT); t = (int)((c + 255u) >> 8); }
        int incl = t;
#pragma unroll
        for (int o = 1; o < 32; o <<= 1) { const int y = __shfl_up(incl, o); if ((F.lane & 31) >= o) incl += y; }
        if (F.lane < NEXP) toff[F.lane + 1] = incl;
        if (F.lane == 0) toff[0] = 0;
    }
    __syncthreads();
}

__device__ __forceinline__ void pd_phase(Frame& F, const Args& A, int l, bool probe = false) {
    RELANE(F);
    LAS float* lgam = (LAS float*)(F.lds);
    LAS float* lbet = lgam + 1024;
    LAS int* cntl = (LAS int*)(F.lds + 8192);
    LAS int* basel = cntl + 32;
    LAS int* sel_e = basel + 32;
    LAS int* sel_r = sel_e + 512; LAS float* sel_g = (LAS float*)(sel_r + 512);
    const bf16* wr = WSP(bf16, WS_WRT) + (size_t)l * NEXP * D; const float* br = A.in[I_B_ROUTER] + l * NEXP;
    const bf16* pre = WSP(bf16, WS_PRE); bf16* hb = TILEP(T_HB); unsigned char* h8 = F.ws + WS_H8;
    const int m = F.lane & 15, g = F.lane >> 4;
    for (int i = F.tid; i < D; i += NWAVES * 64) { lgam[i] = A.in[I_LN1_G][l * D + i]; lbet[i] = A.in[I_LN1_B][l * D + i]; }
    const float br0 = br[m], br1 = br[16 + m];
    for (int blk = blockIdx.x; blk < NTOK / 128; blk += F.G) {
        if (F.tid < NEXP) cntl[F.tid] = 0;
        const size_t row = (size_t)blk * 128 + F.wave * 16 + m;
        const bf16* prow = pre + row * D + 16 * g;
        v4u raw[16][2];
#pragma unroll
        for (int j = 0; j < 16; ++j) { raw[j][0] = *(const v4u*)(prow + 64 * j); raw[j][1] = *(const v4u*)(prow + 64 * j + 8); }
        BAR_LDS();
        float s = 0.f;
#pragma unroll
        for (int j = 0; j < 16; ++j)
#pragma unroll
            for (int hf = 0; hf < 2; ++hf) { const f32x4 a = bf2lo(raw[j][hf]), b = bf2hi(raw[j][hf]); s += ((a.x + a.y) + (a.z + a.w)) + ((b.x + b.y) + (b.z + b.w)); }
#pragma unroll
        for (int j = 0; j < 16; ++j) asm volatile("" : "+v"(raw[j][0]), "+v"(raw[j][1]));
        s += __shfl_xor(s, 16); s += __shfl_xor(s, 32);
        const float mean = s * (1.f / 1024.f); float s2 = 0.f;
#pragma unroll
        for (int j = 0; j < 16; ++j)
#pragma unroll
            for (int hf = 0; hf < 2; ++hf) { const f32x4 a = bf2lo(raw[j][hf]) - mean, b = bf2hi(raw[j][hf]) - mean; s2 += ((a.x * a.x + a.y * a.y) + (a.z * a.z + a.w * a.w)) + ((b.x * b.x + b.y * b.y) + (b.z * b.z + b.w * b.w)); }
#pragma unroll
        for (int j = 0; j < 16; ++j) asm volatile("" : "+v"(raw[j][0]), "+v"(raw[j][1]));
        s2 += __shfl_xor(s2, 16); s2 += __shfl_xor(s2, 32);
        const float rstd = 1.f / sqrtf(s2 * (1.f / 1024.f) + LN_EPS);
        f32x4 a0 = {0.f, 0.f, 0.f, 0.f}, a1 = {0.f, 0.f, 0.f, 0.f};
        bf16* hrow = hb + row * D + 16 * g; unsigned char* qrow = h8 + row * D + 16 * g;
#pragma unroll
        for (int j = 0; j < 16; ++j) {
            v4u o[2]; v4u q8;
#pragma unroll
            for (int hf = 0; hf < 2; ++hf) { const int c = 64 * j + 16 * g + 8 * hf;
                const f32x4 ga = *(const LAS f32x4*)(lgam + c), gb = *(const LAS f32x4*)(lgam + c + 4), ba = *(const LAS f32x4*)(lbet + c), bb = *(const LAS f32x4*)(lbet + c + 4);
                const f32x4 ya = (bf2lo(raw[j][hf]) - mean) * rstd * ga + ba, yb = (bf2hi(raw[j][hf]) - mean) * rstd * gb + bb;
                o[hf] = pack8(ya, yb);
                const unsigned qa = pg8::cvt4_fp8(ya.x * 16.0f, ya.y * 16.0f, ya.z * 16.0f, ya.w * 16.0f), qb = pg8::cvt4_fp8(yb.x * 16.0f, yb.y * 16.0f, yb.z * 16.0f, yb.w * 16.0f);
                if (hf == 0) { q8.x = qa; q8.y = qb; } else { q8.z = qa; q8.w = qb; } }
            *(v4u*)(hrow + 64 * j) = o[0]; *(v4u*)(hrow + 64 * j + 8) = o[1]; *(v4u*)(qrow + 64 * j) = q8;
            const bf16* w0 = wr + (size_t)m * D + 64 * j + 16 * g; const bf16* w1 = w0 + 16 * D;
            const bf16x8 b00 = *(const bf16x8*)w0, b01 = *(const bf16x8*)(w0 + 8), b10 = *(const bf16x8*)w1, b11 = *(const bf16x8*)(w1 + 8);
            a0 = __builtin_amdgcn_mfma_f32_16x16x32_bf16(__builtin_bit_cast(bf16x8, o[0]), b00, a0, 0, 0, 0); a0 = __builtin_amdgcn_mfma_f32_16x16x32_bf16(__builtin_bit_cast(bf16x8, o[1]), b01, a0, 0, 0, 0);
            a1 = __builtin_amdgcn_mfma_f32_16x16x32_bf16(__builtin_bit_cast(bf16x8, o[0]), b10, a1, 0, 0, 0); a1 = __builtin_amdgcn_mfma_f32_16x16x32_bf16(__builtin_bit_cast(bf16x8, o[1]), b11, a1, 0, 0, 0);
            if (j & 1) { asm volatile("" ::: "memory"); __builtin_amdgcn_sched_barrier(0); }
        }
#pragma unroll
        for (int i = 0; i < 4; ++i) {
            float c0 = a0[i] + br0, c1 = a1[i] + br1; float tv[4]; int ti[4];
#pragma unroll
            for (int k = 0; k < 4; ++k) {
                float bv = (c0 >= c1) ? c0 : c1; int be = (c0 >= c1) ? m : 16 + m;
#pragma unroll
                for (int off = 1; off < 16; off <<= 1) { const float ov = __shfl_xor(bv, off); const int oe = __shfl_xor(be, off); const bool take = (ov > bv) || (ov == bv && oe < be); bv = take ? ov : bv; be = take ? oe : be; }
                tv[k] = bv; ti[k] = be;
                c0 = (be == m) ? -3.0e38f : c0; c1 = (be == 16 + m) ? -3.0e38f : c1;
            }
            if (m == 0) {
                float ex[4], sum = 0.f;
#pragma unroll
                for (int k = 0; k < 4; ++k) { ex[k] = __expf(tv[k] - tv[0]); sum += ex[k]; }
                const float inv = 1.0f / sum;
#pragma unroll
                for (int k = 0; k < 4; ++k) { const int p = (F.wave * 16 + 4 * g + i) * 4 + k; sel_e[p] = ti[k]; sel_r[p] = __hip_atomic_fetch_add(cntl + ti[k], 1, __ATOMIC_RELAXED, __HIP_MEMORY_SCOPE_WORKGROUP); sel_g[p] = ex[k] * inv; }
            }
        }
        BAR_LDS();
        if (F.tid < NEXP) basel[F.tid] = probe ? 0 : (int)__hip_atomic_fetch_add(F.ctl + CW_CNT + (l * NEXP + F.tid) * 16, (unsigned)cntl[F.tid], RLX_AGENT);
        BAR_LDS();
        if (!probe) { const int p = F.tid, e = sel_e[p], slot = basel[e] + sel_r[p];
          WSP(int, WS_TOKES)[(size_t)blk * 512 + p] = (e << 16) | slot; WSP(float, WS_TOKG)[(size_t)blk * 512 + p] = sel_g[p]; }
        BAR_LDS();
    }
}
__device__ __forceinline__ void pe_phase(Frame& F, int l) {
    RELANE(F);
    compute_toff(F, l);
    const LAS int* toff = (const LAS int*)(F.lds + TOFF_OFF);
    const unsigned char* h8 = F.ws + WS_H8; unsigned char* xp = F.ws + WS_XP8;
    for (int blk = blockIdx.x; blk < NTOK / 128; blk += F.G) {
        const int p0 = blk * 512 + F.wave * 64;
        const int es = WSP(int, WS_TOKES)[p0 + F.lane];
        const int rowl = toff[es >> 16] * 256 + (es & 0xffff);
        WSP(int, WS_ROWIDX)[p0 + F.lane] = rowl;
#pragma unroll 8
        for (int p = 0; p < 64; ++p) { const int row = __shfl(rowl, p); const int t = (p0 + p) >> 2;
            const v4u a = *(const v4u*)(h8 + (size_t)t * D + 16 * F.lane);
            *(v4u*)(xp + (size_t)row * D + 16 * F.lane) = a; }
    }
}
__device__ __forceinline__ void acc8_fp8(f32x4& a, f32x4& b, const v2u q, const float g) {
    typedef float f2v __attribute__((ext_vector_type(2)));
    const f2v p0 = __builtin_amdgcn_cvt_pk_f32_fp8((int)q.x, false), p1 = __builtin_amdgcn_cvt_pk_f32_fp8((int)q.x, true), p2 = __builtin_amdgcn_cvt_pk_f32_fp8((int)q.y, false), p3 = __builtin_amdgcn_cvt_pk_f32_fp8((int)q.y, true);
    a.x += g * p0.x; a.y += g * p0.y; a.z += g * p1.x; a.w += g * p1.y; b.x += g * p2.x; b.y += g * p2.y; b.z += g * p3.x; b.w += g * p3.y;
}
__device__ __forceinline__ void ph_phase(Frame& F, const Args& A, int l, bool probe = false) {
    RELANE(F);
    const int gw = blockIdx.x * NWAVES + F.wave, NGW = F.G * NWAVES;
    LnPar lp; ln_load(lp, A.in[I_LN2_G] + l * D, A.in[I_LN2_B] + l * D, F.lane);
    bf16* hb = TILEP(T_HB); const unsigned char* ys = F.ws + WS_YS8;
    for (int t0 = gw * 16; t0 < NTOK; t0 += NGW * 16) {
        const int ri = WSP(int, WS_ROWIDX)[(size_t)t0 * 4 + F.lane]; const float gk = WSP(float, WS_TOKG)[(size_t)t0 * 4 + F.lane] * (1.0f / 64.0f);
#pragma nounroll
        for (int i = 0; i < 16; i += 4) {
            v4u hr[4][2]; v2u yr[4][4][2];
#pragma unroll
            for (int rr = 0; rr < 4; ++rr) { const bf16* hp = hb + (size_t)(t0 + i + rr) * D + 8 * F.lane; hr[rr][0] = *(const v4u*)hp; hr[rr][1] = *(const v4u*)(hp + 512);
#pragma unroll
                for (int k = 0; k < 4; ++k) { const int row = __shfl(ri, 4 * (i + rr) + k); const unsigned char* yp = ys + (size_t)row * D + 8 * F.lane; yr[rr][k][0] = *(const v2u*)yp; yr[rr][k][1] = *(const v2u*)(yp + 512); } }
#pragma unroll
            for (int rr = 0; rr < 4; ++rr) { const int t = t0 + i + rr;
                f32x4 v[4]; v[0] = bf2lo(hr[rr][0]) * DN_ALPHA; v[1] = bf2hi(hr[rr][0]) * DN_ALPHA; v[2] = bf2lo(hr[rr][1]) * DN_ALPHA; v[3] = bf2hi(hr[rr][1]) * DN_ALPHA;
#pragma unroll
                for (int k = 0; k < 4; ++k) { const float g = __shfl(gk, 4 * (i + rr) + k); acc8_fp8(v[0], v[1], yr[rr][k][0], g); acc8_fp8(v[2], v[3], yr[rr][k][1], g); }
                ln_affine(v, lp);
                if (probe) { bf16* op = WSP(bf16, WS_PRE) + (size_t)t * D + 8 * F.lane; *(v4u*)op = pack8(v[0], v[1]); *(v4u*)(op + 512) = pack8(v[2], v[3]); }
                else if (l == NLAYER - 1) { float* op = F.out + (size_t)t * D + 8 * F.lane; *(f32x4*)op = v[0]; *(f32x4*)(op + 4) = v[1]; *(f32x4*)(op + 512) = v[2]; *(f32x4*)(op + 516) = v[3]; }
                else { bf16* op = hb + (size_t)t * D + 8 * F.lane; *(v4u*)op = pack8(v[0], v[1]); *(v4u*)(op + 512) = pack8(v[2], v[3]); } }
        }
    }
}

constexpr int MX_VT = 0, MX_K = 65536, MX_V = 65536 + 32768;
__device__ __forceinline__ void unpack8(const v4u raw, float (&f)[8]) {
    f[0] = __builtin_bit_cast(float, raw.x << 16); f[1] = __builtin_bit_cast(float, raw.x & 0xffff0000u); f[2] = __builtin_bit_cast(float, raw.y << 16); f[3] = __builtin_bit_cast(float, raw.y & 0xffff0000u);
    f[4] = __builtin_bit_cast(float, raw.z << 16); f[5] = __builtin_bit_cast(float, raw.z & 0xffff0000u); f[6] = __builtin_bit_cast(float, raw.w << 16); f[7] = __builtin_bit_cast(float, raw.w & 0xffff0000u);
}
__device__ __forceinline__ void mix_finish(float (&val)[8][8], const float* gain, bf16* grow, int q) {
    float ss = 0.f;
#pragma unroll
    for (int cb = 0; cb < 8; ++cb)
#pragma unroll
        for (int i = 0; i < 8; ++i) ss += val[cb][i] * val[cb][i];
    ss += __shfl_xor(ss, 16); ss += __shfl_xor(ss, 32);
    const float rs = 1.0f / sqrtf(ss * (1.0f / 256.0f) + RMS_EPS);
#pragma unroll
    for (int cb = 0; cb < 8; ++cb) { const f32x4 g0 = *(const f32x4*)(gain + 32 * cb + 8 * q), g1 = *(const f32x4*)(gain + 32 * cb + 8 * q + 4);
        v4u o; o.x = pk2(val[cb][0] * rs * g0.x, val[cb][1] * rs * g0.y); o.y = pk2(val[cb][2] * rs * g0.z, val[cb][3] * rs * g0.w);
        o.z = pk2(val[cb][4] * rs * g1.x, val[cb][5] * rs * g1.y); o.w = pk2(val[cb][6] * rs * g1.z, val[cb][7] * rs * g1.w);
        *(v4u*)(grow + 32 * cb + 8 * q) = o; }
}
__device__ __forceinline__ void pb_phase(Frame& F, const Args& A, int l) {
    for (int u = blockIdx.x; u < NTOK / 128; u += F.G) {
    RELANE(F);
    const int r = F.lane & 15, q = F.lane >> 4, w = F.wave;
    const bf16* P = WSP(bf16, WS_P); bf16* G = TILEP(T_G);
    const float* gng = A.in[I_GROUP_NORM_G] + l * 1024;
        const int row = u * 128 + 16 * w + r, tseq = (u & 15) * 128 + 16 * w + r, b = u >> 4;
        const bf16* prow = P + (size_t)row * NPROJ; bf16* grow = G + (size_t)row * 1024;
        float val[8][8];
#if MXMASK & 1
        {
            const float* cw = A.in[I_CONV_W] + l * 768;
#pragma unroll
            for (int cb = 0; cb < 8; ++cb) { const int col = 32 * cb + 8 * q;
                float gb[8], zc[8], zh[8], z[8], acc[8];
                unpack8(*(const v4u*)(prow + col), gb);
#pragma unroll
                for (int i = 0; i < 8; ++i) acc[i] = 0.f;
#pragma unroll
                for (int d = 0; d < 3; ++d) {
                    if (tseq - 2 + d >= 0) { const bf16* pr = prow - (size_t)(2 - d) * NPROJ;
                        unpack8(*(const v4u*)(pr + 256 + col), zc); unpack8(*(const v4u*)(pr + 512 + col), zh);
                        const f32x4 w0 = *(const f32x4*)(cw + d * 256 + col), w1 = *(const f32x4*)(cw + d * 256 + col + 4);
#pragma unroll
                        for (int i = 0; i < 8; ++i) z[i] = zc[i] * zh[i];
                        acc[0] += w0.x * z[0]; acc[1] += w0.y * z[1]; acc[2] += w0.z * z[2]; acc[3] += w0.w * z[3]; acc[4] += w1.x * z[4]; acc[5] += w1.y * z[5]; acc[6] += w1.z * z[6]; acc[7] += w1.w * z[7]; } }
#pragma unroll
                for (int i = 0; i < 8; ++i) val[cb][i] = gb[i] * acc[i];
                asm volatile("" ::: "memory"); }
            mix_finish(val, gng, grow, q);
        }
#endif
        asm volatile("" ::: "memory"); __builtin_amdgcn_sched_barrier(0);
#if MXMASK & 2
        {
            const bf16* pt = WSP(bf16, WS_POOLT) + (size_t)l * 4 * 4096;
            bf16x8 dfr[4][2];
#pragma unroll
            for (int g = 0; g < 4; ++g)
#pragma unroll
                for (int ks = 0; ks < 2; ++ks) { const int col = 768 + g * 64 + 32 * ks + 8 * q, wlen = 2 << g;
                    float acc[8], x[8], t8[8];
                    unpack8(*(const v4u*)(prow + col), x);
#pragma unroll
                    for (int i = 0; i < 8; ++i) acc[i] = x[i];
                    for (int d = 1; d < wlen; ++d) if (tseq - d >= 0) { unpack8(*(const v4u*)(prow - (size_t)d * NPROJ + col), t8);
#pragma unroll
                        for (int i = 0; i < 8; ++i) acc[i] += t8[i]; }
                    const float inv = 1.0f / (float)((tseq + 1 < wlen) ? tseq + 1 : wlen);
                    v4u o; o.x = pk2(acc[0] * inv - x[0], acc[1] * inv - x[1]); o.y = pk2(acc[2] * inv - x[2], acc[3] * inv - x[3]);
                    o.z = pk2(acc[4] * inv - x[4], acc[5] * inv - x[5]); o.w = pk2(acc[6] * inv - x[6], acc[7] * inv - x[7]);
                    dfr[g][ks] = __builtin_bit_cast(bf16x8, o);
                    asm volatile("" ::: "memory"); }
            const float* psc = A.in[I_POOL_SCALE] + l * 256;
#pragma unroll
            for (int g = 0; g < 4; ++g)
#pragma unroll
                for (int mt2 = 0; mt2 < 2; ++mt2) { const f32x4 s0 = *(const f32x4*)(psc + g * 64 + 32 * mt2 + 8 * q), s1 = *(const f32x4*)(psc + g * 64 + 32 * mt2 + 8 * q + 4);
#pragma unroll
                    for (int e = 0; e < 2; ++e) { const int dd = 32 * mt2 + 8 * (r >> 2) + 4 * e + (r & 3);
                        f32x4 o = {0.f, 0.f, 0.f, 0.f};
#pragma unroll
                        for (int ks = 0; ks < 2; ++ks) { const bf16x8 a = *(const bf16x8*)(pt + (size_t)(g * 64 + dd) * 64 + 32 * ks + 8 * q);
                            o = __builtin_amdgcn_mfma_f32_16x16x32_bf16(a, dfr[g][ks], o, 0, 0, 0); }
                        const f32x4 sc = e ? s1 : s0;
                        val[2 * g + mt2][4 * e + 0] = o[0] * sc.x; val[2 * g + mt2][4 * e + 1] = o[1] * sc.y; val[2 * g + mt2][4 * e + 2] = o[2] * sc.z; val[2 * g + mt2][4 * e + 3] = o[3] * sc.w; } }
            mix_finish(val, gng + 256, grow + 256, q);
        }
#endif
        asm volatile("" ::: "memory"); __builtin_amdgcn_sched_barrier(0);
#if MXMASK & 4
        {
            const float* lg = A.in[I_GMLP_LN_G] + l * 256; const float* lb = A.in[I_GMLP_LN_B] + l * 256;
            const f32x4 g4 = *(const f32x4*)(lg + 4 * F.lane), b4 = *(const f32x4*)(lb + 4 * F.lane);
            const int hh_l = F.lane >> 4, mt2_l = (F.lane & 15) >> 3, q_l = (F.lane & 7) >> 1, e_l = F.lane & 1;
#pragma unroll 2
            for (int jp = 0; jp < 8; ++jp) { const int j = 16 * w + 2 * jp;
                const bf16* p0 = P + (size_t)(u * 128 + j) * NPROJ + 1280 + 4 * F.lane;
                const v2u ra = *(const v2u*)p0, rb = *(const v2u*)(p0 + NPROJ);
                float va[4], vb[4];
                va[0] = gelu_tanh(__builtin_bit_cast(float, ra.x << 16)); va[1] = gelu_tanh(__builtin_bit_cast(float, ra.x & 0xffff0000u)); va[2] = gelu_tanh(__builtin_bit_cast(float, ra.y << 16)); va[3] = gelu_tanh(__builtin_bit_cast(float, ra.y & 0xffff0000u));
                vb[0] = gelu_tanh(__builtin_bit_cast(float, rb.x << 16)); vb[1] = gelu_tanh(__builtin_bit_cast(float, rb.x & 0xffff0000u)); vb[2] = gelu_tanh(__builtin_bit_cast(float, rb.y << 16)); vb[3] = gelu_tanh(__builtin_bit_cast(float, rb.y & 0xffff0000u));
                const float ma = wave_sum((va[0] + va[1]) + (va[2] + va[3])) * (1.f / 256.f), mb = wave_sum((vb[0] + vb[1]) + (vb[2] + vb[3])) * (1.f / 256.f);
                float sa = 0.f, sb = 0.f;
#pragma unroll
                for (int c = 0; c < 4; ++c) { va[c] -= ma; vb[c] -= mb; sa += va[c] * va[c]; sb += vb[c] * vb[c]; }
                const float ra_ = 1.f / sqrtf(wave_sum(sa) * (1.f / 256.f) + LN_EPS), rb_ = 1.f / sqrtf(wave_sum(sb) * (1.f / 256.f) + LN_EPS);
                const int ks = j >> 5, gg = (j & 31) >> 3, jj = j & 7;
                LAS unsigned char* dst = F.lds + MX_VT + ((((hh_l * 2 + mt2_l) * 2 + e_l) * 4 + ks) * 64 + 16 * gg + 4 * q_l) * 16 + jj * 2;
                const float ga[4] = {g4.x, g4.y, g4.z, g4.w}, ba[4] = {b4.x, b4.y, b4.z, b4.w};
#pragma unroll
                for (int c = 0; c < 4; ++c) *(LAS unsigned*)(dst + c * 16) = pk2(va[c] * ra_ * ga[c] + ba[c], vb[c] * rb_ * ga[c] + ba[c]);
            }
            __syncthreads();
            const bf16* wm = WSP(bf16, WS_WMB) + (size_t)l * 4 * 128 * 128; const float* gbias = A.in[I_GMLP_B] + l * 512;
            const int nks = (w < 4) ? 2 : 4;
#pragma unroll
            for (int hh = 0; hh < 4; ++hh) {
                bf16x8 wf[4];
#pragma unroll
                for (int ks = 0; ks < 4; ++ks) wf[ks] = *(const bf16x8*)(wm + (size_t)(hh * 128 + 16 * w + r) * 128 + 32 * ks + 8 * q);
                const float bias = gbias[hh * 128 + 16 * w + r];
#pragma unroll
                for (int mt2 = 0; mt2 < 2; ++mt2) {
                    float uu[8]; unpack8(*(const v4u*)(prow + 1024 + hh * 64 + 32 * mt2 + 8 * q), uu);
#pragma unroll
                    for (int e = 0; e < 2; ++e) { f32x4 o = {0.f, 0.f, 0.f, 0.f};
#pragma unroll
                        for (int ks = 0; ks < 4; ++ks) if (ks < nks) { const bf16x8 a = *(const LAS bf16x8*)(F.lds + MX_VT + ((((hh * 2 + mt2) * 2 + e) * 4 + ks) * 64 + F.lane) * 16);
                            o = __builtin_amdgcn_mfma_f32_16x16x32_bf16(a, wf[ks], o, 0, 0, 0); }
#pragma unroll
                        for (int i = 0; i < 4; ++i) val[2 * hh + mt2][4 * e + i] = gelu_tanh(uu[4 * e + i]) * (o[i] + bias); } }
            }
            mix_finish(val, gng + 512, grow + 512, q);
        }
#endif
        asm volatile("" ::: "memory"); __builtin_amdgcn_sched_barrier(0);
#if MXMASK & 8
        {
            const bf16* kb = WSP(bf16, WS_KB) + ((size_t)l * 4096 + (size_t)b * 256) * 256;
            const bf16* vt = WSP(bf16, WS_VT) + (size_t)l * 256 * 4096 + (size_t)b * 256;
            float rsum[4];
#pragma unroll
            for (int hh = 0; hh < 4; ++hh) {
                __syncthreads();
#pragma unroll
                for (int i = 0; i < 4; ++i) { const int idx = F.tid + 512 * i;
                    { const int key = idx >> 3, cidx = idx & 7; const v4u x = *(const v4u*)(kb + (size_t)key * 256 + hh * 64 + 8 * cidx);
                      *(LAS v4u*)(F.lds + MX_K + ((((key >> 4) * 2 + (cidx >> 2)) * 64) + 16 * (cidx & 3) + (key & 15)) * 16) = x; }
                    { const int d = idx >> 5, c16 = idx & 31; const v4u x = *(const v4u*)(vt + (size_t)(hh * 64 + d) * 4096 + 8 * c16);
                      const int key0 = 8 * c16, s = key0 >> 5, kk = key0 & 31, half = kk >> 4, gA = (kk & 15) >> 2, mt2 = d >> 5, rem = d & 31, m = 4 * (rem >> 3) + (rem & 3), e = (rem >> 2) & 1;
                      LAS unsigned char* dst = F.lds + MX_V + ((((mt2 * 2 + e) * 8 + s) * 64) + 16 * gA + m) * 16 + half * 8;
                      v2u lo; lo.x = x.x; lo.y = x.y; v2u hi; hi.x = x.z; hi.y = x.w; *(LAS v2u*)dst = lo; *(LAS v2u*)(dst + 256) = hi; } }
                const bf16x8 q0 = *(const bf16x8*)(prow + 1536 + hh * 64 + 8 * q), q1 = *(const bf16x8*)(prow + 1536 + hh * 64 + 32 + 8 * q);
                __syncthreads();
                f32x4 st[16];
#pragma unroll
                for (int t = 0; t < 16; ++t) { const bf16x8 k0 = *(const LAS bf16x8*)(F.lds + MX_K + ((t * 2 + 0) * 64 + F.lane) * 16), k1 = *(const LAS bf16x8*)(F.lds + MX_K + ((t * 2 + 1) * 64 + F.lane) * 16);
                    f32x4 z = {0.f, 0.f, 0.f, 0.f}; z = __builtin_amdgcn_mfma_f32_16x16x32_bf16(k0, q0, z, 0, 0, 0); st[t] = __builtin_amdgcn_mfma_f32_16x16x32_bf16(k1, q1, z, 0, 0, 0); }
                float mx = -3.0e38f;
#pragma unroll
                for (int t = 0; t < 16; ++t) mx = fmaxf(fmaxf(mx, fmaxf(st[t][0], st[t][1])), fmaxf(st[t][2], st[t][3]));
                mx = fmaxf(mx, __shfl_xor(mx, 16)); mx = fmaxf(mx, __shfl_xor(mx, 32));
                float sum = 0.f; const float c2 = 0.125f * 1.4426950408889634f, mo = mx * c2;
#pragma unroll
                for (int t = 0; t < 16; ++t)
#pragma unroll
                    for (int i = 0; i < 4; ++i) { const float p = __builtin_amdgcn_exp2f(st[t][i] * c2 - mo); st[t][i] = p; sum += p; }
                sum += __shfl_xor(sum, 16); sum += __shfl_xor(sum, 32); rsum[hh] = 1.0f / sum;
                bf16x8 pb[8];
#pragma unroll
                for (int s = 0; s < 8; ++s) { v4u o; o.x = pk2(st[2 * s][0], st[2 * s][1]); o.y = pk2(st[2 * s][2], st[2 * s][3]); o.z = pk2(st[2 * s + 1][0], st[2 * s + 1][1]); o.w = pk2(st[2 * s + 1][2], st[2 * s + 1][3]);
                    pb[s] = __builtin_bit_cast(bf16x8, o); }
#pragma unroll
                for (int mt2 = 0; mt2 < 2; ++mt2)
#pragma unroll
                    for (int e = 0; e < 2; ++e) { f32x4 o = {0.f, 0.f, 0.f, 0.f};
#pragma unroll
                        for (int s = 0; s < 8; ++s) { const bf16x8 a = *(const LAS bf16x8*)(F.lds + MX_V + (((mt2 * 2 + e) * 8 + s) * 64 + F.lane) * 16);
                            o = __builtin_amdgcn_mfma_f32_16x16x32_bf16(a, pb[s], o, 0, 0, 0); }
#pragma unroll
                        for (int i = 0; i < 4; ++i) val[2 * hh + mt2][4 * e + i] = o[i] * rsum[hh]; }
            }
            mix_finish(val, gng + 768, grow + 768, q);
        }
#endif
        __syncthreads();
    }
}

#if NAIVE_MIX
__global__ void __launch_bounds__(256) nv_mix_pre(const bf16* P, const float* lng, const float* lnb, float* Vn, float* Dp) {
    const int row = blockIdx.x * 4 + (threadIdx.x >> 6), lane = threadIdx.x & 63;
    const bf16* p = P + (size_t)row * NPROJ;
    float v[4]; float s = 0.f;
    for (int i = 0; i < 4; ++i) { v[i] = gelu_tanh(bf2f(p[1280 + 4 * lane + i])); s += v[i]; }
    const float mean = wave_sum(s) * (1.f / 256.f); float s2 = 0.f;
    for (int i = 0; i < 4; ++i) { v[i] -= mean; s2 += v[i] * v[i]; }
    const float rstd = 1.f / sqrtf(wave_sum(s2) * (1.f / 256.f) + LN_EPS);
    for (int i = 0; i < 4; ++i) Vn[(size_t)row * 256 + 4 * lane + i] = v[i] * rstd * lng[4 * lane + i] + lnb[4 * lane + i];
    const int t = row % SEQ, w = 2 << (lane >> 4), cnt = (t + 1 < w) ? t + 1 : w;
    for (int i = 0; i < 4; ++i) { const int c = 4 * lane + i; float acc = 0.f;
        for (int d = 0; d < cnt; ++d) acc += bf2f(P[(size_t)(row - d) * NPROJ + 768 + c]);
        Dp[(size_t)row * 256 + c] = acc / (float)cnt - bf2f(p[768 + c]); }
}
__global__ void __launch_bounds__(256) nv_mix_main(const bf16* P, const float* Vn, const float* Dp, const bf16* Kb, const bf16* VT, const float* conv_w, const float* pool_w, const float* pool_scale,
                                                   const float* gmlp_w, const float* gmlp_b, float* Y) {
    const int row = blockIdx.x >> 2, grp = blockIdx.x & 3, c = threadIdx.x, t = row % SEQ;
    const bf16* p = P + (size_t)row * NPROJ; float y = 0.f;
    if (grp == 0) {
        float z[3];
        for (int d = 0; d < 3; ++d) { const int tt = t - 2 + d; z[d] = (tt >= 0) ? bf2f(P[(size_t)(row - 2 + d) * NPROJ + 256 + c]) * bf2f(P[(size_t)(row - 2 + d) * NPROJ + 512 + c]) : 0.f; }
        y = bf2f(p[c]) * (conv_w[c] * z[0] + conv_w[256 + c] * z[1] + conv_w[512 + c] * z[2]);
    } else if (grp == 1) {
        const int gi = c >> 6, dd = c & 63; float acc = 0.f;
        for (int cc = 0; cc < 64; ++cc) acc += Dp[(size_t)row * 256 + gi * 64 + cc] * pool_w[(gi * 64 + cc) * 64 + dd];
        y = acc * pool_scale[c];
    } else if (grp == 2) {
        const int hh = c >> 6, i = t & 127, jmax = ((i >> 6) + 1) * 64; const size_t blk0 = (size_t)(row - i); float acc = 0.f;
        for (int j = 0; j < jmax; ++j) acc += gmlp_w[(hh * 128 + i) * 128 + j] * Vn[(blk0 + j) * 256 + c];
        y = gelu_tanh(bf2f(p[1024 + c])) * (acc + gmlp_b[hh * 128 + i]);
    } else {
        const int hh = c >> 6, lane = c & 63, b = row / SEQ;
        const float q = bf2f(p[1536 + hh * 64 + lane]);
        float sc[4] = {0.f, 0.f, 0.f, 0.f};
        for (int d = 0; d < 64; ++d) { const float qd = __shfl(q, d);
            for (int m = 0; m < 4; ++m) sc[m] += qd * bf2f(Kb[(size_t)(b * 256 + lane + 64 * m) * 256 + hh * 64 + d]); }
        float mx = -3.0e38f;
        for (int m = 0; m < 4; ++m) { sc[m] *= 0.125f; mx = fmaxf(mx, sc[m]); }
        for (int o = 1; o < 64; o <<= 1) mx = fmaxf(mx, __shfl_xor(mx, o));
        float sum = 0.f;
        for (int m = 0; m < 4; ++m) { sc[m] = __expf(sc[m] - mx); sum += sc[m]; }
        sum = wave_sum(sum);
        float o = 0.f;
        for (int m = 0; m < 4; ++m) for (int j = 0; j < 64; ++j) { const float pj = __shfl(sc[m], j); o += pj * bf2f(VT[(size_t)(hh * 64 + lane) * 4096 + b * 256 + j + 64 * m]); }
        y = o / sum;
    }
    Y[(size_t)row * 1024 + grp * 256 + c] = y;
}
__global__ void __launch_bounds__(256) nv_mix_norm(const float* Y, const float* gng, bf16* G) {
    const int wv = blockIdx.x * 4 + (threadIdx.x >> 6), lane = threadIdx.x & 63, row = wv >> 2, grp = wv & 3;
    const float* y = Y + (size_t)row * 1024 + grp * 256; float v[4], s2 = 0.f;
    for (int i = 0; i < 4; ++i) { v[i] = y[4 * lane + i]; s2 += v[i] * v[i]; }
    const float r = 1.f / sqrtf(wave_sum(s2) * (1.f / 256.f) + RMS_EPS);
    for (int i = 0; i < 4; ++i) G[(size_t)row * 1024 + grp * 256 + 4 * lane + i] = (bf16)f2bf(v[i] * r * gng[grp * 256 + 4 * lane + i]);
}
#endif

constexpr int PH_PRO = 0, PH_KV = 1, PH_L0 = 2, PH_PER_LAYER = 8, N_PHASES = PH_L0 + NLAYER * PH_PER_LAYER;
__global__ void __launch_bounds__(NWAVES * 64, 2) fwd(Args args) {
    const Args& A = args;
    extern __shared__ __attribute__((aligned(16))) unsigned char lds[];
    Frame F;
    F.lds = (LAS unsigned char*)lds;
    F.MISC = (volatile LAS unsigned*)(F.lds + MISC_OFF);
    F.tid = threadIdx.x; F.lane = F.tid & 63; F.wave = __builtin_amdgcn_readfirstlane(F.tid >> 6);
    F.G = gridDim.x; F.ws = args.ws; F.ctl = (gu32*)(args.ws + WS_CTL); F.out = args.out;
    for (int u = F.tid; u < (LDS_BYTES - LDSCTL_OFF) / 4; u += NWAVES * 64) ((LAS unsigned*)(F.lds + LDSCTL_OFF))[u] = 0u;
    __syncthreads();
#if MK_ONE_LAUNCH
    XcdBarrier bar = xcd_barrier_post((unsigned*)(F.ctl + CW_BAR), F.MISC + 8);
#define GRID_BAR() xcd_barrier(bar)
#else
#define GRID_BAR() do { } while (0)
#endif
    const int lo = args.ph_lo, hi = args.ph_hi;
#define IN(k) (lo <= (k) && (k) < hi)
#define REP(q) for (int rep_ = 0; rep_ < ((DUP_PHASE == (q)) ? 2 : 1); ++rep_)
#define BOTH(k) (IN(k) && IN((k) + 1))
    const pg8::Gemm gm{(const pg8::bf16_t*)F.ws, (const pg8::bf16_t*)F.ws, D};
    const int c = (int)blockIdx.x;

    REP(100) if (IN(PH_PRO) && (PHMASK & 1)) { p0_prologue(F, args); if (BOTH(PH_PRO)) GRID_BAR(); }
    REP(101) if (IN(PH_KV) && (PHMASK & 2)) {
        KvOrder S{F.G, c};
        pg8::EpiBf16Sel E{WSP(bf16, WS_KB), WSP(bf16, WS_VT), 256, 4096, 0};
        pg8::gemm_phase<pg8::EpiBf16Sel, KvOrder, true, true>(F.lds + RING_OFF, gm, S, E);
        if (BOTH(PH_KV)) GRID_BAR();
    }
    for (int l = 0; l < NLAYER; ++l) {
        const int pb = PH_L0 + l * PH_PER_LAYER;
        REP(0) if (IN(pb + 0) && (PHMASK & 4)) {
            DenseOrder S{NTOK / 256, NPROJ / 256, F.G, c, T_HB, T_WIN + l * (NPROJ / 256)};
            pg8::EpiBf16Sel E{WSP(bf16, WS_P), WSP(bf16, WS_P), NPROJ, NPROJ, 0};
            pg8::gemm_phase<pg8::EpiBf16Sel, DenseOrder, true, true>(F.lds + RING_OFF, gm, S, E);
            if (BOTH(pb + 0)) GRID_BAR();
        }
        REP(1) if (IN(pb + 1) && (PHMASK & 512)) {
            pb_phase(F, args, l);
            if (BOTH(pb + 1)) GRID_BAR();
        }
        REP(2) if (IN(pb + 2) && (PHMASK & 8)) {
            DenseOrder S{NTOK / 256, D / 256, F.G, c, T_G, T_WOUT + l * (D / 256)};
            pg8::EpiResBf16 E{TILEP(T_HB), WSP(bf16, WS_PRE), DN_ALPHA, 0};
            pg8::gemm_phase<pg8::EpiResBf16, DenseOrder, true, true>(F.lds + RING_OFF, gm, S, E);
            if (BOTH(pb + 2)) GRID_BAR();
        }
        REP(3) if (IN(pb + 3) && (PHMASK & 16)) { pd_phase(F, args, l, DUP_PHASE == 3 && rep_ == 0); if (BOTH(pb + 3)) GRID_BAR(); }
        REP(4) if (IN(pb + 4) && (PHMASK & 32)) { pe_phase(F, l); if (BOTH(pb + 4)) GRID_BAR(); }
        REP(5) if (IN(pb + 5) && (PHMASK & 64)) {
            compute_toff(F, l);
            const LAS int* toff = (const LAS int*)(F.lds + TOFF_OFF);
            MoeOrder S{__builtin_amdgcn_readfirstlane(toff[NEXP]), 8, F.G, c, Q8(WS_XP8), Q8(WS_W18) + l * NEXP * 8, toff};
            pg8::EpiSwiglu E{F.ws + WS_ACT8, A.in[I_B1] + (size_t)l * NEXP * 2048, (DUP_PHASE == 5 && rep_ == 0) ? PROBE_MODE : 0};
            pg8::gemm_phase<pg8::EpiSwiglu, MoeOrder, true, true, true>(F.lds + RING_OFF, gm, S, E);
            if (BOTH(pb + 5)) GRID_BAR();
        }
        REP(6) if (IN(pb + 6) && (PHMASK & 128)) {
            compute_toff(F, l);
            const LAS int* toff = (const LAS int*)(F.lds + TOFF_OFF);
            MoeOrder S{__builtin_amdgcn_readfirstlane(toff[NEXP]), 4, F.G, c, Q8(WS_ACT8), Q8(WS_W28) + l * NEXP * 4, toff};
            pg8::EpiDown E{F.ws + WS_YS8, A.in[I_B2] + (size_t)l * NEXP * 1024, (DUP_PHASE == 6 && rep_ == 0) ? PROBE_MODE : 0};
            pg8::gemm_phase<pg8::EpiDown, MoeOrder, true, true, true>(F.lds + RING_OFF, gm, S, E);
            if (BOTH(pb + 6)) GRID_BAR();
        }
        REP(7) if (IN(pb + 7) && (PHMASK & 256)) { ph_phase(F, args, l, DUP_PHASE == 7 && rep_ == 0); if ((DUP_PHASE == 7 && rep_ == 0) || BOTH(pb + 7)) GRID_BAR(); }
    }
#undef IN
#undef BOTH
}

extern "C" void kernel_launch(void* const* d_in, const int* in_sizes, int n_in, void* d_out, int out_size, void* d_ws, size_t ws_size, hipStream_t stream) {
    static int grid = 0;
    if (grid == 0) {
        if (n_in != 27 || out_size != NTOK * D || ws_size < WS_END) { fprintf(stderr, "kernel_launch: unexpected problem (n_in %d, out %d, ws %zu < %zu)\n", n_in, out_size, ws_size, (size_t)WS_END); grid = -1; return; }
        int dev = 0, cus = 0, per_cu = 0;
        if (hipGetDevice(&dev) != hipSuccess || hipDeviceGetAttribute(&cus, hipDeviceAttributeMultiprocessorCount, dev) != hipSuccess) { grid = -1; return; }
        if (hipFuncSetAttribute((const void*)fwd, hipFuncAttributeMaxDynamicSharedMemorySize, LDS_BYTES) != hipSuccess) { fprintf(stderr, "kernel_launch: hipFuncSetAttribute failed\n"); grid = -1; return; }
        if (hipOccupancyMaxActiveBlocksPerMultiprocessor(&per_cu, (const void*)fwd, NWAVES * 64, LDS_BYTES) != hipSuccess || per_cu < 1) fprintf(stderr, "kernel_launch: occupancy query says %d\n", per_cu);
        (void)hipGetLastError();
        grid = cus;
    }
    if (grid < 0) return;
    if (hipMemsetAsync((char*)d_ws + WS_CTL, 0, CTL_ZERO_BYTES, stream) != hipSuccess) return;
    Args a{};
    for (int i = 0; i < 27; ++i) a.in[i] = (const float*)d_in[i];
    a.out = (float*)d_out; a.ws = (unsigned char*)d_ws;
#if MK_ONE_LAUNCH
    a.ph_lo = 0; a.ph_hi = N_PHASES;
    hipLaunchKernelGGL(fwd, dim3(grid), dim3(NWAVES * 64), LDS_BYTES, stream, a);
#else
    unsigned char* ws = (unsigned char*)d_ws;
    for (int p = 0; p < N_PHASES; ++p) {
        const int l = (p - PH_L0) / PH_PER_LAYER, q = (p - PH_L0) % PH_PER_LAYER;
        if (p >= PH_L0 && q == 1) {
#if NAIVE_MIX
            const float* const* in = (const float* const*)d_in;
            hipLaunchKernelGGL(nv_mix_pre, dim3(NTOK / 4), dim3(256), 0, stream, (const bf16*)(ws + WS_P), in[10] + l * 256, in[11] + l * 256, (float*)(ws + WS_NV_VN), (float*)(ws + WS_NV_DP));
            hipLaunchKernelGGL(nv_mix_main, dim3(NTOK * 4), dim3(256), 0, stream, (const bf16*)(ws + WS_P), (const float*)(ws + WS_NV_VN), (const float*)(ws + WS_NV_DP),
                               (const bf16*)(ws + WS_KB) + (size_t)l * 4096 * 256, (const bf16*)(ws + WS_VT) + (size_t)l * 256 * 4096, in[7] + l * 768, in[8] + l * 4 * 64 * 64, in[9] + l * 256,
                               in[12] + l * 4 * 128 * 128, in[13] + l * 4 * 128, (float*)(ws + WS_NV_Y));
            hipLaunchKernelGGL(nv_mix_norm, dim3(NTOK), dim3(256), 0, stream, (const float*)(ws + WS_NV_Y), in[15] + l * 1024, (bf16*)(ws + (size_t)T_G * TILE));
            continue;
#endif
        }
        a.ph_lo = p; a.ph_hi = p + 1;
        hipLaunchKernelGGL(fwd, dim3(grid), dim3(NWAVES * 64), LDS_BYTES, stream, a);
    }
#endif
}
```

```cpp
#include <hip/hip_runtime.h>
#include <cstdio>
#include <cstdint>

#ifndef MK_ONE_LAUNCH
#define MK_ONE_LAUNCH 1
#endif
#ifndef PHMASK
#define PHMASK 0xffff
#endif
#ifndef MXMASK
#define MXMASK 15
#endif
#ifndef DUP_PHASE
#define DUP_PHASE -1
#endif
#ifndef DUP_EPI
#define DUP_EPI 0
#endif
#ifndef PROBE_MODE
#define PROBE_MODE 0
#endif
#ifndef NAIVE_MIX
#define NAIVE_MIX 0
#endif

namespace pg8 {
#define PG8_LAS __attribute__((address_space(3)))
typedef unsigned short bf16_t;
typedef short bf16x8 __attribute__((ext_vector_type(8)));
typedef float f32x4 __attribute__((ext_vector_type(4)));
typedef float f32x2 __attribute__((ext_vector_type(2)));
typedef unsigned u32x4 __attribute__((ext_vector_type(4)));
typedef unsigned u32x2 __attribute__((ext_vector_type(2)));
constexpr int BM = 256, BK = 64, HALF = 128, HTB = HALF * BK * 2  , STAGE_BYTES = 8 * HTB, NXCD = 8, WGM = 8;

__host__ __device__ __forceinline__ int lds_byte(int r, int c) { const int st = (r >> 4) * 2 + (c >> 5), rr = r & 15, cc = c & 31, ob = rr * 64 + cc * 2; return st * 1024 + (ob ^ (((ob >> 9) & 1) << 5)); }
__host__ __device__ __forceinline__ void stage_rc(int b, int& R, int& C) { const int st = b / 1024, sb = b % 1024, swz = sb ^ (((sb >> 9) & 1) << 5); R = (st >> 1) * 16 + swz / 64; C = (st & 1) * 32 + (swz % 64) / 2; }
__host__ __device__ __forceinline__ int perm32(int rho) { const int n = rho >> 4, i = rho & 15; return 8 * (i >> 2) + 4 * n + (i & 3); }

__host__ __device__ __forceinline__ int bsrc_perm32(int R) { return (R & ~31) + perm32(R & 31); }
__host__ __device__ __forceinline__ int bsrc_swap32(int R) { const int fq = (R >> 2) & 3; return (R & ~31) + 16 * (fq & 1) + 8 * (fq >> 1) + 4 * ((R >> 4) & 1) + (R & 3); }
__host__ __device__ __forceinline__ int bsrc_wide16(int R) { return 64 * (R >> 5) + 16 * ((R >> 2) & 3) + 4 * ((R >> 4) & 1) + (R & 3); }

struct Unit { int pm, pn, lm, ln, a0; };
struct Gemm { const bf16_t* A; const bf16_t* Bt; int K; };

__device__ __forceinline__ void tile_of(int L, int nM, int nN, int& tm, int& tn) {
    const int nwg = nM * nN; int wgid = L; { const int q = nwg / NXCD, r = nwg % NXCD, xcd = wgid % NXCD, off = wgid / NXCD; wgid = (xcd < r ? xcd * (q + 1) : r * (q + 1) + (xcd - r) * q) + off; }
    const int nig = WGM * nN, gid = wgid / nig, fm = gid * WGM, gsz = (nM - fm) < WGM ? (nM - fm) : WGM;
    tm = fm + ((wgid % nig) % gsz); tn = (wgid % nig) / gsz;
}

typedef int v8i __attribute__((ext_vector_type(8)));
__device__ __forceinline__ v8i cat8(bf16x8 a, bf16x8 b) { typedef short s16x16 __attribute__((ext_vector_type(16))); return __builtin_bit_cast(v8i, __builtin_shufflevector(a, b, 0, 1, 2, 3, 4, 5, 6, 7, 8, 9, 10, 11, 12, 13, 14, 15)); }
__device__ __forceinline__ bf16x8 half8(v8i x, int k) { typedef int v4i __attribute__((ext_vector_type(4))); return __builtin_bit_cast(bf16x8, k ? __builtin_shufflevector(x, x, 4, 5, 6, 7) : __builtin_shufflevector(x, x, 0, 1, 2, 3)); }
__device__ __forceinline__ void mfma_fp8_acc(f32x4& acc, const v8i& a, const v8i& b) { asm volatile("v_mfma_f32_16x16x128_f8f6f4 %0, %1, %2, %0" : "+v"(acc) : "v"(a), "v"(b)); }
__device__ __forceinline__ unsigned cvt4_fp8(float a, float b, float c, float d) {
    a = __builtin_amdgcn_fmed3f(a, -448.f, 448.f); b = __builtin_amdgcn_fmed3f(b, -448.f, 448.f); c = __builtin_amdgcn_fmed3f(c, -448.f, 448.f); d = __builtin_amdgcn_fmed3f(d, -448.f, 448.f);
    int r = __builtin_amdgcn_cvt_pk_fp8_f32(a, b, 0, false); r = __builtin_amdgcn_cvt_pk_fp8_f32(c, d, r, true); return (unsigned)r; }
__device__ __forceinline__ unsigned cvt_pk_bf16(float lo, float hi) { unsigned r; asm volatile("v_cvt_pk_bf16_f32 %0, %1, %2" : "=v"(r) : "v"(lo), "v"(hi)); return r; }


struct EpiBf16Sel {
    static constexpr int BH1 = 128; __host__ __device__ static int bsrc(int R) { return bsrc_perm32(R); }
    static constexpr bool PERM = true, AFTER_DRAIN = false, DUP = (DUP_EPI & 4) != 0, DUPK = false; static constexpr int NSTORE = 16;
    bf16_t* o0; bf16_t* o1; int ld0, ld1; int mode;
    __device__ __forceinline__ void operator()(const f32x4 (&acc)[2][2][4][2], const Unit& u, int wr, int wc, int fr, int fq) const {
        bf16_t* base = u.a0 == 0 ? o0 : o1; const int ldc = u.a0 == 0 ? ld0 : ld1;
        const int row0 = u.lm * BM + wr * 64 + fr, col0 = u.ln * BM + wc * 32 + 8 * fq;
#pragma unroll
        for (int ai = 0; ai < 2; ++ai)
#pragma unroll
            for (int m = 0; m < 4; ++m) { bf16_t* rowp = base + (size_t)(row0 + ai * HALF + m * 16) * ldc + col0;
#pragma unroll
                for (int bj = 0; bj < 2; ++bj) { const f32x4 v0 = acc[ai][bj][m][0], v1 = acc[ai][bj][m][1];
                    u32x4 w; w.x = cvt_pk_bf16(v0[0], v0[1]); w.y = cvt_pk_bf16(v0[2], v0[3]); w.z = cvt_pk_bf16(v1[0], v1[1]); w.w = cvt_pk_bf16(v1[2], v1[3]);
                    *(u32x4*)(rowp + bj * HALF) = w; } }
    }
};
struct EpiResBf16 {
    static constexpr int BH1 = 128; __host__ __device__ static int bsrc(int R) { return bsrc_perm32(R); }
    static constexpr bool PERM = true, AFTER_DRAIN = false, DUP = (DUP_EPI & 8) != 0, DUPK = false; static constexpr int NSTORE = 16;
    const bf16_t* h; bf16_t* pre; float alpha; int mode;
    __device__ __forceinline__ void operator()(const f32x4 (&acc)[2][2][4][2], const Unit& u, int wr, int wc, int fr, int fq) const {
        const int row0 = u.lm * BM + wr * 64 + fr, col0 = u.ln * BM + wc * 32 + 8 * fq;
#pragma unroll
        for (int ai = 0; ai < 2; ++ai)
#pragma unroll
            for (int m = 0; m < 4; ++m) { const size_t off = (size_t)(row0 + ai * HALF + m * 16) * 1024 + col0;
#pragma unroll
                for (int bj = 0; bj < 2; ++bj) { const u32x4 hv = *(const u32x4*)(h + off + bj * HALF); const f32x4 a0 = acc[ai][bj][m][0], a1 = acc[ai][bj][m][1];
                    u32x4 w;
                    w.x = cvt_pk_bf16(__builtin_bit_cast(float, hv.x << 16) * alpha + a0[0], __builtin_bit_cast(float, hv.x & 0xffff0000u) * alpha + a0[1]);
                    w.y = cvt_pk_bf16(__builtin_bit_cast(float, hv.y << 16) * alpha + a0[2], __builtin_bit_cast(float, hv.y & 0xffff0000u) * alpha + a0[3]);
                    w.z = cvt_pk_bf16(__builtin_bit_cast(float, hv.z << 16) * alpha + a1[0], __builtin_bit_cast(float, hv.z & 0xffff0000u) * alpha + a1[1]);
                    w.w = cvt_pk_bf16(__builtin_bit_cast(float, hv.w << 16) * alpha + a1[2], __builtin_bit_cast(float, hv.w & 0xffff0000u) * alpha + a1[3]);
                    *(u32x4*)(pre + off + bj * HALF) = w; }
                asm volatile("" ::: "memory"); }
    }
};
typedef float f32x2v __attribute__((ext_vector_type(2)));
__device__ __forceinline__ f32x2v swiglu2(f32x2v a, f32x2v b, f32x2v bg, f32x2v bl, float ds) {
    f32x2v g = a * ds + bg, l = b * ds + bl;
    g.x = fminf(g.x, 7.0f); g.y = fminf(g.y, 7.0f);
    l.x = __builtin_amdgcn_fmed3f(l.x, -7.0f, 7.0f); l.y = __builtin_amdgcn_fmed3f(l.y, -7.0f, 7.0f);
    const f32x2v ea = g * (-1.702f * 1.4426950408889634f);
    f32x2v e; e.x = __builtin_amdgcn_exp2f(ea.x); e.y = __builtin_amdgcn_exp2f(ea.y);
    const f32x2v den = e + 1.0f;
    f32x2v s; s.x = __builtin_amdgcn_rcpf(den.x); s.y = __builtin_amdgcn_rcpf(den.y);
    return (g * s) * (l * 4.0f + 4.0f);
}
__device__ __forceinline__ unsigned cvt4_fp8_nc(float a, float b, float c, float d) { int r = __builtin_amdgcn_cvt_pk_fp8_f32(a, b, 0, false); r = __builtin_amdgcn_cvt_pk_fp8_f32(c, d, r, true); return (unsigned)r; }
struct EpiSwiglu {
    static constexpr int BH1 = 128; __host__ __device__ static int bsrc(int R) { return bsrc_swap32(R); }
    static constexpr bool PERM = true, AFTER_DRAIN = false, DUP = (DUP_EPI & 1) != 0, DUPK = false; static constexpr int NSTORE = 4;
    unsigned char* act; const float* b1; int mode;
    __device__ __forceinline__ void operator()(const f32x4 (&acc)[2][2][4][2], const Unit& u, int wr, int wc, int fr, int fq) const {
        const int cb = u.ln * HALF + wc * 32 + 16 * (fq & 1), lc0 = cb + 8 * (fq >> 1);
        const int row0 = u.lm * BM + wr * 64 + fr + 16 * (fq >> 1);
        const float* bb = b1 + (size_t)u.a0 * 2048 + lc0;
        f32x4 bg[2], bl[2];
        bg[0] = *(const f32x4*)(bb); bg[1] = *(const f32x4*)(bb + 4); bl[0] = *(const f32x4*)(bb + 1024); bl[1] = *(const f32x4*)(bb + 1028);
        constexpr float DS = 1.0f / 512.0f;
#pragma unroll
        for (int ai = 0; ai < 2; ++ai)
#pragma unroll
            for (int mp = 0; mp < 2; ++mp) {
                unsigned w[2][2];
#pragma unroll
                for (int mo = 0; mo < 2; ++mo)
#pragma unroll
                    for (int n = 0; n < 2; ++n) { const f32x4 G = acc[ai][0][2 * mp + mo][n], L = acc[ai][1][2 * mp + mo][n];
                        const f32x2v r0 = swiglu2((f32x2v){G[0], G[1]}, (f32x2v){L[0], L[1]}, (f32x2v){bg[n][0], bg[n][1]}, (f32x2v){bl[n][0], bl[n][1]}, DS);
                        const f32x2v r1 = swiglu2((f32x2v){G[2], G[3]}, (f32x2v){L[2], L[3]}, (f32x2v){bg[n][2], bg[n][3]}, (f32x2v){bl[n][2], bl[n][3]}, DS);
                        w[mo][n] = cvt4_fp8_nc(r0.x, r0.y, r1.x, r1.y); }
                const auto s0 = __builtin_amdgcn_permlane32_swap(w[0][0], w[1][0], false, false), s1 = __builtin_amdgcn_permlane32_swap(w[0][1], w[1][1], false, false);
                u32x4 o; o.x = s0[0]; o.y = s1[0]; o.z = s0[1]; o.w = s1[1];
                if (mode != 1) *(u32x4*)(act + (size_t)(row0 + ai * HALF + mp * 32) * 1024 + cb) = o; }
    }
};
struct EpiDown {
    static constexpr int BH1 = 8; __host__ __device__ static int bsrc(int R) { return bsrc_wide16(R); }
    static constexpr bool PERM = true, AFTER_DRAIN = false, DUP = (DUP_EPI & 2) != 0, DUPK = false; static constexpr int NSTORE = 8;
    unsigned char* ys; const float* b2; int mode;
    __device__ __forceinline__ void operator()(const f32x4 (&acc)[2][2][4][2], const Unit& u, int wr, int wc, int fr, int fq) const {
        const int row0 = u.lm * BM + wr * 64 + fr, col0 = u.ln * BM + wc * 64 + 16 * fq;
        f32x4 bv[2][2];
#pragma unroll
        for (int bj = 0; bj < 2; ++bj)
#pragma unroll
            for (int n = 0; n < 2; ++n) bv[bj][n] = *(const f32x4*)(b2 + (size_t)u.a0 * 1024 + col0 + 8 * bj + 4 * n) * 64.0f;
#pragma unroll
        for (int ai = 0; ai < 2; ++ai)
#pragma unroll
            for (int m = 0; m < 4; ++m) { u32x4 w; unsigned* wp = (unsigned*)&w;
#pragma unroll
                for (int bj = 0; bj < 2; ++bj)
#pragma unroll
                    for (int n = 0; n < 2; ++n) { const f32x4 v = acc[ai][bj][m][n] * 0.25f + bv[bj][n]; wp[2 * bj + n] = cvt4_fp8(v[0], v[1], v[2], v[3]); }
                if (mode != 1) *(u32x4*)(ys + (size_t)(row0 + ai * HALF + m * 16) * 1024 + col0) = w; }
    }
};

template <class Epi, class Sched, bool ALIGN_EPI = false, bool SP2 = false, bool FP8 = false, bool KROT = true>
__device__ __forceinline__ void gemm_phase(PG8_LAS unsigned char* lds, const Gemm g, const Sched& S, const Epi& E) {
    int tid_l = threadIdx.x; asm volatile("" : "+v"(tid_l));
    const int tid = tid_l, wid = __builtin_amdgcn_readfirstlane(tid >> 6), lane = tid & 63, wr = wid >> 2, wc = wid & 3, fr = lane & 15, fq = lane >> 4;
    const int RB = g.K * (FP8 ? 1 : 2), nt = RB / 128;
    unsigned voffA[2], voffB[2];
#pragma unroll
    for (int i = 0; i < 2; ++i) { int R, C; stage_rc(tid * 16 + i * 8192, R, C); const int Rb = Epi::bsrc(R);
        voffA[i] = (unsigned)(R * RB + C * 2); voffB[i] = (unsigned)(Rb * RB + C * 2); }
    const size_t kstep = (size_t)(BK * 2);
    const size_t hstepB = (size_t)Epi::BH1 * RB;
    const size_t hstep = (size_t)HALF * RB;
    const size_t tstep = 2 * hstep;
    const unsigned ldsw = (unsigned)wid * 1024u;
    const int aoff = lds_byte(wr * 64 + fr, fq * 8), boff = lds_byte(wc * 32 + fr, fq * 8);
#define PG8_SA(b, h) (((b) * 2 + (h)) * HTB)
#define PG8_SB(b, h) ((4 + (b) * 2 + (h)) * HTB)
#define PG8_STAGE(bufoff, gbase, voff) do { _Pragma("unroll") for (int _i = 0; _i < 2; ++_i) \
        __builtin_amdgcn_global_load_lds((const unsigned*)((const char*)(gbase) + (voff)[_i]), (PG8_LAS unsigned*)(lds + (bufoff) + ldsw + _i * 8192), 16, 0, 0); } while (0)
#define PG8_LDA(dst, b, h) do { _Pragma("unroll") for (int m = 0; m < 4; ++m) dst[m] = cat8(*(const PG8_LAS bf16x8*)(lds + PG8_SA(b, h) + aoff + m * 2048), *(const PG8_LAS bf16x8*)(lds + PG8_SA(b, h) + aoff + m * 2048 + 1024)); } while (0)
#define PG8_LDB(dst, b, h) do { _Pragma("unroll") for (int n = 0; n < 2; ++n) dst[n] = cat8(*(const PG8_LAS bf16x8*)(lds + PG8_SB(b, h) + boff + n * 2048), *(const PG8_LAS bf16x8*)(lds + PG8_SB(b, h) + boff + n * 2048 + 1024)); } while (0)
#define PG8_MMA(ai, bj, At, Bt) do { __builtin_amdgcn_s_setprio(1); _Pragma("unroll") for (int m = 0; m < 4; ++m) _Pragma("unroll") for (int n = 0; n < 2; ++n) { \
        if constexpr (FP8) mfma_fp8_acc(acc[ai][bj][m][n], Bt[n], At[m]); \
        else { _Pragma("unroll") for (int k = 0; k < 2; ++k) acc[ai][bj][m][n] = __builtin_amdgcn_mfma_f32_16x16x32_bf16(half8(Bt[n], k), half8(At[m], k), acc[ai][bj][m][n], 0, 0, 0); } } \
        __builtin_amdgcn_s_setprio(0); } while (0)
#define PG8_WAIT_V(n) asm volatile("s_waitcnt vmcnt(" #n ")" ::: "memory")
#define PG8_WAIT_L(n) asm volatile("s_waitcnt lgkmcnt(" #n ")" ::: "memory")
#define PG8_BAR __builtin_amdgcn_s_barrier()
#define PG8_SCHED __builtin_amdgcn_sched_barrier(0)
    Unit cur, nxt; int ui = 0;
    if (!S.next(0, cur)) return;
    f32x4 acc[2][2][4][2];
#pragma unroll
    for (int a = 0; a < 2; ++a)
#pragma unroll
        for (int b = 0; b < 2; ++b)
#pragma unroll
            for (int m = 0; m < 4; ++m)
#pragma unroll
                for (int n = 0; n < 2; ++n) acc[a][b][m][n] = (f32x4){0.f, 0.f, 0.f, 0.f};
    v8i At[4], B0[2], B1[2];
    const char* cA = (const char*)g.A + (size_t)cur.pm * tstep; const char* cB = (const char*)g.Bt + (size_t)cur.pn * tstep;
#define PG8_ROT(u) ((unsigned)(2 * (((u).lm + (u).ln) & (nt / 2 - 1))) * 128u)
#define PG8_KOFF(i, rb) ((size_t)((((unsigned)(i)) * 128u + (rb)) & (unsigned)(RB - 1)))
    unsigned rbc = KROT ? PG8_ROT(cur) : 0u, rbn = 0u;
    S.a_ready(cur);
    if constexpr (SP2) {
        PG8_STAGE(PG8_SB(0, 0), cB + PG8_KOFF(0, rbc), voffB); PG8_STAGE(PG8_SB(0, 1), cB + PG8_KOFF(0, rbc) + hstepB, voffB); PG8_STAGE(PG8_SA(0, 0), cA + PG8_KOFF(0, rbc), voffA); PG8_STAGE(PG8_SA(0, 1), cA + PG8_KOFF(0, rbc) + hstep, voffA);
        if (wr == 1) PG8_BAR;
        PG8_WAIT_V(2); PG8_BAR;
        PG8_STAGE(PG8_SB(1, 0), cB + PG8_KOFF(1, rbc), voffB); PG8_STAGE(PG8_SA(1, 0), cA + PG8_KOFF(1, rbc), voffA); PG8_STAGE(PG8_SB(1, 1), cB + PG8_KOFF(1, rbc) + hstepB, voffB);
        PG8_WAIT_V(6); PG8_BAR;
    } else {
        PG8_STAGE(PG8_SB(0, 0), cB + PG8_KOFF(0, rbc), voffB); PG8_STAGE(PG8_SA(0, 0), cA + PG8_KOFF(0, rbc), voffA); PG8_STAGE(PG8_SB(0, 1), cB + PG8_KOFF(0, rbc) + hstepB, voffB); PG8_STAGE(PG8_SA(0, 1), cA + PG8_KOFF(0, rbc) + hstep, voffA);
        if (wr == 1) PG8_BAR;
        PG8_WAIT_V(4); PG8_BAR;
        PG8_STAGE(PG8_SB(1, 0), cB + PG8_KOFF(1, rbc), voffB); PG8_STAGE(PG8_SA(1, 0), cA + PG8_KOFF(1, rbc), voffA); PG8_STAGE(PG8_SB(1, 1), cB + PG8_KOFF(1, rbc) + hstepB, voffB);
        PG8_WAIT_V(6); PG8_BAR;
    }
    for (;;) {
        const bool has_next = S.next(ui + 1, nxt);
        const char* nA = has_next ? (const char*)g.A + (size_t)nxt.pm * tstep : cA; const char* nB = has_next ? (const char*)g.Bt + (size_t)nxt.pn * tstep : cB;
        rbn = has_next ? (KROT ? PG8_ROT(nxt) : 0u) : rbc;
#pragma nounroll
        for (int t = 0; t < nt; t += 2) {
            const bool last = (t == nt - 2);
            const char* a1 = cA + PG8_KOFF(t + 1, rbc);
            const char* a2 = last ? nA + PG8_KOFF(0, rbn) : cA + PG8_KOFF(t + 2, rbc); const char* b2 = last ? nB + PG8_KOFF(0, rbn) : cB + PG8_KOFF(t + 2, rbc);
            const char* a3 = a2 + kstep; const char* b3 = b2 + kstep;
            if (last && has_next) S.a_ready(nxt);
            if constexpr (SP2) {
            PG8_LDB(B0, 0, 0); PG8_LDB(B1, 0, 1); PG8_SCHED; PG8_LDA(At, 0, 0); PG8_STAGE(PG8_SA(1, 1), a1 + hstep, voffA);
            PG8_WAIT_V(8); PG8_WAIT_L(0); PG8_BAR; PG8_MMA(0, 0, At, B0); PG8_MMA(0, 1, At, B1); PG8_BAR; PG8_SCHED;
            PG8_LDA(At, 0, 1); PG8_STAGE(PG8_SB(0, 0), b2, voffB); PG8_STAGE(PG8_SB(0, 1), b2 + hstepB, voffB); PG8_STAGE(PG8_SA(0, 0), a2, voffA);
            PG8_WAIT_V(8); PG8_WAIT_L(0); PG8_BAR; PG8_MMA(1, 0, At, B0); PG8_MMA(1, 1, At, B1); PG8_BAR; PG8_SCHED;
            PG8_LDB(B0, 1, 0); PG8_LDB(B1, 1, 1); PG8_SCHED; PG8_LDA(At, 1, 0); PG8_STAGE(PG8_SA(0, 1), a2 + hstep, voffA);
            PG8_WAIT_V(8); PG8_WAIT_L(0); PG8_BAR; PG8_MMA(0, 0, At, B0); PG8_MMA(0, 1, At, B1); PG8_BAR; PG8_SCHED;
            PG8_LDA(At, 1, 1); PG8_STAGE(PG8_SB(1, 0), b3, voffB); PG8_STAGE(PG8_SB(1, 1), b3 + hstepB, voffB); PG8_STAGE(PG8_SA(1, 0), a3, voffA);
            PG8_WAIT_V(8); PG8_WAIT_L(0); PG8_BAR; PG8_MMA(1, 0, At, B0); PG8_MMA(1, 1, At, B1); PG8_BAR; PG8_SCHED;
            } else {
            PG8_LDB(B0, 0, 0); PG8_SCHED; PG8_LDA(At, 0, 0); PG8_STAGE(PG8_SA(1, 1), a1 + hstep, voffA);
            PG8_WAIT_L(8); PG8_BAR; PG8_WAIT_L(0); PG8_MMA(0, 0, At, B0); PG8_BAR; PG8_SCHED;
            PG8_LDB(B1, 0, 1); PG8_STAGE(PG8_SB(0, 0), b2, voffB);
            PG8_BAR; PG8_WAIT_L(0); PG8_MMA(0, 1, At, B1); PG8_BAR;
            PG8_LDA(At, 0, 1); PG8_STAGE(PG8_SA(0, 0), a2, voffA);
            PG8_BAR; PG8_WAIT_L(0); PG8_MMA(1, 0, At, B0); PG8_BAR; PG8_SCHED;
            PG8_STAGE(PG8_SB(0, 1), b2 + hstepB, voffB);
            PG8_WAIT_V(6); PG8_BAR; PG8_MMA(1, 1, At, B1); PG8_BAR;
            PG8_LDB(B0, 1, 0); PG8_SCHED; PG8_LDA(At, 1, 0); PG8_STAGE(PG8_SA(0, 1), a2 + hstep, voffA);
            PG8_WAIT_L(8); PG8_BAR; PG8_WAIT_L(0); PG8_MMA(0, 0, At, B0); PG8_BAR; PG8_SCHED;
            PG8_LDB(B1, 1, 1); PG8_STAGE(PG8_SB(1, 0), b3, voffB);
            PG8_BAR; PG8_WAIT_L(0); PG8_MMA(0, 1, At, B1); PG8_BAR;
            PG8_LDA(At, 1, 1); PG8_STAGE(PG8_SA(1, 0), a3, voffA);
            PG8_BAR; PG8_WAIT_L(0); PG8_MMA(1, 0, At, B0); PG8_BAR; PG8_SCHED;
            PG8_STAGE(PG8_SB(1, 1), b3 + hstepB, voffB);
            PG8_WAIT_V(6); PG8_BAR; PG8_MMA(1, 1, At, B1); PG8_BAR;
            }
        }
        if constexpr (ALIGN_EPI) { if (wr == 0) PG8_BAR; }
        if constexpr (FP8) asm volatile("s_nop 15\n\ts_nop 15" ::: "memory");
        if constexpr (!Epi::AFTER_DRAIN) { if (E.mode != 2) E(acc, cur, wr, wc, fr, fq); if constexpr (Epi::DUP) { asm volatile("" ::: "memory"); E(acc, cur, wr, wc, fr, fq); } S.done(cur); }
        if (!has_next) break;
#pragma unroll
        for (int a = 0; a < 2; ++a)
#pragma unroll
            for (int b = 0; b < 2; ++b)
#pragma unroll
                for (int m = 0; m < 4; ++m)
#pragma unroll
                    for (int n = 0; n < 2; ++n) acc[a][b][m][n] = (f32x4){0.f, 0.f, 0.f, 0.f};
        cur = nxt; cA = nA; cB = nB; rbc = rbn; ++ui;
        if constexpr (ALIGN_EPI) { if (wr == 1) PG8_BAR; }
    }
    PG8_WAIT_V(0);
    if constexpr (!ALIGN_EPI) { if (wr == 0) PG8_BAR; }
    PG8_BAR;
    if constexpr (Epi::AFTER_DRAIN) { E.fused(acc, cur, wr, wc, fr, fq, lds, wid, lane); S.done(cur); }
#undef PG8_SA
#undef PG8_SB
#undef PG8_STAGE
#undef PG8_LDA
#undef PG8_LDB
#undef PG8_MMA
#undef PG8_WAIT_V
#undef PG8_ROT
#undef PG8_KOFF
#undef PG8_WAIT_L
#undef PG8_BAR
#undef PG8_SCHED
}
}

#define GAS __attribute__((address_space(1)))
#define LAS __attribute__((address_space(3)))
typedef unsigned short bf16;
typedef unsigned v4u __attribute__((ext_vector_type(4)));
typedef unsigned v2u __attribute__((ext_vector_type(2)));
typedef float f32x4 __attribute__((ext_vector_type(4)));
typedef short bf16x8 __attribute__((ext_vector_type(8)));
typedef GAS unsigned gu32;
typedef GAS unsigned long long gu64;
#define RLX_AGENT __ATOMIC_RELAXED, __HIP_MEMORY_SCOPE_AGENT
#define LDS_WAIT() asm volatile("s_waitcnt lgkmcnt(0)" ::: "memory")
#define VM_WAIT() asm volatile("s_waitcnt vmcnt(0)" ::: "memory")
__device__ __forceinline__ unsigned long long rt() { return __builtin_amdgcn_s_memrealtime(); }
__device__ __forceinline__ unsigned f2bf(float f) { unsigned u = __builtin_bit_cast(unsigned, f); return (u + 0x7fffu + ((u >> 16) & 1u)) >> 16; }
__device__ __forceinline__ unsigned pk2(float lo, float hi) { return f2bf(lo) | (f2bf(hi) << 16); }

#define XB_TMO      128
#define XB_XCNT(j)  (256  + 64 * (j))
#define XB_XSUB(j)  (1280 + 64 * (j))
#define XB_XGEN(j)  (2304 + 64 * (j))
#define XB_TOP      3328
#define XB_TOPGEN   3392
#define XCD_BAR_WORDS 3456
#define XB_SPIN_CAP (1u << 18)

__device__ __forceinline__ unsigned xb_ld(unsigned* p)              { return __hip_atomic_load(p, __ATOMIC_RELAXED, __HIP_MEMORY_SCOPE_AGENT); }
__device__ __forceinline__ unsigned xb_add(unsigned* p, unsigned v) { return __hip_atomic_fetch_add(p, v, __ATOMIC_RELAXED, __HIP_MEMORY_SCOPE_AGENT); }
__device__ __forceinline__ unsigned xb_xcc_id() { return (unsigned)__builtin_amdgcn_s_getreg((3 << 11) | 20) & 0xFu; }
#define XB_SPIN(cond, bar) do { unsigned _sp = 0; while (cond) { __builtin_amdgcn_s_sleep(1); \
    if ((++_sp & 255u) == 0u) { if (xb_ld(&(bar)[XB_TMO])) break; if (_sp > XB_SPIN_CAP) { atomicAdd(&(bar)[XB_TMO], 1u); break; } } } } while (0)

struct XcdBarrier {
    unsigned* bar; unsigned x;
    volatile LAS unsigned* st;
};

__device__ __forceinline__ XcdBarrier xcd_barrier_post(unsigned* bar, volatile LAS unsigned* st) {
    XcdBarrier b; b.bar = bar; b.x = xb_xcc_id(); b.st = st;
    if (threadIdx.x == 0) (void)xb_add(&bar[XB_XCNT(b.x)], 1u);
    return b;
}
__device__ __forceinline__ void xcd_barrier_complete(unsigned* bar, unsigned x, unsigned& nloc, unsigned& nx) {
    const unsigned G = gridDim.x * gridDim.y * gridDim.z;
    unsigned sum, cnt, mine, sp = 0u;
    for (;;) {
        sum = 0u; cnt = 0u; mine = 0u;
#pragma unroll
        for (unsigned j = 0; j < 16; ++j) { const unsigned c = xb_ld(&bar[XB_XCNT(j)]); sum += c; cnt += (c > 0u) ? 1u : 0u; mine = (j == x) ? c : mine; }
        if (sum == G) break;
        __builtin_amdgcn_s_sleep(1);
        if ((++sp & 255u) == 0u) { if (xb_ld(&bar[XB_TMO])) break; if (sp > XB_SPIN_CAP) { atomicAdd(&bar[XB_TMO], 1u); break; } }
    }
    nloc = mine > 0u ? mine : 1u; nx = cnt > 0u ? cnt : 1u;
}

__device__ __forceinline__ void xcd_barrier(const XcdBarrier& b) {
    asm volatile("s_waitcnt vmcnt(0)" ::: "memory");
    __syncthreads();
    if (threadIdx.x == 0) {
        unsigned* bar = b.bar;
        __builtin_amdgcn_s_waitcnt(0);
        unsigned nloc = b.st[0], nx = b.st[1];
        if (nloc == 0u) { xcd_barrier_complete(bar, b.x, nloc, nx); b.st[0] = nloc; b.st[1] = nx; }
        const unsigned old = xb_add(&bar[XB_XSUB(b.x)], 1u);
        const unsigned gen = old / nloc;
        if (old + 1u == (gen + 1u) * nloc) {
            __builtin_amdgcn_fence(__ATOMIC_RELEASE, "agent");
            asm volatile("s_waitcnt vmcnt(0)" ::: "memory");
            const unsigned og = xb_add(&bar[XB_TOP], 1u);
            const unsigned tg = og / nx;
            if (og + 1u == (tg + 1u) * nx) xb_add(&bar[XB_TOPGEN], 1u);
            else XB_SPIN(xb_ld(&bar[XB_TOPGEN]) == tg, bar);
            __builtin_amdgcn_fence(__ATOMIC_ACQUIRE, "agent");
            xb_add(&bar[XB_XGEN(b.x)], 1u);
            asm volatile("s_waitcnt vmcnt(0)" ::: "memory");
        } else {
            XB_SPIN(xb_ld(&bar[XB_XGEN(b.x)]) == gen, bar);
            __builtin_amdgcn_fence(__ATOMIC_ACQUIRE, "agent");
            asm volatile("s_waitcnt vmcnt(0)" ::: "memory");
        }
    }
    __syncthreads();
}


constexpr int NWAVES = 8;
constexpr int NTOK = 32768, D = 1024, NPROJ = 1792, NLAYER = 4, NEXP = 32, SEQ = 2048, NBATCH = 16, NMEM = 256;
constexpr float LN_EPS = 1e-5f, RMS_EPS = 1e-6f;
constexpr float DN_ALPHA = 1.6817928305074292f;
constexpr int XP_TILES = NTOK * 4 / 256 + NEXP;

constexpr size_t MiB = 1u << 20, TILE = 512 * 1024;
constexpr size_t WS_CTL = 0, CTL_ZERO_BYTES = 1 * MiB;
constexpr size_t WS_WMB = 1 * MiB;
constexpr size_t WS_POOLT = WS_WMB + 512 * 1024;
constexpr size_t WS_WRT = WS_POOLT + 128 * 1024;
constexpr int T_WIN = 4, T_WOUT = T_WIN + 28, T_WKV = T_WOUT + 16, T_MEMN = T_WKV + 8, T_HB = T_MEMN + 16, T_G = T_HB + 128, T_END = T_G + 128;
constexpr size_t QT = 256 * 1024;
constexpr size_t WS_W18 = (size_t)T_END * TILE;
constexpr size_t WS_W28 = WS_W18 + 256 * MiB;
constexpr size_t WS_H8 = WS_W28 + 128 * MiB;
constexpr size_t WS_XP8 = WS_H8 + 32 * MiB;
constexpr size_t WS_ACT8 = WS_XP8 + (size_t)XP_TILES * QT;
constexpr size_t WS_YS8 = WS_ACT8 + (size_t)XP_TILES * QT;
constexpr size_t WS_P = WS_YS8 + (size_t)XP_TILES * QT;
#define Q8(off) ((int)((off) / QT))
constexpr size_t WS_PRE = WS_P + 112 * MiB;
constexpr size_t WS_KB = WS_PRE + 64 * MiB;
constexpr size_t WS_VT = WS_KB + 8 * MiB;
constexpr size_t WS_TOKES = WS_VT + 8 * MiB;
constexpr size_t WS_TOKG = WS_TOKES + 512 * 1024;
constexpr size_t WS_ROWIDX = WS_TOKG + 512 * 1024;
constexpr size_t WS_NV_VN = WS_ROWIDX + 512 * 1024;
constexpr size_t WS_NV_DP = WS_NV_VN + 32 * MiB;
constexpr size_t WS_NV_Y = WS_NV_DP + 32 * MiB;
constexpr size_t WS_END = WS_NV_Y + 128 * MiB;
constexpr int CW_TMO = 0, CW_CODE = 1;
constexpr int CW_BAR = 4096;
constexpr int CW_CNT = 16384;
static_assert((CW_CNT + NLAYER * NEXP * 16) * 4 <= (int)CTL_ZERO_BYTES, "CTL words inside the memset region");
constexpr int RING_OFF = 0, RING_BYTES = 131072;
constexpr int LDSCTL_OFF = 163840 - 1024, MISC_OFF = LDSCTL_OFF + 320, TOFF_OFF = MISC_OFF + 128;
constexpr int LDS_BYTES = 163840;
static_assert(TOFF_OFF + 160 <= LDS_BYTES, "LDS map");

__device__ __forceinline__ float bf2f(unsigned short b) { return __builtin_bit_cast(float, (unsigned)b << 16); }
__device__ __forceinline__ float wave_sum(float v) {
#pragma unroll
    for (int o = 1; o < 64; o <<= 1) v += __shfl_xor(v, o);
    return v;
}
__device__ __forceinline__ float gelu_tanh(float x) {
    const float u = 0.7978845608028654f * (x + 0.044715f * x * x * x);
    return x * __builtin_amdgcn_rcpf(1.0f + __builtin_amdgcn_exp2f(u * (-2.0f * 1.4426950408889634f)));
}

struct Frame {
    LAS unsigned char* lds;
    volatile LAS unsigned* MISC;
    gu32* ctl;
    unsigned char* ws;
    int tid, lane, wave, G;
    float* out;
};
struct Args { const float* in[27]; float* out; unsigned char* ws; int ph_lo, ph_hi; };
enum { I_X = 0, I_MEM, I_LN_IN_G, I_LN_IN_B, I_MEM_LN_G, I_MEM_LN_B, I_W_IN, I_CONV_W, I_POOL_W, I_POOL_SCALE, I_GMLP_LN_G, I_GMLP_LN_B, I_GMLP_W, I_GMLP_B, I_W_MEM_KV, I_GROUP_NORM_G, I_W_OUT,
       I_LN1_G, I_LN1_B, I_W_ROUTER, I_B_ROUTER, I_W1, I_B1, I_W2, I_B2, I_LN2_G, I_LN2_B };
#define RELANE(F) do { int t_ = threadIdx.x; asm volatile("" : "+v"(t_)); (F).tid = t_; (F).lane = t_ & 63; (F).wave = __builtin_amdgcn_readfirstlane(t_ >> 6); } while (0)
#define WSP(T, off) ((T*)(F.ws + (off)))
#define TILEP(t) ((bf16*)(F.ws + (size_t)(t) * TILE))

__device__ __forceinline__ void tr64(const float* W, int ldw, int k0, int n0, bf16* WT, int ldt, int drow0, LAS float* scr, int lane) {
    const int c4 = 4 * (lane & 15), kq = lane >> 4;
#pragma unroll
    for (int i = 0; i < 16; ++i) { const int kk = 4 * i + kq; const f32x4 v = *(const f32x4*)(W + (size_t)(k0 + kk) * ldw + n0 + c4);
        LAS float* s = scr + kk * 65 + c4; s[0] = v.x; s[1] = v.y; s[2] = v.z; s[3] = v.w; }
    LDS_WAIT(); asm volatile("" ::: "memory");
    const int ck = lane & 7;
#pragma unroll
    for (int j = 0; j < 8; ++j) { const int n = (lane >> 3) + 8 * j; const LAS float* s = scr + (8 * ck) * 65 + n;
        v4u o; o.x = pk2(s[0 * 65], s[1 * 65]); o.y = pk2(s[2 * 65], s[3 * 65]); o.z = pk2(s[4 * 65], s[5 * 65]); o.w = pk2(s[6 * 65], s[7 * 65]);
        *(v4u*)(WT + (size_t)(drow0 + n) * ldt + k0 + 8 * ck) = o; }
    LDS_WAIT(); asm volatile("" ::: "memory");
}
struct Fp8Item { const float* src; unsigned char* dst; int ldw; float scale; };
__device__ __forceinline__ Fp8Item fp8_item(const Args& A, unsigned char* ws, int r) {
    constexpr int NI1 = NLAYER * NEXP * 8 * 64;
    Fp8Item it;
    if (r < NI1) { const int le = r >> 9, rr = r & 511, kb = rr >> 6, nb = rr & 63; const int n0 = 32 * nb, nn = n0 & 1023;
        const int drow = (nn >> 7) * 256 + (n0 >= 1024 ? 128 : 0) + (nn & 127);
        it.src = A.in[I_W1] + (size_t)le * 1024 * 2048 + (size_t)(128 * kb) * 2048 + n0; it.ldw = 2048; it.scale = 32.0f;
        it.dst = ws + WS_W18 + (size_t)le * 2048 * 1024 + (size_t)drow * 1024 + 128 * kb; }
    else { r -= NI1; const int le = r >> 8, rr = r & 255, kb = rr >> 5, nb = rr & 31;
        it.src = A.in[I_W2] + (size_t)le * 1024 * 1024 + (size_t)(128 * kb) * 1024 + 32 * nb; it.ldw = 1024; it.scale = 64.0f;
        it.dst = ws + WS_W28 + (size_t)le * 1024 * 1024 + (size_t)(32 * nb) * 1024 + 128 * kb; }
    return it;
}
__device__ __forceinline__ void fp8_load(f32x4 (&v)[16], const Fp8Item& it, int lane) {
    const float* p = it.src + (size_t)(lane >> 3) * it.ldw + 4 * (lane & 7);
#pragma unroll
    for (int i = 0; i < 16; ++i) v[i] = *(const f32x4*)(p + (size_t)(8 * i) * it.ldw);
}
__device__ __forceinline__ void fp8_store(const f32x4 (&v)[16], const Fp8Item& it, LAS float* scr, int lane) {
    const int c4 = 4 * (lane & 7), kr = lane >> 3;
#pragma unroll
    for (int i = 0; i < 16; ++i) { const int kk = 8 * i + kr; *(LAS f32x4*)(scr + ((kk & 15) * 8 + (kk >> 4)) * 36 + c4) = v[i] * it.scale; }
    LDS_WAIT(); asm volatile("" ::: "memory");
    const int ck = lane & 7, nl = lane >> 3;
#pragma unroll
    for (int j = 0; j < 4; ++j) { const int n = nl + 8 * j; const LAS float* s = scr + ck * 36 + n;
        v4u o;
        o.x = pg8::cvt4_fp8(s[0 * 288], s[1 * 288], s[2 * 288], s[3 * 288]); o.y = pg8::cvt4_fp8(s[4 * 288], s[5 * 288], s[6 * 288], s[7 * 288]);
        o.z = pg8::cvt4_fp8(s[8 * 288], s[9 * 288], s[10 * 288], s[11 * 288]); o.w = pg8::cvt4_fp8(s[12 * 288], s[13 * 288], s[14 * 288], s[15 * 288]);
        *(v4u*)(it.dst + (size_t)n * 1024 + 16 * ck) = o; }
    LDS_WAIT(); asm volatile("" ::: "memory");
}
#define BAR_LDS() do { asm volatile("s_waitcnt lgkmcnt(0)" ::: "memory"); __builtin_amdgcn_s_barrier(); asm volatile("" ::: "memory"); } while (0)
__device__ __forceinline__ f32x4 bf2lo(const v4u r) { f32x4 o; o.x = __builtin_bit_cast(float, r.x << 16); o.y = __builtin_bit_cast(float, r.x & 0xffff0000u); o.z = __builtin_bit_cast(float, r.y << 16); o.w = __builtin_bit_cast(float, r.y & 0xffff0000u); return o; }
__device__ __forceinline__ f32x4 bf2hi(const v4u r) { f32x4 o; o.x = __builtin_bit_cast(float, r.z << 16); o.y = __builtin_bit_cast(float, r.z & 0xffff0000u); o.z = __builtin_bit_cast(float, r.w << 16); o.w = __builtin_bit_cast(float, r.w & 0xffff0000u); return o; }
__device__ __forceinline__ v4u pack8(const f32x4 a, const f32x4 b) { v4u o; o.x = pg8::cvt_pk_bf16(a.x, a.y); o.y = pg8::cvt_pk_bf16(a.z, a.w); o.z = pg8::cvt_pk_bf16(b.x, b.y); o.w = pg8::cvt_pk_bf16(b.z, b.w); return o; }
struct LnPar { f32x4 g[4], b[4]; };
__device__ __forceinline__ void ln_load(LnPar& p, const float* gam, const float* bet, int lane) {
#pragma unroll
    for (int j = 0; j < 4; ++j) { const int o = 8 * lane + 512 * (j >> 1) + 4 * (j & 1); p.g[j] = *(const f32x4*)(gam + o); p.b[j] = *(const f32x4*)(bet + o); }
}
__device__ __forceinline__ void ln_affine(f32x4 (&v)[4], const LnPar& p) {
    float s = 0.f;
#pragma unroll
    for (int j = 0; j < 4; ++j) s += (v[j].x + v[j].y) + (v[j].z + v[j].w);
    const float mean = wave_sum(s) * (1.f / 1024.f); float s2 = 0.f;
#pragma unroll
    for (int j = 0; j < 4; ++j) { v[j] = v[j] - mean; s2 += (v[j].x * v[j].x + v[j].y * v[j].y) + (v[j].z * v[j].z + v[j].w * v[j].w); }
    const float rstd = 1.f / sqrtf(wave_sum(s2) * (1.f / 1024.f) + LN_EPS);
#pragma unroll
    for (int j = 0; j < 4; ++j) v[j] = v[j] * rstd * p.g[j] + p.b[j];
}
__device__ __forceinline__ void p0_prologue(Frame& F, const Args& A) {
    RELANE(F);
    LAS float* scr = (LAS float*)(F.lds + RING_OFF + F.wave * 18432);
    const int gw = blockIdx.x * NWAVES + F.wave, NGW = F.G * NWAVES;
    constexpr int NI_W1 = NLAYER * NEXP * 16 * 32, NI_W2 = NLAYER * NEXP * 16 * 16, NI_WIN = NLAYER * 16 * 28, NI_WOUT = NLAYER * 16 * 16, NI_WKV = NLAYER * 16 * 8, NI_POOL = NLAYER * 4;
    constexpr int NITEMS = NI_W1 + NI_W2 + NI_WIN + NI_WOUT + NI_WKV + NI_POOL;
    {
        constexpr int NF = NI_W1 + NI_W2;
        int r = gw; f32x4 cur[16]; Fp8Item ic = fp8_item(A, F.ws, r < NF ? r : 0);
        if (r < NF) fp8_load(cur, ic, F.lane);
        while (r < NF) {
            const int rn = r + NGW; f32x4 nxt[16]; const Fp8Item in_ = fp8_item(A, F.ws, rn < NF ? rn : r);
            if (rn < NF) fp8_load(nxt, in_, F.lane);
            fp8_store(cur, ic, scr, F.lane);
#pragma unroll
            for (int i = 0; i < 16; ++i) cur[i] = nxt[i];
            ic = in_; r = rn;
        }
    }
    for (int it = gw; it < NITEMS - NI_W1 - NI_W2; it += NGW) {
        int r = it;
        if (r < NI_WIN) { const int l = r / 448, rr = r % 448, kb = rr / 28, nb = rr % 28;
            tr64(A.in[I_W_IN] + (size_t)l * 1024 * NPROJ, NPROJ, 64 * kb, 64 * nb, TILEP(T_WIN) + (size_t)l * NPROJ * 1024, 1024, 64 * nb, scr, F.lane); continue; } r -= NI_WIN;
        if (r < NI_WOUT) { const int l = r >> 8, rr = r & 255, kb = rr >> 4, nb = rr & 15;
            tr64(A.in[I_W_OUT] + (size_t)l * 1024 * 1024, 1024, 64 * kb, 64 * nb, TILEP(T_WOUT) + (size_t)l * 1024 * 1024, 1024, 64 * nb, scr, F.lane); continue; } r -= NI_WOUT;
        if (r < NI_WKV) { const int l = r >> 7, rr = r & 127, kb = rr >> 3, nb = rr & 7;
            tr64(A.in[I_W_MEM_KV] + (size_t)l * 1024 * 512, 512, 64 * kb, 64 * nb, TILEP(T_WKV) + (size_t)l * 512 * 1024, 1024, 64 * nb, scr, F.lane); continue; } r -= NI_WKV;
        tr64(A.in[I_POOL_W] + (size_t)r * 64 * 64, 64, 0, 0, WSP(bf16, WS_POOLT) + (size_t)r * 64 * 64, 64, 0, scr, F.lane);
    }
    const int gt = blockIdx.x * (NWAVES * 64) + F.tid, NGT = F.G * NWAVES * 64;
    for (int i = gt; i < NLAYER * 4 * 128 * 128; i += NGT) { const int j = i & 127, ii = (i >> 7) & 127; WSP(bf16, WS_WMB)[i] = (bf16)(((j >> 6) <= (ii >> 6)) ? f2bf(A.in[I_GMLP_W][i]) : 0u); }
    for (int i = gt; i < NLAYER * 32 * 1024; i += NGT) { const int k = i & 1023, e = (i >> 10) & 31, l = i >> 15; WSP(bf16, WS_WRT)[i] = (bf16)f2bf(A.in[I_W_ROUTER][((size_t)l * 1024 + k) * 32 + e]); }
    LnPar px, pm; ln_load(px, A.in[I_LN_IN_G], A.in[I_LN_IN_B], F.lane); ln_load(pm, A.in[I_MEM_LN_G], A.in[I_MEM_LN_B], F.lane);
    for (int m = gw; m < NTOK + NBATCH * NMEM; m += NGW) {
        const bool ismem = m >= NTOK; const int row = ismem ? m - NTOK : m;
        const float* src = (ismem ? A.in[I_MEM] : A.in[I_X]) + (size_t)row * D + 8 * F.lane;
        f32x4 v[4]; v[0] = *(const f32x4*)(src); v[1] = *(const f32x4*)(src + 4); v[2] = *(const f32x4*)(src + 512); v[3] = *(const f32x4*)(src + 516);
        if (ismem) ln_affine(v, pm); else ln_affine(v, px);
        bf16* dst = (ismem ? TILEP(T_MEMN) : TILEP(T_HB)) + (size_t)row * D + 8 * F.lane;
        *(v4u*)dst = pack8(v[0], v[1]); *(v4u*)(dst + 512) = pack8(v[2], v[3]);
    }
}

struct DenseOrder {
    int nM, nN, G, c, a_t0, b_t0;
    __device__ __forceinline__ bool next(int i, pg8::Unit& u) const {
        const long L = (long)i * G + c; if (L >= (long)nM * nN) return false;
        int tm, tn; pg8::tile_of((int)L, nM, nN, tm, tn); u.pm = a_t0 + tm; u.pn = b_t0 + tn; u.lm = tm; u.ln = tn; u.a0 = 0; return true;
    }
    __device__ __forceinline__ void a_ready(const pg8::Unit&) const {}
    __device__ __forceinline__ void done(const pg8::Unit&) const {}
};
struct KvOrder {
    int G, c;
    __device__ __forceinline__ bool next(int i, pg8::Unit& u) const {
        const int L = i * G + c; if (L >= NLAYER * 32) return false;
        const int l = L >> 5, r = L & 31;
        if (r < 16) { u.pm = T_MEMN + r; u.pn = T_WKV + 2 * l; u.lm = l * 16 + r; u.ln = 0; u.a0 = 0; }
        else { u.pm = T_WKV + 2 * l + 1; u.pn = T_MEMN + (r - 16); u.lm = l; u.ln = r - 16; u.a0 = 1; }
        return true;
    }
    __device__ __forceinline__ void a_ready(const pg8::Unit&) const {}
    __device__ __forceinline__ void done(const pg8::Unit&) const {}
};
struct MoeOrder {
    int TM, NTN, G, c, a_t0, b_t0; const LAS int* toff;
    __device__ __forceinline__ bool next(int i, pg8::Unit& u) const {
        const long L = (long)i * G + c; if (L >= (long)TM * NTN) return false;
        int tm, tn; pg8::tile_of((int)L, TM, NTN, tm, tn);
        int e = 0;
#pragma unroll
        for (int j = 1; j < NEXP; ++j) e += (toff[j] <= tm) ? 1 : 0;
        e = __builtin_amdgcn_readfirstlane(e);
        u.pm = a_t0 + tm; u.pn = b_t0 + e * NTN + tn; u.lm = tm; u.ln = tn; u.a0 = e; return true;
    }
    __device__ __forceinline__ void a_ready(const pg8::Unit&) const {}
    __device__ __forceinline__ void done(const pg8::Unit&) const {}
};
__device__ __forceinline__ void compute_toff(Frame& F, int l) {
    RELANE(F);
    LAS int* toff = (LAS int*)(F.lds + TOFF_OFF);
    __syncthreads();
    if (F.wave == 0) {
        int t = 0;
        if (F.lane < NEXP) { const unsigned c = __hip_atomic_load(F.ctl + CW_CNT + (l * NEXP + F.lane) * 16, RLX_AGENT); t = (int)((c + 255u) >> 8); }
        int incl = t;
#pragma unroll
        for (int o = 1; o < 32; o <<= 1) { const int y = __shfl_up(incl, o); if ((F.lane & 31) >= o) incl += y; }
        if (F.lane < NEXP) toff[F.lane + 1] = incl;
        if (F.lane == 0) toff[0] = 0;
    }
    __syncthreads();
}

__device__ __forceinline__ void pd_phase(Frame& F, const Args& A, int l, bool probe = false) {
    RELANE(F);
    LAS float* lgam = (LAS float*)(F.lds);
    LAS float* lbet = lgam + 1024;
    LAS int* cntl = (LAS int*)(F.lds + 8192);
    LAS int* basel = cntl + 32;
    LAS int* sel_e = basel + 32;
    LAS int* sel_r = sel_e + 512; LAS float* sel_g = (LAS float*)(sel_r + 512);
    const bf16* wr = WSP(bf16, WS_WRT) + (size_t)l * NEXP * D; const float* br = A.in[I_B_ROUTER] + l * NEXP;
    const bf16* pre = WSP(bf16, WS_PRE); bf16* hb = TILEP(T_HB); unsigned char* h8 = F.ws + WS_H8;
    const int m = F.lane & 15, g = F.lane >> 4;
    for (int i = F.tid; i < D; i += NWAVES * 64) { lgam[i] = A.in[I_LN1_G][l * D + i]; lbet[i] = A.in[I_LN1_B][l * D + i]; }
    const float br0 = br[m], br1 = br[16 + m];
    for (int blk = blockIdx.x; blk < NTOK / 128; blk += F.G) {
        if (F.tid < NEXP) cntl[F.tid] = 0;
        const size_t row = (size_t)blk * 128 + F.wave * 16 + m;
        const bf16* prow = pre + row * D + 16 * g;
        v4u raw[16][2];
#pragma unroll
        for (int j = 0; j < 16; ++j) { raw[j][0] = *(const v4u*)(prow + 64 * j); raw[j][1] = *(const v4u*)(prow + 64 * j + 8); }
        BAR_LDS();
        float s = 0.f;
#pragma unroll
        for (int j = 0; j < 16; ++j)
#pragma unroll
            for (int hf = 0; hf < 2; ++hf) { const f32x4 a = bf2lo(raw[j][hf]), b = bf2hi(raw[j][hf]); s += ((a.x + a.y) + (a.z + a.w)) + ((b.x + b.y) + (b.z + b.w)); }
#pragma unroll
        for (int j = 0; j < 16; ++j) asm volatile("" : "+v"(raw[j][0]), "+v"(raw[j][1]));
        s += __shfl_xor(s, 16); s += __shfl_xor(s, 32);
        const float mean = s * (1.f / 1024.f); float s2 = 0.f;
#pragma unroll
        for (int j = 0; j < 16; ++j)
#pragma unroll
            for (int hf = 0; hf < 2; ++hf) { const f32x4 a = bf2lo(raw[j][hf]) - mean, b = bf2hi(raw[j][hf]) - mean; s2 += ((a.x * a.x + a.y * a.y) + (a.z * a.z + a.w * a.w)) + ((b.x * b.x + b.y * b.y) + (b.z * b.z + b.w * b.w)); }
#pragma unroll
        for (int j = 0; j < 16; ++j) asm volatile("" : "+v"(raw[j][0]), "+v"(raw[j][1]));
        s2 += __shfl_xor(s2, 16); s2 += __shfl_xor(s2, 32);
        const float rstd = 1.f / sqrtf(s2 * (1.f / 1024.f) + LN_EPS);
        f32x4 a0 = {0.f, 0.f, 0.f, 0.f}, a1 = {0.f, 0.f, 0.f, 0.f};
        bf16* hrow = hb + row * D + 16 * g; unsigned char* qrow = h8 + row * D + 16 * g;
#pragma unroll
        for (int j = 0; j < 16; ++j) {
            v4u o[2]; v4u q8;
#pragma unroll
            for (int hf = 0; hf < 2; ++hf) { const int c = 64 * j + 16 * g + 8 * hf;
                const f32x4 ga = *(const LAS f32x4*)(lgam + c), gb = *(const LAS f32x4*)(lgam + c + 4), ba = *(const LAS f32x4*)(lbet + c), bb = *(const LAS f32x4*)(lbet + c + 4);
                const f32x4 ya = (bf2lo(raw[j][hf]) - mean) * rstd * ga + ba, yb = (bf2hi(raw[j][hf]) - mean) * rstd * gb + bb;
                o[hf] = pack8(ya, yb);
                const unsigned qa = pg8::cvt4_fp8(ya.x * 16.0f, ya.y * 16.0f, ya.z * 16.0f, ya.w * 16.0f), qb = pg8::cvt4_fp8(yb.x * 16.0f, yb.y * 16.0f, yb.z * 16.0f, yb.w * 16.0f);
                if (hf == 0) { q8.x = qa; q8.y = qb; } else { q8.z = qa; q8.w = qb; } }
            *(v4u*)(hrow + 64 * j) = o[0]; *(v4u*)(hrow + 64 * j + 8) = o[1]; *(v4u*)(qrow + 64 * j) = q8;
            const bf16* w0 = wr + (size_t)m * D + 64 * j + 16 * g; const bf16* w1 = w0 + 16 * D;
            const bf16x8 b00 = *(const bf16x8*)w0, b01 = *(const bf16x8*)(w0 + 8), b10 = *(const bf16x8*)w1, b11 = *(const bf16x8*)(w1 + 8);
            a0 = __builtin_amdgcn_mfma_f32_16x16x32_bf16(__builtin_bit_cast(bf16x8, o[0]), b00, a0, 0, 0, 0); a0 = __builtin_amdgcn_mfma_f32_16x16x32_bf16(__builtin_bit_cast(bf16x8, o[1]), b01, a0, 0, 0, 0);
            a1 = __builtin_amdgcn_mfma_f32_16x16x32_bf16(__builtin_bit_cast(bf16x8, o[0]), b10, a1, 0, 0, 0); a1 = __builtin_amdgcn_mfma_f32_16x16x32_bf16(__builtin_bit_cast(bf16x8, o[1]), b11, a1, 0, 0, 0);
            if (j & 1) { asm volatile("" ::: "memory"); __builtin_amdgcn_sched_barrier(0); }
        }
#pragma unroll
        for (int i = 0; i < 4; ++i) {
            float c0 = a0[i] + br0, c1 = a1[i] + br1; float tv[4]; int ti[4];
#pragma unroll
            for (int k = 0; k < 4; ++k) {
                float bv = (c0 >= c1) ? c0 : c1; int be = (c0 >= c1) ? m : 16 + m;
#pragma unroll
                for (int off = 1; off < 16; off <<= 1) { const float ov = __shfl_xor(bv, off); const int oe = __shfl_xor(be, off); const bool take = (ov > bv) || (ov == bv && oe < be); bv = take ? ov : bv; be = take ? oe : be; }
                tv[k] = bv; ti[k] = be;
                c0 = (be == m) ? -3.0e38f : c0; c1 = (be == 16 + m) ? -3.0e38f : c1;
            }
            if (m == 0) {
                float ex[4], sum = 0.f;
#pragma unroll
                for (int k = 0; k < 4; ++k) { ex[k] = __expf(tv[k] - tv[0]); sum += ex[k]; }
                const float inv = 1.0f / sum;
#pragma unroll
                for (int k = 0; k < 4; ++k) { const int p = (F.wave * 16 + 4 * g + i) * 4 + k; sel_e[p] = ti[k]; sel_r[p] = __hip_atomic_fetch_add(cntl + ti[k], 1, __ATOMIC_RELAXED, __HIP_MEMORY_SCOPE_WORKGROUP); sel_g[p] = ex[k] * inv; }
            }
        }
        BAR_LDS();
        if (F.tid < NEXP) basel[F.tid] = probe ? 0 : (int)__hip_atomic_fetch_add(F.ctl + CW_CNT + (l * NEXP + F.tid) * 16, (unsigned)cntl[F.tid], RLX_AGENT);
        BAR_LDS();
        if (!probe) { const int p = F.tid, e = sel_e[p], slot = basel[e] + sel_r[p];
          WSP(int, WS_TOKES)[(size_t)blk * 512 + p] = (e << 16) | slot; WSP(float, WS_TOKG)[(size_t)blk * 512 + p] = sel_g[p]; }
        BAR_LDS();
    }
}
__device__ __forceinline__ void pe_phase(Frame& F, int l) {
    RELANE(F);
    compute_toff(F, l);
    const LAS int* toff = (const LAS int*)(F.lds + TOFF_OFF);
    const unsigned char* h8 = F.ws + WS_H8; unsigned char* xp = F.ws + WS_XP8;
    for (int blk = blockIdx.x; blk < NTOK / 128; blk += F.G) {
        const int p0 = blk * 512 + F.wave * 64;
        const int es = WSP(int, WS_TOKES)[p0 + F.lane];
        const int rowl = toff[es >> 16] * 256 + (es & 0xffff);
        WSP(int, WS_ROWIDX)[p0 + F.lane] = rowl;
#pragma unroll 8
        for (int p = 0; p < 64; ++p) { const int row = __shfl(rowl, p); const int t = (p0 + p) >> 2;
            const v4u a = *(const v4u*)(h8 + (size_t)t * D + 16 * F.lane);
            *(v4u*)(xp + (size_t)row * D + 16 * F.lane) = a; }
    }
}
__device__ __forceinline__ void acc8_fp8(f32x4& a, f32x4& b, const v2u q, const float g) {
    typedef float f2v __attribute__((ext_vector_type(2)));
    const f2v p0 = __builtin_amdgcn_cvt_pk_f32_fp8((int)q.x, false), p1 = __builtin_amdgcn_cvt_pk_f32_fp8((int)q.x, true), p2 = __builtin_amdgcn_cvt_pk_f32_fp8((int)q.y, false), p3 = __builtin_amdgcn_cvt_pk_f32_fp8((int)q.y, true);
    a.x += g * p0.x; a.y += g * p0.y; a.z += g * p1.x; a.w += g * p1.y; b.x += g * p2.x; b.y += g * p2.y; b.z += g * p3.x; b.w += g * p3.y;
}
__device__ __forceinline__ void ph_phase(Frame& F, const Args& A, int l, bool probe = false) {
    RELANE(F);
    const int gw = blockIdx.x * NWAVES + F.wave, NGW = F.G * NWAVES;
    LnPar lp; ln_load(lp, A.in[I_LN2_G] + l * D, A.in[I_LN2_B] + l * D, F.lane);
    bf16* hb = TILEP(T_HB); const unsigned char* ys = F.ws + WS_YS8;
    for (int t0 = gw * 16; t0 < NTOK; t0 += NGW * 16) {
        const int ri = WSP(int, WS_ROWIDX)[(size_t)t0 * 4 + F.lane]; const float gk = WSP(float, WS_TOKG)[(size_t)t0 * 4 + F.lane] * (1.0f / 64.0f);
#pragma nounroll
        for (int i = 0; i < 16; i += 4) {
            v4u hr[4][2]; v2u yr[4][4][2];
#pragma unroll
            for (int rr = 0; rr < 4; ++rr) { const bf16* hp = hb + (size_t)(t0 + i + rr) * D + 8 * F.lane; hr[rr][0] = *(const v4u*)hp; hr[rr][1] = *(const v4u*)(hp + 512);
#pragma unroll
                for (int k = 0; k < 4; ++k) { const int row = __shfl(ri, 4 * (i + rr) + k); const unsigned char* yp = ys + (size_t)row * D + 8 * F.lane; yr[rr][k][0] = *(const v2u*)yp; yr[rr][k][1] = *(const v2u*)(yp + 512); } }
#pragma unroll
            for (int rr = 0; rr < 4; ++rr) { const int t = t0 + i + rr;
                f32x4 v[4]; v[0] = bf2lo(hr[rr][0]) * DN_ALPHA; v[1] = bf2hi(hr[rr][0]) * DN_ALPHA; v[2] = bf2lo(hr[rr][1]) * DN_ALPHA; v[3] = bf2hi(hr[rr][1]) * DN_ALPHA;
#pragma unroll
                for (int k = 0; k < 4; ++k) { const float g = __shfl(gk, 4 * (i + rr) + k); acc8_fp8(v[0], v[1], yr[rr][k][0], g); acc8_fp8(v[2], v[3], yr[rr][k][1], g); }
                ln_affine(v, lp);
                if (probe) { bf16* op = WSP(bf16, WS_PRE) + (size_t)t * D + 8 * F.lane; *(v4u*)op = pack8(v[0], v[1]); *(v4u*)(op + 512) = pack8(v[2], v[3]); }
                else if (l == NLAYER - 1) { float* op = F.out + (size_t)t * D + 8 * F.lane; *(f32x4*)op = v[0]; *(f32x4*)(op + 4) = v[1]; *(f32x4*)(op + 512) = v[2]; *(f32x4*)(op + 516) = v[3]; }
                else { bf16* op = hb + (size_t)t * D + 8 * F.lane; *(v4u*)op = pack8(v[0], v[1]); *(v4u*)(op + 512) = pack8(v[2], v[3]); } }
        }
    }
}

constexpr int MX_VT = 0, MX_K = 65536, MX_V = 65536 + 32768;
__device__ __forceinline__ void unpack8(const v4u raw, float (&f)[8]) {
    f[0] = __builtin_bit_cast(float, raw.x << 16); f[1] = __builtin_bit_cast(float, raw.x & 0xffff0000u); f[2] = __builtin_bit_cast(float, raw.y << 16); f[3] = __builtin_bit_cast(float, raw.y & 0xffff0000u);
    f[4] = __builtin_bit_cast(float, raw.z << 16); f[5] = __builtin_bit_cast(float, raw.z & 0xffff0000u); f[6] = __builtin_bit_cast(float, raw.w << 16); f[7] = __builtin_bit_cast(float, raw.w & 0xffff0000u);
}
__device__ __forceinline__ void mix_finish(float (&val)[8][8], const float* gain, bf16* grow, int q) {
    float ss = 0.f;
#pragma unroll
    for (int cb = 0; cb < 8; ++cb)
#pragma unroll
        for (int i = 0; i < 8; ++i) ss += val[cb][i] * val[cb][i];
    ss += __shfl_xor(ss, 16); ss += __shfl_xor(ss, 32);
    const float rs = 1.0f / sqrtf(ss * (1.0f / 256.0f) + RMS_EPS);
#pragma unroll
    for (int cb = 0; cb < 8; ++cb) { const f32x4 g0 = *(const f32x4*)(gain + 32 * cb + 8 * q), g1 = *(const f32x4*)(gain + 32 * cb + 8 * q + 4);
        v4u o; o.x = pk2(val[cb][0] * rs * g0.x, val[cb][1] * rs * g0.y); o.y = pk2(val[cb][2] * rs * g0.z, val[cb][3] * rs * g0.w);
        o.z = pk2(val[cb][4] * rs * g1.x, val[cb][5] * rs * g1.y); o.w = pk2(val[cb][6] * rs * g1.z, val[cb][7] * rs * g1.w);
        *(v4u*)(grow + 32 * cb + 8 * q) = o; }
}
__device__ __forceinline__ void pb_phase(Frame& F, const Args& A, int l) {
    for (int u = blockIdx.x; u < NTOK / 128; u += F.G) {
    RELANE(F);
    const int r = F.lane & 15, q = F.lane >> 4, w = F.wave;
    const bf16* P = WSP(bf16, WS_P); bf16* G = TILEP(T_G);
    const float* gng = A.in[I_GROUP_NORM_G] + l * 1024;
        const int row = u * 128 + 16 * w + r, tseq = (u & 15) * 128 + 16 * w + r, b = u >> 4;
        const bf16* prow = P + (size_t)row * NPROJ; bf16* grow = G + (size_t)row * 1024;
        float val[8][8];
#if MXMASK & 1
        {
            const float* cw = A.in[I_CONV_W] + l * 768;
#pragma unroll
            for (int cb = 0; cb < 8; ++cb) { const int col = 32 * cb + 8 * q;
                float gb[8], zc[8], zh[8], z[8], acc[8];
                unpack8(*(const v4u*)(prow + col), gb);
#pragma unroll
                for (int i = 0; i < 8; ++i) acc[i] = 0.f;
#pragma unroll
                for (int d = 0; d < 3; ++d) {
                    if (tseq - 2 + d >= 0) { const bf16* pr = prow - (size_t)(2 - d) * NPROJ;
                        unpack8(*(const v4u*)(pr + 256 + col), zc); unpack8(*(const v4u*)(pr + 512 + col), zh);
                        const f32x4 w0 = *(const f32x4*)(cw + d * 256 + col), w1 = *(const f32x4*)(cw + d * 256 + col + 4);
#pragma unroll
                        for (int i = 0; i < 8; ++i) z[i] = zc[i] * zh[i];
                        acc[0] += w0.x * z[0]; acc[1] += w0.y * z[1]; acc[2] += w0.z * z[2]; acc[3] += w0.w * z[3]; acc[4] += w1.x * z[4]; acc[5] += w1.y * z[5]; acc[6] += w1.z * z[6]; acc[7] += w1.w * z[7]; } }
#pragma unroll
                for (int i = 0; i < 8; ++i) val[cb][i] = gb[i] * acc[i];
                asm volatile("" ::: "memory"); }
            mix_finish(val, gng, grow, q);
        }
#endif
        asm volatile("" ::: "memory"); __builtin_amdgcn_sched_barrier(0);
#if MXMASK & 2
        {
            const bf16* pt = WSP(bf16, WS_POOLT) + (size_t)l * 4 * 4096;
            bf16x8 dfr[4][2];
#pragma unroll
            for (int g = 0; g < 4; ++g)
#pragma unroll
                for (int ks = 0; ks < 2; ++ks) { const int col = 768 + g * 64 + 32 * ks + 8 * q, wlen = 2 << g;
                    float acc[8], x[8], t8[8];
                    unpack8(*(const v4u*)(prow + col), x);
#pragma unroll
                    for (int i = 0; i < 8; ++i) acc[i] = x[i];
                    for (int d = 1; d < wlen; ++d) if (tseq - d >= 0) { unpack8(*(const v4u*)(prow - (size_t)d * NPROJ + col), t8);
#pragma unroll
                        for (int i = 0; i < 8; ++i) acc[i] += t8[i]; }
                    const float inv = 1.0f / (float)((tseq + 1 < wlen) ? tseq + 1 : wlen);
                    v4u o; o.x = pk2(acc[0] * inv - x[0], acc[1] * inv - x[1]); o.y = pk2(acc[2] * inv - x[2], acc[3] * inv - x[3]);
                    o.z = pk2(acc[4] * inv - x[4], acc[5] * inv - x[5]); o.w = pk2(acc[6] * inv - x[6], acc[7] * inv - x[7]);
                    dfr[g][ks] = __builtin_bit_cast(bf16x8, o);
                    asm volatile("" ::: "memory"); }
            const float* psc = A.in[I_POOL_SCALE] + l * 256;
#pragma unroll
            for (int g = 0; g < 4; ++g)
#pragma unroll
                for (int mt2 = 0; mt2 < 2; ++mt2) { const f32x4 s0 = *(const f32x4*)(psc + g * 64 + 32 * mt2 + 8 * q), s1 = *(const f32x4*)(psc + g * 64 + 32 * mt2 + 8 * q + 4);
#pragma unroll
                    for (int e = 0; e < 2; ++e) { const int dd = 32 * mt2 + 8 * (r >> 2) + 4 * e + (r & 3);
                        f32x4 o = {0.f, 0.f, 0.f, 0.f};
#pragma unroll
                        for (int ks = 0; ks < 2; ++ks) { const bf16x8 a = *(const bf16x8*)(pt + (size_t)(g * 64 + dd) * 64 + 32 * ks + 8 * q);
                            o = __builtin_amdgcn_mfma_f32_16x16x32_bf16(a, dfr[g][ks], o, 0, 0, 0); }
                        const f32x4 sc = e ? s1 : s0;
                        val[2 * g + mt2][4 * e + 0] = o[0] * sc.x; val[2 * g + mt2][4 * e + 1] = o[1] * sc.y; val[2 * g + mt2][4 * e + 2] = o[2] * sc.z; val[2 * g + mt2][4 * e + 3] = o[3] * sc.w; } }
            mix_finish(val, gng + 256, grow + 256, q);
        }
#endif
        asm volatile("" ::: "memory"); __builtin_amdgcn_sched_barrier(0);
#if MXMASK & 4
        {
            const float* lg = A.in[I_GMLP_LN_G] + l * 256; const float* lb = A.in[I_GMLP_LN_B] + l * 256;
            const f32x4 g4 = *(const f32x4*)(lg + 4 * F.lane), b4 = *(const f32x4*)(lb + 4 * F.lane);
            const int hh_l = F.lane >> 4, mt2_l = (F.lane & 15) >> 3, q_l = (F.lane & 7) >> 1, e_l = F.lane & 1;
#pragma unroll 2
            for (int jp = 0; jp < 8; ++jp) { const int j = 16 * w + 2 * jp;
                const bf16* p0 = P + (size_t)(u * 128 + j) * NPROJ + 1280 + 4 * F.lane;
                const v2u ra = *(const v2u*)p0, rb = *(const v2u*)(p0 + NPROJ);
                float va[4], vb[4];
                va[0] = gelu_tanh(__builtin_bit_cast(float, ra.x << 16)); va[1] = gelu_tanh(__builtin_bit_cast(float, ra.x & 0xffff0000u)); va[2] = gelu_tanh(__builtin_bit_cast(float, ra.y << 16)); va[3] = gelu_tanh(__builtin_bit_cast(float, ra.y & 0xffff0000u));
                vb[0] = gelu_tanh(__builtin_bit_cast(float, rb.x << 16)); vb[1] = gelu_tanh(__builtin_bit_cast(float, rb.x & 0xffff0000u)); vb[2] = gelu_tanh(__builtin_bit_cast(float, rb.y << 16)); vb[3] = gelu_tanh(__builtin_bit_cast(float, rb.y & 0xffff0000u));
                const float ma = wave_sum((va[0] + va[1]) + (va[2] + va[3])) * (1.f / 256.f), mb = wave_sum((vb[0] + vb[1]) + (vb[2] + vb[3])) * (1.f / 256.f);
                float sa = 0.f, sb = 0.f;
#pragma unroll
                for (int c = 0; c < 4; ++c) { va[c] -= ma; vb[c] -= mb; sa += va[c] * va[c]; sb += vb[c] * vb[c]; }
                const float ra_ = 1.f / sqrtf(wave_sum(sa) * (1.f / 256.f) + LN_EPS), rb_ = 1.f / sqrtf(wave_sum(sb) * (1.f / 256.f) + LN_EPS);
                const int ks = j >> 5, gg = (j & 31) >> 3, jj = j & 7;
                LAS unsigned char* dst = F.lds + MX_VT + ((((hh_l * 2 + mt2_l) * 2 + e_l) * 4 + ks) * 64 + 16 * gg + 4 * q_l) * 16 + jj * 2;
                const float ga[4] = {g4.x, g4.y, g4.z, g4.w}, ba[4] = {b4.x, b4.y, b4.z, b4.w};
#pragma unroll
                for (int c = 0; c < 4; ++c) *(LAS unsigned*)(dst + c * 16) = pk2(va[c] * ra_ * ga[c] + ba[c], vb[c] * rb_ * ga[c] + ba[c]);
            }
            __syncthreads();
            const bf16* wm = WSP(bf16, WS_WMB) + (size_t)l * 4 * 128 * 128; const float* gbias = A.in[I_GMLP_B] + l * 512;
            const int nks = (w < 4) ? 2 : 4;
#pragma unroll
            for (int hh = 0; hh < 4; ++hh) {
                bf16x8 wf[4];
#pragma unroll
                for (int ks = 0; ks < 4; ++ks) wf[ks] = *(const bf16x8*)(wm + (size_t)(hh * 128 + 16 * w + r) * 128 + 32 * ks + 8 * q);
                const float bias = gbias[hh * 128 + 16 * w + r];
#pragma unroll
                for (int mt2 = 0; mt2 < 2; ++mt2) {
                    float uu[8]; unpack8(*(const v4u*)(prow + 1024 + hh * 64 + 32 * mt2 + 8 * q), uu);
#pragma unroll
                    for (int e = 0; e < 2; ++e) { f32x4 o = {0.f, 0.f, 0.f, 0.f};
#pragma unroll
                        for (int ks = 0; ks < 4; ++ks) if (ks < nks) { const bf16x8 a = *(const LAS bf16x8*)(F.lds + MX_VT + ((((hh * 2 + mt2) * 2 + e) * 4 + ks) * 64 + F.lane) * 16);
                            o = __builtin_amdgcn_mfma_f32_16x16x32_bf16(a, wf[ks], o, 0, 0, 0); }
#pragma unroll
                        for (int i = 0; i < 4; ++i) val[2 * hh + mt2][4 * e + i] = gelu_tanh(uu[4 * e + i]) * (o[i] + bias); } }
            }
            mix_finish(val, gng + 512, grow + 512, q);
        }
#endif
        asm volatile("" ::: "memory"); __builtin_amdgcn_sched_barrier(0);
#if MXMASK & 8
        {
            const bf16* kb = WSP(bf16, WS_KB) + ((size_t)l * 4096 + (size_t)b * 256) * 256;
            const bf16* vt = WSP(bf16, WS_VT) + (size_t)l * 256 * 4096 + (size_t)b * 256;
            float rsum[4];
#pragma unroll
            for (int hh = 0; hh < 4; ++hh) {
                __syncthreads();
#pragma unroll
                for (int i = 0; i < 4; ++i) { const int idx = F.tid + 512 * i;
                    { const int key = idx >> 3, cidx = idx & 7; const v4u x = *(const v4u*)(kb + (size_t)key * 256 + hh * 64 + 8 * cidx);
                      *(LAS v4u*)(F.lds + MX_K + ((((key >> 4) * 2 + (cidx >> 2)) * 64) + 16 * (cidx & 3) + (key & 15)) * 16) = x; }
                    { const int d = idx >> 5, c16 = idx & 31; const v4u x = *(const v4u*)(vt + (size_t)(hh * 64 + d) * 4096 + 8 * c16);
                      const int key0 = 8 * c16, s = key0 >> 5, kk = key0 & 31, half = kk >> 4, gA = (kk & 15) >> 2, mt2 = d >> 5, rem = d & 31, m = 4 * (rem >> 3) + (rem & 3), e = (rem >> 2) & 1;
                      LAS unsigned char* dst = F.lds + MX_V + ((((mt2 * 2 + e) * 8 + s) * 64) + 16 * gA + m) * 16 + half * 8;
                      v2u lo; lo.x = x.x; lo.y = x.y; v2u hi; hi.x = x.z; hi.y = x.w; *(LAS v2u*)dst = lo; *(LAS v2u*)(dst + 256) = hi; } }
                const bf16x8 q0 = *(const bf16x8*)(prow + 1536 + hh * 64 + 8 * q), q1 = *(const bf16x8*)(prow + 1536 + hh * 64 + 32 + 8 * q);
                __syncthreads();
                f32x4 st[16];
#pragma unroll
                for (int t = 0; t < 16; ++t) { const bf16x8 k0 = *(const LAS bf16x8*)(F.lds + MX_K + ((t * 2 + 0) * 64 + F.lane) * 16), k1 = *(const LAS bf16x8*)(F.lds + MX_K + ((t * 2 + 1) * 64 + F.lane) * 16);
                    f32x4 z = {0.f, 0.f, 0.f, 0.f}; z = __builtin_amdgcn_mfma_f32_16x16x32_bf16(k0, q0, z, 0, 0, 0); st[t] = __builtin_amdgcn_mfma_f32_16x16x32_bf16(k1, q1, z, 0, 0, 0); }
                float mx = -3.0e38f;
#pragma unroll
                for (int t = 0; t < 16; ++t) mx = fmaxf(fmaxf(mx, fmaxf(st[t][0], st[t][1])), fmaxf(st[t][2], st[t][3]));
                mx = fmaxf(mx, __shfl_xor(mx, 16)); mx = fmaxf(mx, __shfl_xor(mx, 32));
                float sum = 0.f; const float c2 = 0.125f * 1.4426950408889634f, mo = mx * c2;
#pragma unroll
                for (int t = 0; t < 16; ++t)
#pragma unroll
                    for (int i = 0; i < 4; ++i) { const float p = __builtin_amdgcn_exp2f(st[t][i] * c2 - mo); st[t][i] = p; sum += p; }
                sum += __shfl_xor(sum, 16); sum += __shfl_xor(sum, 32); rsum[hh] = 1.0f / sum;
                bf16x8 pb[8];
#pragma unroll
                for (int s = 0; s < 8; ++s) { v4u o; o.x = pk2(st[2 * s][0], st[2 * s][1]); o.y = pk2(st[2 * s][2], st[2 * s][3]); o.z = pk2(st[2 * s + 1][0], st[2 * s + 1][1]); o.w = pk2(st[2 * s + 1][2], st[2 * s + 1][3]);
                    pb[s] = __builtin_bit_cast(bf16x8, o); }
#pragma unroll
                for (int mt2 = 0; mt2 < 2; ++mt2)
#pragma unroll
                    for (int e = 0; e < 2; ++e) { f32x4 o = {0.f, 0.f, 0.f, 0.f};
#pragma unroll
                        for (int s = 0; s < 8; ++s) { const bf16x8 a = *(const LAS bf16x8*)(F.lds + MX_V + (((mt2 * 2 + e) * 8 + s) * 64 + F.lane) * 16);
                            o = __builtin_amdgcn_mfma_f32_16x16x32_bf16(a, pb[s], o, 0, 0, 0); }
#pragma unroll
                        for (int i = 0; i < 4; ++i) val[2 * hh + mt2][4 * e + i] = o[i] * rsum[hh]; }
            }
            mix_finish(val, gng + 768, grow + 768, q);
        }
#endif
        __syncthreads();
    }
}

#if NAIVE_MIX
__global__ void __launch_bounds__(256) nv_mix_pre(const bf16* P, const float* lng, const float* lnb, float* Vn, float* Dp) {
    const int row = blockIdx.x * 4 + (threadIdx.x >> 6), lane = threadIdx.x & 63;
    const bf16* p = P + (size_t)row * NPROJ;
    float v[4]; float s = 0.f;
    for (int i = 0; i < 4; ++i) { v[i] = gelu_tanh(bf2f(p[1280 + 4 * lane + i])); s += v[i]; }
    const float mean = wave_sum(s) * (1.f / 256.f); float s2 = 0.f;
    for (int i = 0; i < 4; ++i) { v[i] -= mean; s2 += v[i] * v[i]; }
    const float rstd = 1.f / sqrtf(wave_sum(s2) * (1.f / 256.f) + LN_EPS);
    for (int i = 0; i < 4; ++i) Vn[(size_t)row * 256 + 4 * lane + i] = v[i] * rstd * lng[4 * lane + i] + lnb[4 * lane + i];
    const int t = row % SEQ, w = 2 << (lane >> 4), cnt = (t + 1 < w) ? t + 1 : w;
    for (int i = 0; i < 4; ++i) { const int c = 4 * lane + i; float acc = 0.f;
        for (int d = 0; d < cnt; ++d) acc += bf2f(P[(size_t)(row - d) * NPROJ + 768 + c]);
        Dp[(size_t)row * 256 + c] = acc / (float)cnt - bf2f(p[768 + c]); }
}
__global__ void __launch_bounds__(256) nv_mix_main(const bf16* P, const float* Vn, const float* Dp, const bf16* Kb, const bf16* VT, const float* conv_w, const float* pool_w, const float* pool_scale,
                                                   const float* gmlp_w, const float* gmlp_b, float* Y) {
    const int row = blockIdx.x >> 2, grp = blockIdx.x & 3, c = threadIdx.x, t = row % SEQ;
    const bf16* p = P + (size_t)row * NPROJ; float y = 0.f;
    if (grp == 0) {
        float z[3];
        for (int d = 0; d < 3; ++d) { const int tt = t - 2 + d; z[d] = (tt >= 0) ? bf2f(P[(size_t)(row - 2 + d) * NPROJ + 256 + c]) * bf2f(P[(size_t)(row - 2 + d) * NPROJ + 512 + c]) : 0.f; }
        y = bf2f(p[c]) * (conv_w[c] * z[0] + conv_w[256 + c] * z[1] + conv_w[512 + c] * z[2]);
    } else if (grp == 1) {
        const int gi = c >> 6, dd = c & 63; float acc = 0.f;
        for (int cc = 0; cc < 64; ++cc) acc += Dp[(size_t)row * 256 + gi * 64 + cc] * pool_w[(gi * 64 + cc) * 64 + dd];
        y = acc * pool_scale[c];
    } else if (grp == 2) {
        const int hh = c >> 6, i = t & 127, jmax = ((i >> 6) + 1) * 64; const size_t blk0 = (size_t)(row - i); float acc = 0.f;
        for (int j = 0; j < jmax; ++j) acc += gmlp_w[(hh * 128 + i) * 128 + j] * Vn[(blk0 + j) * 256 + c];
        y = gelu_tanh(bf2f(p[1024 + c])) * (acc + gmlp_b[hh * 128 + i]);
    } else {
        const int hh = c >> 6, lane = c & 63, b = row / SEQ;
        const float q = bf2f(p[1536 + hh * 64 + lane]);
        float sc[4] = {0.f, 0.f, 0.f, 0.f};
        for (int d = 0; d < 64; ++d) { const float qd = __shfl(q, d);
            for (int m = 0; m < 4; ++m) sc[m] += qd * bf2f(Kb[(size_t)(b * 256 + lane + 64 * m) * 256 + hh * 64 + d]); }
        float mx = -3.0e38f;
        for (int m = 0; m < 4; ++m) { sc[m] *= 0.125f; mx = fmaxf(mx, sc[m]); }
        for (int o = 1; o < 64; o <<= 1) mx = fmaxf(mx, __shfl_xor(mx, o));
        float sum = 0.f;
        for (int m = 0; m < 4; ++m) { sc[m] = __expf(sc[m] - mx); sum += sc[m]; }
        sum = wave_sum(sum);
        float o = 0.f;
        for (int m = 0; m < 4; ++m) for (int j = 0; j < 64; ++j) { const float pj = __shfl(sc[m], j); o += pj * bf2f(VT[(size_t)(hh * 64 + lane) * 4096 + b * 256 + j + 64 * m]); }
        y = o / sum;
    }
    Y[(size_t)row * 1024 + grp * 256 + c] = y;
}
__global__ void __launch_bounds__(256) nv_mix_norm(const float* Y, const float* gng, bf16* G) {
    const int wv = blockIdx.x * 4 + (threadIdx.x >> 6), lane = threadIdx.x & 63, row = wv >> 2, grp = wv & 3;
    const float* y = Y + (size_t)row * 1024 + grp * 256; float v[4], s2 = 0.f;
    for (int i = 0; i < 4; ++i) { v[i] = y[4 * lane + i]; s2 += v[i] * v[i]; }
    const float r = 1.f / sqrtf(wave_sum(s2) * (1.f / 256.f) + RMS_EPS);
    for (int i = 0; i < 4; ++i) G[(size_t)row * 1024 + grp * 256 + 4 * lane + i] = (bf16)f2bf(v[i] * r * gng[grp * 256 + 4 * lane + i]);
}
#endif

constexpr int PH_PRO = 0, PH_KV = 1, PH_L0 = 2, PH_PER_LAYER = 8, N_PHASES = PH_L0 + NLAYER * PH_PER_LAYER;
__global__ void __launch_bounds__(NWAVES * 64, 2) fwd(Args args) {
    const Args& A = args;
    extern __shared__ __attribute__((aligned(16))) unsigned char lds[];
    Frame F;
    F.lds = (LAS unsigned char*)lds;
    F.MISC = (volatile LAS unsigned*)(F.lds + MISC_OFF);
    F.tid = threadIdx.x; F.lane = F.tid & 63; F.wave = __builtin_amdgcn_readfirstlane(F.tid >> 6);
    F.G = gridDim.x; F.ws = args.ws; F.ctl = (gu32*)(args.ws + WS_CTL); F.out = args.out;
    for (int u = F.tid; u < (LDS_BYTES - LDSCTL_OFF) / 4; u += NWAVES * 64) ((LAS unsigned*)(F.lds + LDSCTL_OFF))[u] = 0u;
    __syncthreads();
#if MK_ONE_LAUNCH
    XcdBarrier bar = xcd_barrier_post((unsigned*)(F.ctl + CW_BAR), F.MISC + 8);
#define GRID_BAR() xcd_barrier(bar)
#else
#define GRID_BAR() do { } while (0)
#endif
    const int lo = args.ph_lo, hi = args.ph_hi;
#define IN(k) (lo <= (k) && (k) < hi)
#define REP(q) for (int rep_ = 0; rep_ < ((DUP_PHASE == (q)) ? 2 : 1); ++rep_)
#define BOTH(k) (IN(k) && IN((k) + 1))
    const pg8::Gemm gm{(const pg8::bf16_t*)F.ws, (const pg8::bf16_t*)F.ws, D};
    const int c = (int)blockIdx.x;

    REP(100) if (IN(PH_PRO) && (PHMASK & 1)) { p0_prologue(F, args); if (BOTH(PH_PRO)) GRID_BAR(); }
    REP(101) if (IN(PH_KV) && (PHMASK & 2)) {
        KvOrder S{F.G, c};
        pg8::EpiBf16Sel E{WSP(bf16, WS_KB), WSP(bf16, WS_VT), 256, 4096, 0};
        pg8::gemm_phase<pg8::EpiBf16Sel, KvOrder, true, true>(F.lds + RING_OFF, gm, S, E);
        if (BOTH(PH_KV)) GRID_BAR();
    }
    for (int l = 0; l < NLAYER; ++l) {
        const int pb = PH_L0 + l * PH_PER_LAYER;
        REP(0) if (IN(pb + 0) && (PHMASK & 4)) {
            DenseOrder S{NTOK / 256, NPROJ / 256, F.G, c, T_HB, T_WIN + l * (NPROJ / 256)};
            pg8::EpiBf16Sel E{WSP(bf16, WS_P), WSP(bf16, WS_P), NPROJ, NPROJ, 0};
            pg8::gemm_phase<pg8::EpiBf16Sel, DenseOrder, true, true>(F.lds + RING_OFF, gm, S, E);
            if (BOTH(pb + 0)) GRID_BAR();
        }
        REP(1) if (IN(pb + 1) && (PHMASK & 512)) {
            pb_phase(F, args, l);
            if (BOTH(pb + 1)) GRID_BAR();
        }
        REP(2) if (IN(pb + 2) && (PHMASK & 8)) {
            DenseOrder S{NTOK / 256, D / 256, F.G, c, T_G, T_WOUT + l * (D / 256)};
            pg8::EpiResBf16 E{TILEP(T_HB), WSP(bf16, WS_PRE), DN_ALPHA, 0};
            pg8::gemm_phase<pg8::EpiResBf16, DenseOrder, true, true>(F.lds + RING_OFF, gm, S, E);
            if (BOTH(pb + 2)) GRID_BAR();
        }
        REP(3) if (IN(pb + 3) && (PHMASK & 16)) { pd_phase(F, args, l, DUP_PHASE == 3 && rep_ == 0); if (BOTH(pb + 3)) GRID_BAR(); }
        REP(4) if (IN(pb + 4) && (PHMASK & 32)) { pe_phase(F, l); if (BOTH(pb + 4)) GRID_BAR(); }
        REP(5) if (IN(pb + 5) && (PHMASK & 64)) {
            compute_toff(F, l);
            const LAS int* toff = (const LAS int*)(F.lds + TOFF_OFF);
            MoeOrder S{__builtin_amdgcn_readfirstlane(toff[NEXP]), 8, F.G, c, Q8(WS_XP8), Q8(WS_W18) + l * NEXP * 8, toff};
            pg8::EpiSwiglu E{F.ws + WS_ACT8, A.in[I_B1] + (size_t)l * NEXP * 2048, (DUP_PHASE == 5 && rep_ == 0) ? PROBE_MODE : 0};
            pg8::gemm_phase<pg8::EpiSwiglu, MoeOrder, true, true, true>(F.lds + RING_OFF, gm, S, E);
            if (BOTH(pb + 5)) GRID_BAR();
        }
        REP(6) if (IN(pb + 6) && (PHMASK & 128)) {
            compute_toff(F, l);
            const LAS int* toff = (const LAS int*)(F.lds + TOFF_OFF);
            MoeOrder S{__builtin_amdgcn_readfirstlane(toff[NEXP]), 4, F.G, c, Q8(WS_ACT8), Q8(WS_W28) + l * NEXP * 4, toff};
            pg8::EpiDown E{F.ws + WS_YS8, A.in[I_B2] + (size_t)l * NEXP * 1024, (DUP_PHASE == 6 && rep_ == 0) ? PROBE_MODE : 0};
            pg8::gemm_phase<pg8::EpiDown, MoeOrder, true, true, true>(F.lds + RING_OFF, gm, S, E);
            if (BOTH(pb + 6)) GRID_BAR();
        }
        REP(7) if (IN(pb + 7) && (PHMASK & 256)) { ph_phase(F, args, l, DUP_PHASE == 7 && rep_ == 0); if ((DUP_PHASE == 7 && rep_ == 0) || BOTH(pb + 7)) GRID_BAR(); }
    }
#undef IN
#undef BOTH
}

extern "C" void kernel_launch(void* const* d_in, const int* in_sizes, int n_in, void* d_out, int out_size, void* d_ws, size_t ws_size, hipStream_t stream) {
    static int grid = 0;
    if (grid == 0) {
        if (n_in != 27 || out_size != NTOK * D || ws_size < WS_END) { fprintf(stderr, "kernel_launch: unexpected problem (n_in %d, out %d, ws %zu < %zu)\n", n_in, out_size, ws_size, (size_t)WS_END); grid = -1; return; }
        int dev = 0, cus = 0, per_cu = 0;
        if (hipGetDevice(&dev) != hipSuccess || hipDeviceGetAttribute(&cus, hipDeviceAttributeMultiprocessorCount, dev) != hipSuccess) { grid = -1; return; }
        if (hipFuncSetAttribute((const void*)fwd, hipFuncAttributeMaxDynamicSharedMemorySize, LDS_BYTES) != hipSuccess) { fprintf(stderr, "kernel_launch: hipFuncSetAttribute failed\n"); grid = -1; return; }
        if (hipOccupancyMaxActiveBlocksPerMultiprocessor(&per_cu, (const void*)fwd, NWAVES * 64, LDS_BYTES) != hipSuccess || per_cu < 1) fprintf(stderr, "kernel_launch: occupancy query says %d\n", per_cu);
        (void)hipGetLastError();
        grid = cus;
    }
    if (grid < 0) return;
    if (hipMemsetAsync((char*)d_ws + WS_CTL, 0, CTL_ZERO_BYTES, stream) != hipSuccess) return;
    Args a{};
    for (int i = 0; i < 27; ++i) a.in[i] = (const float*)d_in[i];
    a.out = (float*)d_out; a.ws = (unsigned char*)d_ws;
#if MK_ONE_LAUNCH
    a.ph_lo = 0; a.ph_hi = N_PHASES;
    hipLaunchKernelGGL(fwd, dim3(grid), dim3(NWAVES * 64), LDS_BYTES, stream, a);
#else
    unsigned char* ws = (unsigned char*)d_ws;
    for (int p = 0; p < N_PHASES; ++p) {
        const int l = (p - PH_L0) / PH_PER_LAYER, q = (p - PH_L0) % PH_PER_LAYER;
        if (p >= PH_L0 && q == 1) {
#if NAIVE_MIX
            const float* const* in = (const float* const*)d_in;
            hipLaunchKernelGGL(nv_mix_pre, dim3(NTOK / 4), dim3(256), 0, stream, (const bf16*)(ws + WS_P), in[10] + l * 256, in[11] + l * 256, (float*)(ws + WS_NV_VN), (float*)(ws + WS_NV_DP));
            hipLaunchKernelGGL(nv_mix_main, dim3(NTOK * 4), dim3(256), 0, stream, (const bf16*)(ws + WS_P), (const float*)(ws + WS_NV_VN), (const float*)(ws + WS_NV_DP),
                               (const bf16*)(ws + WS_KB) + (size_t)l * 4096 * 256, (const bf16*)(ws + WS_VT) + (size_t)l * 256 * 4096, in[7] + l * 768, in[8] + l * 4 * 64 * 64, in[9] + l * 256,
                               in[12] + l * 4 * 128 * 128, in[13] + l * 4 * 128, (float*)(ws + WS_NV_Y));
            hipLaunchKernelGGL(nv_mix_norm, dim3(NTOK), dim3(256), 0, stream, (const float*)(ws + WS_NV_Y), in[15] + l * 1024, (bf16*)(ws + (size_t)T_G * TILE));
            continue;
#endif
        }
        a.ph_lo = p; a.ph_hi = p + 1;
        hipLaunchKernelGGL(fwd, dim3(grid), dim3(NWAVES * 64), LDS_BYTES, stream, a);
    }
#endif
}
```
